# Optimizing an MI355X kernel written in HIP

```python
import jax, jax.numpy as jnp
from jax import lax
import numpy as np

D_MODEL = 2048
BATCH = 2
SEQ = 8192
DEPTH = 1

GRID_W = 64
CTX_LEN = 256
D_MIX = D_MODEL
D_A = D_MIX // 2
D_B = D_MIX - D_A
LRU_HEADS = 8
LRU_BLK = D_A // LRU_HEADS
LRU_C = 8.0
CONV_A_W = 4
CONV_A_LEFT = 2
CONV_B_W = 3
CONV_B_LEFT = 1
N_EXPERTS = 32
TOP_K = 4
D_FF = D_MODEL
SWIGLU_LIMIT = 7.0
SWIGLU_ALPHA = 1.702
MOE_BLOCK = 256
EPS = 1e-6
N_IN = 2 * D_A + 3 * D_B

kernel_name = "hybrid_rglru_shortconv_moe_dit"


def rms_norm(x, g):
    xf = x.astype(jnp.float32)
    y = xf * lax.rsqrt(jnp.mean(xf * xf, axis=-1, keepdims=True) + EPS)
    return (y * g.astype(jnp.float32)).astype(x.dtype)


def modulate(x, shift, scale):
    return x * (1 + scale) + shift


def dwconv(x, w, axis, left):
    k_w = w.shape[0]
    n = x.shape[axis]
    pad = [(0, 0)] * x.ndim
    pad[axis] = (left, k_w - 1 - left)
    xp = jnp.pad(x, pad)
    out = lax.slice_in_dim(xp, 0, n, axis=axis) * w[0]
    for k in range(1, k_w):
        out = out + lax.slice_in_dim(xp, k, k + n, axis=axis) * w[k]
    return out


def conv_b_latent(z, w):
    bsz, n, ch = z.shape
    rows = n // GRID_W
    half = ch // 2
    zg = z.reshape(bsz, rows, GRID_W, ch)
    horiz = dwconv(zg[..., :half], w[:, :half], 2, CONV_B_LEFT)
    vert = dwconv(zg[..., half:], w[:, half:], 1, CONV_B_LEFT)
    return jnp.concatenate([horiz, vert], axis=-1).reshape(bsz, n, ch)


def split_in(u):
    return jnp.split(u, [D_A, 2 * D_A, 2 * D_A + D_B, 2 * D_A + 2 * D_B], axis=-1)


def rglru_coeffs(xa, conv_w, conv_b, w_r, b_r, w_i, b_i, lam):
    xc = dwconv(xa, conv_w, 1, CONV_A_LEFT) + conv_b
    bsz, n, _ = xc.shape
    xh = xc.reshape(bsz, n, LRU_HEADS, LRU_BLK)
    r = jax.nn.sigmoid(jnp.einsum('blhi,dhij->dblhj', xh, w_r).reshape(2, bsz, n, D_A) + b_r[:, None, None])
    i = jax.nn.sigmoid(jnp.einsum('blhi,dhij->dblhj', xh, w_i).reshape(2, bsz, n, D_A) + b_i[:, None, None])
    log_a = -LRU_C * r.astype(jnp.float32) * jax.nn.softplus(-lam.astype(jnp.float32))[:, None, None]
    a = jnp.exp(log_a)
    b = jnp.sqrt(-jnp.expm1(2.0 * log_a)) * (i.astype(jnp.float32) * xc.astype(jnp.float32)[None])
    return a, b


def linear_scan(a, b, h0, reverse):
    def combine(lhs, rhs):
        return lhs[0] * rhs[0], rhs[0] * lhs[1] + rhs[1]
    a_cum, b_cum = lax.associative_scan(combine, (a, b), axis=1, reverse=reverse)
    return a_cum * h0[:, None] + b_cum


def mixer_out(y_a, y_b, g_out_a, g_out_b, w_out):
    y = jnp.concatenate([rms_norm(y_a, g_out_a), rms_norm(y_b, g_out_b)], axis=-1)
    return y @ w_out


def moe_ffn(xt, w_router, b_router, w_gate, b_gate, w_up, b_up, w_down, b_down):
    n_tok, d = xt.shape
    logits = (xt @ w_router + b_router).astype(jnp.float32)
    top_v, top_e = lax.top_k(logits, TOP_K)
    top_w = jax.nn.softmax(top_v, axis=-1).astype(xt.dtype)
    n_slot = n_tok * TOP_K
    flat_e = top_e.reshape(n_slot)
    order = jnp.argsort(flat_e)
    sorted_e = flat_e[order]
    slot_tok = (order // TOP_K).astype(jnp.int32)
    slot_w = top_w.reshape(n_slot)[order]
    counts = jnp.bincount(flat_e, length=N_EXPERTS)
    padded = (counts + MOE_BLOCK - 1) // MOE_BLOCK * MOE_BLOCK
    pad_end = jnp.cumsum(padded)
    pad_start = pad_end - padded
    grp_start = jnp.cumsum(counts) - counts
    dest = pad_start[sorted_e] + jnp.arange(n_slot, dtype=jnp.int32) - grp_start[sorted_e]
    n_blocks = -(-n_slot // MOE_BLOCK) + N_EXPERTS
    n_buf = n_blocks * MOE_BLOCK
    buf_tok = jnp.zeros((n_buf,), jnp.int32).at[dest].set(slot_tok)
    buf_w = jnp.zeros((n_buf,), xt.dtype).at[dest].set(slot_w)
    block_e = jnp.minimum(
        jnp.searchsorted(pad_end, jnp.arange(n_blocks, dtype=jnp.int32) * MOE_BLOCK, side='right'),
        N_EXPERTS - 1)

    def expert_block(args):
        idx, wts, e = args
        h = jnp.take(xt, idx, axis=0)
        gate = jnp.minimum(h @ w_gate[e] + b_gate[e], SWIGLU_LIMIT)
        up = jnp.clip(h @ w_up[e] + b_up[e], -SWIGLU_LIMIT, SWIGLU_LIMIT)
        act = (up + 1) * gate * jax.nn.sigmoid(SWIGLU_ALPHA * gate)
        return (act @ w_down[e] + b_down[e]) * wts[:, None]

    y = lax.map(expert_block, (buf_tok.reshape(n_blocks, MOE_BLOCK),
                               buf_w.reshape(n_blocks, MOE_BLOCK), block_e))
    return jax.ops.segment_sum(y.reshape(n_buf, d), buf_tok, num_segments=n_tok)


def setup_inputs(seed: int = 0) -> dict:
    key = jax.random.key(seed)
    ks = jax.random.split(key, 32)
    f32 = jnp.float32

    def nrm(k, shape, scale):
        return jax.random.normal(k, shape, f32) * scale

    u = jax.random.uniform(ks[14], (DEPTH, 2, D_A), f32, minval=0.9, maxval=0.999)
    a0 = u ** (1.0 / LRU_C)
    lru_lam = jnp.log(a0) - jnp.log1p(-a0)
    return {
        "x": nrm(ks[0], (BATCH, SEQ, D_MODEL), 1.0),
        "c": nrm(ks[1], (BATCH, D_MODEL), 1.0),
        "ctx": nrm(ks[2], (BATCH, CTX_LEN, D_MODEL), 1.0),
        "c_ctx": nrm(ks[3], (D_MODEL,), 1.0),
        "w_mod": nrm(ks[4], (DEPTH, D_MODEL, 6 * D_MODEL), 0.5 * D_MODEL ** -0.5),
        "b_mod": nrm(ks[5], (DEPTH, 6 * D_MODEL), 0.02),
        "g_mix": 1.0 + nrm(ks[6], (DEPTH, D_MODEL), 0.02),
        "w_in": nrm(ks[7], (DEPTH, D_MODEL, N_IN), D_MODEL ** -0.5),
        "conv_a_w": nrm(ks[8], (DEPTH, CONV_A_W, D_A), CONV_A_W ** -0.5),
        "conv_a_b": nrm(ks[9], (DEPTH, D_A), 0.02),
        "lru_w_r": nrm(ks[10], (DEPTH, 2, LRU_HEADS, LRU_BLK, LRU_BLK), LRU_BLK ** -0.5),
        "lru_b_r": nrm(ks[11], (DEPTH, 2, D_A), 0.02),
        "lru_w_i": nrm(ks[12], (DEPTH, 2, LRU_HEADS, LRU_BLK, LRU_BLK), LRU_BLK ** -0.5),
        "lru_b_i": nrm(ks[13], (DEPTH, 2, D_A), 0.02),
        "lru_lam": lru_lam,
        "conv_b_w": nrm(ks[15], (DEPTH, CONV_B_W, D_B), CONV_B_W ** -0.5),
        "g_out_a": 1.0 + nrm(ks[16], (DEPTH, D_A), 0.02),
        "g_out_b": 1.0 + nrm(ks[17], (DEPTH, D_B), 0.02),
        "w_out": nrm(ks[18], (DEPTH, D_MIX, D_MODEL), D_MIX ** -0.5),
        "g_ffn": 1.0 + nrm(ks[19], (DEPTH, D_MODEL), 0.02),
        "w_router": nrm(ks[20], (DEPTH, D_MODEL, N_EXPERTS), D_MODEL ** -0.5),
        "b_router": nrm(ks[21], (DEPTH, N_EXPERTS), 0.01),
        "w_gate": nrm(ks[22], (DEPTH, N_EXPERTS, D_MODEL, D_FF), D_MODEL ** -0.5),
        "b_gate": nrm(ks[23], (DEPTH, N_EXPERTS, D_FF), 0.01),
        "w_up": nrm(ks[24], (DEPTH, N_EXPERTS, D_MODEL, D_FF), D_MODEL ** -0.5),
        "b_up": nrm(ks[25], (DEPTH, N_EXPERTS, D_FF), 0.01),
        "w_down": nrm(ks[26], (DEPTH, N_EXPERTS, D_FF, D_MODEL), D_FF ** -0.5),
        "b_down": nrm(ks[27], (DEPTH, N_EXPERTS, D_MODEL), 0.01),
        "g_final": 1.0 + nrm(ks[28], (D_MODEL,), 0.02),
    }


def reference(x, c, ctx, c_ctx, w_mod, b_mod, g_mix, w_in, conv_a_w, conv_a_b, lru_w_r, lru_b_r,
              lru_w_i, lru_b_i, lru_lam, conv_b_w, g_out_a, g_out_b, w_out, g_ffn, w_router,
              b_router, w_gate, b_gate, w_up, b_up, w_down, b_down, g_final):
    bsz, n_lat, d = x.shape
    n_ctx = ctx.shape[1]
    s = ctx
    for l in range(DEPTH):
        last = l == DEPTH - 1
        mod = jax.nn.silu(c) @ w_mod[l] + b_mod[l]
        mod_s = jax.nn.silu(c_ctx) @ w_mod[l] + b_mod[l]
        sh1, sc1, gt1, sh2, sc2, gt2 = [m[:, None] for m in jnp.split(mod, 6, axis=-1)]
        ssh1, ssc1, sgt1, ssh2, ssc2, sgt2 = jnp.split(mod_s, 6, axis=-1)
        lru_p = (conv_a_w[l], conv_a_b[l], lru_w_r[l], lru_b_r[l], lru_w_i[l], lru_b_i[l], lru_lam[l])
        zero_state = jnp.zeros((bsz, D_A), jnp.float32)

        sn = modulate(rms_norm(s, g_mix[l]), ssh1, ssc1)
        if last:
            s_ax = sn @ w_in[l][:, D_A:2 * D_A]
        else:
            s_ag, s_ax, s_bb, s_bc, s_bh = split_in(sn @ w_in[l])
        a_s, b_s = rglru_coeffs(s_ax, *lru_p)
        hf_s = linear_scan(a_s[0], b_s[0], zero_state, False)
        hb_s = linear_scan(a_s[1], b_s[1], zero_state, True)
        if not last:
            ys_a = jax.nn.gelu(s_ag) * (hf_s + hb_s).astype(s.dtype)
            ys_b = s_bb * dwconv(s_bc * s_bh, conv_b_w[l], 1, CONV_B_LEFT)
            s = s + sgt1 * mixer_out(ys_a, ys_b, g_out_a[l], g_out_b[l], w_out[l])

        xn = modulate(rms_norm(x, g_mix[l]), sh1, sc1)
        x_ag, x_ax, x_bb, x_bc, x_bh = split_in(xn @ w_in[l])
        a_x, b_x = rglru_coeffs(x_ax, *lru_p)
        hf = linear_scan(a_x[0], b_x[0], hf_s[:, -1], False)
        hb = linear_scan(a_x[1], b_x[1], hb_s[:, 0], True)
        y_a = jax.nn.gelu(x_ag) * (hf + hb).astype(x.dtype)
        y_b = x_bb * conv_b_latent(x_bc * x_bh, conv_b_w[l])
        x = x + gt1 * mixer_out(y_a, y_b, g_out_a[l], g_out_b[l], w_out[l])

        moe_p = (w_router[l], b_router[l], w_gate[l], b_gate[l], w_up[l], b_up[l], w_down[l], b_down[l])
        xn = modulate(rms_norm(x, g_ffn[l]), sh2, sc2).reshape(bsz * n_lat, d)
        if last:
            x = x + gt2 * moe_ffn(xn, *moe_p).reshape(bsz, n_lat, d)
        else:
            sn = modulate(rms_norm(s, g_ffn[l]), ssh2, ssc2).reshape(bsz * n_ctx, d)
            out = moe_ffn(jnp.concatenate([xn, sn], axis=0), *moe_p)
            x = x + gt2 * out[:bsz * n_lat].reshape(bsz, n_lat, d)
            s = s + sgt2 * out[bsz * n_lat:].reshape(bsz, n_ctx, d)
    return rms_norm(x, g_final)
```

```cpp
#include <hip/hip_runtime.h>
#include <cstdio>
#include <cstdint>
#include <type_traits>

#ifndef MK_N_LAUNCHES
#define MK_N_LAUNCHES 1
#endif

#define GAS __attribute__((address_space(1)))
#define LAS __attribute__((address_space(3)))
typedef unsigned short bf16_t;
typedef short bf16x8 __attribute__((ext_vector_type(8)));
typedef float f32x4 __attribute__((ext_vector_type(4)));
typedef float f32x2 __attribute__((ext_vector_type(2)));
typedef unsigned u32x4 __attribute__((ext_vector_type(4)));
typedef unsigned u32x2 __attribute__((ext_vector_type(2)));

constexpr int T = 16384, SEQ = 8192, D = 2048, DA = 1024, NIN = 5120, CTXL = 256, NCTX = 512, MROWS = T + NCTX;
constexpr int NE = 32, FF = 2048, CAP = 16384, HROWS = 73728;
constexpr int NCHUNK = 132;
constexpr float EPS = 1e-6f;
constexpr int NPH = 12;
constexpr int N_LAUNCHES = MK_N_LAUNCHES;
#ifndef REPEAT_MASK
#define REPEAT_MASK 0
#endif
#ifndef MK_NC8
#define MK_NC8 3
#endif
constexpr int NC8 = MK_NC8;

constexpr size_t MiB = 1u << 20;
constexpr size_t WS_CTL = 0, CTL_ZERO_BYTES = 1 * MiB;
constexpr size_t WS_MOD = 1 * MiB;
constexpr size_t WS_WG = 2 * MiB;
constexpr size_t WS_WIN = 4 * MiB;
constexpr size_t WS_WOUT = 24 * MiB;
constexpr size_t WS_AGG = 32 * MiB;
constexpr size_t WS_HIN = 38 * MiB;
constexpr size_t WS_ER = 40 * MiB;
constexpr size_t WS_STOK = 41 * MiB;
constexpr size_t WS_SLW = 43 * MiB;
constexpr size_t WS_XN = 48 * MiB;
constexpr size_t WS_G = 116 * MiB;
constexpr size_t WS_XA = 148 * MiB;
constexpr size_t WS_BB = 182 * MiB;
constexpr size_t WS_P = 214 * MiB;
constexpr size_t WS_Y = 246 * MiB;
constexpr size_t WS_WGU = 320 * MiB;
constexpr size_t WS_WDN = 832 * MiB;
constexpr size_t WS_H = 1088 * MiB;
constexpr size_t WS_O = 1376 * MiB;
constexpr size_t WS_HS = 1664 * MiB;
constexpr size_t WS_XN2 = 1696 * MiB;
constexpr size_t WS_END = 1728 * MiB;
constexpr int CW_CNT = 64;
constexpr int CW_BAR = 4096;
constexpr int CW_BARM = 8192;
constexpr int CW_Q0 = 96;
constexpr int CW_QCV6 = 224;
constexpr int CW_QCV = 160;

constexpr int LDS_BYTES = 155648;
constexpr int MISC_OFF = 154624;

__device__ __forceinline__ unsigned cvt_pk_bf16(float lo, float hi) { unsigned r; asm volatile("v_cvt_pk_bf16_f32 %0, %1, %2" : "=v"(r) : "v"(lo), "v"(hi)); return r; }
constexpr float X6_SCALE = 1.5f, GU_INV = 1.0f / 96.0f;
constexpr float W8_SCALE = 64.0f, W8_INV = 1.0f / 64.0f, O8_SCALE = 16.0f, O8_INV = 1.0f / 16.0f;
__device__ __forceinline__ unsigned pk4_fp8(float a, float b, float c, float d) { int w = 0; w = __builtin_amdgcn_cvt_pk_fp8_f32(a, b, w, false); w = __builtin_amdgcn_cvt_pk_fp8_f32(c, d, w, true); return (unsigned)w; }
__device__ __forceinline__ float bf_lo(unsigned w) { return __uint_as_float(w << 16); }
__device__ __forceinline__ float bf_hi(unsigned w) { return __uint_as_float(w & 0xffff0000u); }
__device__ __forceinline__ float fexp(float x) { return __builtin_amdgcn_exp2f(x * 1.44269504089f); }
__device__ __forceinline__ float fsigmoid(float x) { return __builtin_amdgcn_rcpf(1.0f + fexp(-x)); }
__device__ __forceinline__ float gelu_tanh(float x) { const float u = 0.7978845608028654f * (x + 0.044715f * x * x * x); return x * __builtin_amdgcn_rcpf(1.0f + fexp(-2.0f * u)); }
__device__ __forceinline__ float one_minus_exp(float u) { const float ser = -u * (1.0f + 0.5f * u * (1.0f + (1.0f / 3.0f) * u * (1.0f + 0.25f * u))); const float dir = 1.0f - fexp(u); return u > -0.05f ? ser : dir; }
__device__ __forceinline__ void gate_pair(float xr, float xi, float cf, float xc, float& a_out, float& b_out) {
    const float er = 1.0f + fexp(-fmaxf(xr, -30.0f)), ei = 1.0f + fexp(-fmaxf(xi, -30.0f)), inv = __builtin_amdgcn_rcpf(er * ei);
    const float r = inv * ei, ig = inv * er, la = cf * r, a = fexp(la), u = 2.0f * la;
    const float ser = -u * (1.0f + 0.5f * u * (1.0f + (1.0f / 3.0f) * u * (1.0f + 0.25f * u))), dir = 1.0f - a * a;
    a_out = a; b_out = __builtin_amdgcn_sqrtf(u > -0.05f ? ser : dir) * ig * xc;
}
__device__ __forceinline__ float wave_sum(float v) {
#pragma unroll
    for (int o = 1; o < 64; o <<= 1) v += __shfl_xor(v, o);
    return v;
}
__device__ __forceinline__ void unpack8(const u32x4 w, float (&f)[8]) { f[0] = bf_lo(w.x); f[1] = bf_hi(w.x); f[2] = bf_lo(w.y); f[3] = bf_hi(w.y); f[4] = bf_lo(w.z); f[5] = bf_hi(w.z); f[6] = bf_lo(w.w); f[7] = bf_hi(w.w); }

namespace pg8 {
#define PG8_LAS __attribute__((address_space(3)))
constexpr int BM = 256, BK = 64, HALF = 128, HTB = HALF * BK * 2, STAGE_BYTES = 8 * HTB, NXCD = 8, WGM = 8;
__host__ __device__ __forceinline__ int lds_byte(int r, int c) { const int st = (r >> 4) * 2 + (c >> 5), rr = r & 15, cc = c & 31, ob = rr * 64 + cc * 2; return st * 1024 + (ob ^ (((ob >> 9) & 1) << 5)); }
__host__ __device__ __forceinline__ void stage_rc(int b, int& R, int& C) { const int st = b / 1024, sb = b % 1024, swz = sb ^ (((sb >> 9) & 1) << 5); R = (st >> 1) * 16 + swz / 64; C = (st & 1) * 32 + (swz % 64) / 2; }
__host__ __device__ __forceinline__ int perm32(int rho) { const int n = rho >> 4, i = rho & 15; return 8 * (i >> 2) + 4 * n + (i & 3); }

struct Unit { int pm, pn, e, mt; };

__device__ __forceinline__ int xcd_remap(int L, int nwg) { const int q = nwg / NXCD, r = nwg % NXCD, xcd = L % NXCD, off = L / NXCD; return (xcd < r ? xcd * (q + 1) : r * (q + 1) + (xcd - r) * q) + off; }

typedef int i32x4 __attribute__((ext_vector_type(4)));
typedef int i32x8 __attribute__((ext_vector_type(8)));
__device__ __forceinline__ i32x8 cat8(const bf16x8 a, const bf16x8 b) { return __builtin_shufflevector(__builtin_bit_cast(i32x4, a), __builtin_bit_cast(i32x4, b), 0, 1, 2, 3, 4, 5, 6, 7); }
__device__ __forceinline__ void mfma_fp8(f32x4& acc, const i32x8 a, const i32x8 b, const int sc) {
    (void)sc; asm volatile("v_mfma_f32_16x16x128_f8f6f4 %0, %1, %2, %0" : "+v"(acc) : "v"(a), "v"(b)); }
typedef int i32x6 __attribute__((ext_vector_type(6)));
typedef int i32x2 __attribute__((ext_vector_type(2)));
__device__ __forceinline__ void mfma_fp6(f32x4& acc, const i32x6 a, const i32x6 b) { asm volatile("v_mfma_f32_16x16x128_f8f6f4 %0, %1, %2, %0 cbsz:2 blgp:2" : "+v"(acc) : "v"(a), "v"(b)); }
__device__ __forceinline__ i32x6 cat6(const bf16x8 a, const i32x2 b) { return __builtin_shufflevector(__builtin_bit_cast(i32x4, a), __builtin_shufflevector(b, b, 0, 1, -1, -1), 0, 1, 2, 3, 4, 5); }
template <int OFF> __device__ __forceinline__ i32x2 lds_rd64(const PG8_LAS unsigned char* p) { i32x2 r; asm volatile("ds_read_b64 %0, %1 offset:%2" : "=v"(r) : "v"(p), "n"(OFF)); return r; }
template <class Epi, class Sched, bool GATHER, bool ALIGN_EPI, bool SP2, bool FP8, bool FP6 = false>
__device__ __forceinline__ void gemm_phase(PG8_LAS unsigned char* lds, const int K, const Sched& S, const Epi& E) {
    int tid = threadIdx.x; asm volatile("" : "+v"(tid));
    const int wid = __builtin_amdgcn_readfirstlane(tid >> 6), lane = tid & 63, wr = wid >> 2, wc = wid & 3, fr = lane & 15, fq = lane >> 4;
    const int nt = K / BK;
    int Rr[2], Cc[2]; unsigned voffB[2]; unsigned vAc[2][2], vAn[2][2];
#pragma unroll
    for (int i = 0; i < 2; ++i) { stage_rc(tid * 16 + i * 8192, Rr[i], Cc[i]); const int Rb = Epi::PERM ? ((Rr[i] & ~31) + perm32(Rr[i] & 31)) : Rr[i];
        voffB[i] = (unsigned)(Rb * K + Cc[i]) * 2u; }
    const size_t kstep = (size_t)(BK * 2);
    const size_t hstep = (size_t)HALF * K * 2;
    const unsigned ldsw = (unsigned)wid * 1024u;
    const int aoff = lds_byte(wr * 64 + fr, fq * 8), boff = lds_byte(wc * 32 + fr, fq * 8);
    const int dup8 = 8 * ((fr >> 2) & 1);
#define PG8_SA(b, h) (((b) * 2 + (h)) * HTB)
#define PG8_SB(b, h) ((4 + (b) * 2 + (h)) * HTB)
#define PG8_STAGE(bufoff, gbase, voff) do { _Pragma("unroll") for (int _i = 0; _i < 2; ++_i) \
        __builtin_amdgcn_global_load_lds((const unsigned*)((const char*)(gbase) + (voff)[_i]), (PG8_LAS unsigned*)(lds + (bufoff) + ldsw + _i * 8192), 16, 0, 0); } while (0)
#define PG8_STAGE_A(bufoff, gbase, VO, h) do { if constexpr (GATHER) { PG8_STAGE(bufoff, gbase, (VO)[h]); } else { PG8_STAGE(bufoff, (gbase) + (h) * hstep, (VO)[0]); } } while (0)
#define PG8_LDA(dst, b, h) do { _Pragma("unroll") for (int m = 0; m < 4; ++m) dst[m] = *(const PG8_LAS bf16x8*)(lds + PG8_SA(b, h) + aoff + m * 2048); \
        if constexpr (FP6) { dst##2[0] = rd2<PG8_SA(b, h) + 1024>(lds + aoff + dup8); dst##2[1] = rd2<PG8_SA(b, h) + 3072>(lds + aoff + dup8); dst##2[2] = rd2<PG8_SA(b, h) + 5120>(lds + aoff + dup8); dst##2[3] = rd2<PG8_SA(b, h) + 7168>(lds + aoff + dup8); } \
        else { _Pragma("unroll") for (int m = 0; m < 4; ++m) dst##2[m] = rd2v(lds + PG8_SA(b, h) + aoff + m * 2048 + 1024); } } while (0)
#define PG8_LDB(dst, b, h) do { _Pragma("unroll") for (int n = 0; n < 2; ++n) dst[n] = *(const PG8_LAS bf16x8*)(lds + PG8_SB(b, h) + boff + n * 2048); \
        if constexpr (FP6) { dst##2[0] = rd2<PG8_SB(b, h) - 65536 + 1024>(lds + 65536 + boff + dup8); dst##2[1] = rd2<PG8_SB(b, h) - 65536 + 3072>(lds + 65536 + boff + dup8); } \
        else { _Pragma("unroll") for (int n = 0; n < 2; ++n) dst##2[n] = rd2v(lds + PG8_SB(b, h) + boff + n * 2048 + 1024); } } while (0)
#define PG8_MMA(ai, bj, At, Bt) do { __builtin_amdgcn_s_setprio(1); _Pragma("unroll") for (int m = 0; m < 4; ++m) _Pragma("unroll") for (int n = 0; n < 2; ++n) { \
        if constexpr (FP6) mfma_fp6(acc[ai][bj][m][n], cat6(Bt[n], Bt##2[n]), cat6(At[m], At##2[m])); \
        else if constexpr (FP8) mfma_fp8(acc[ai][bj][m][n], cat8(Bt[n], Bt##2[n]), cat8(At[m], At##2[m]), sc1); \
        else { acc[ai][bj][m][n] = __builtin_amdgcn_mfma_f32_16x16x32_bf16(Bt[n], At[m], acc[ai][bj][m][n], 0, 0, 0); acc[ai][bj][m][n] = __builtin_amdgcn_mfma_f32_16x16x32_bf16(Bt##2[n], At##2[m], acc[ai][bj][m][n], 0, 0, 0); } } __builtin_amdgcn_s_setprio(0); } while (0)
#define PG8_WAIT_V(n) asm volatile("s_waitcnt vmcnt(" #n ")" ::: "memory")
#define PG8_WAIT_L(n) asm volatile("s_waitcnt lgkmcnt(" #n ")" ::: "memory")
#define PG8_BAR __builtin_amdgcn_s_barrier()
#define PG8_SCHED __builtin_amdgcn_sched_barrier(0)
    int sc1 = 0x7F7F7F7F; asm volatile("" : "+v"(sc1));
    Unit cur, nxt; int ui = 0;
    if (!S.next(0, cur)) return;
    f32x4 acc[2][2][4][2];
#pragma unroll
    for (int a = 0; a < 2; ++a)
#pragma unroll
        for (int b = 0; b < 2; ++b)
#pragma unroll
            for (int m = 0; m < 4; ++m)
#pragma unroll
                for (int n = 0; n < 2; ++n) acc[a][b][m][n] = (f32x4){0.f, 0.f, 0.f, 0.f};
    using S2 = typename std::conditional<FP6, i32x2, bf16x8>::type;
    auto rd2v = [](const PG8_LAS unsigned char* p) -> S2 { return *(const PG8_LAS S2*)p; };
#define rd2 lds_rd64
    bf16x8 At[4], B0[2], B1[2]; S2 At2[4], B02[2], B12[2];
    const char* cA = S.a_base(cur); const char* cB = S.b_base(cur);
#pragma unroll
    for (int h = 0; h < 2; ++h)
#pragma unroll
        for (int i = 0; i < 2; ++i) { if constexpr (GATHER) vAc[h][i] = S.gather_off(cur, Rr[i] + HALF * h) + (unsigned)Cc[i] * 2u; else vAc[h][i] = (unsigned)(Rr[i] * K + Cc[i]) * 2u; vAn[h][i] = vAc[h][i]; }
    if constexpr (SP2) {
        PG8_STAGE(PG8_SB(0, 0), cB, voffB); PG8_STAGE(PG8_SB(0, 1), cB + hstep, voffB); PG8_STAGE_A(PG8_SA(0, 0), cA, vAc, 0); PG8_STAGE_A(PG8_SA(0, 1), cA, vAc, 1);
        if (wr == 1) PG8_BAR;
        PG8_WAIT_V(2); PG8_BAR;
        PG8_STAGE(PG8_SB(1, 0), cB + kstep, voffB); PG8_STAGE_A(PG8_SA(1, 0), cA + kstep, vAc, 0); PG8_STAGE(PG8_SB(1, 1), cB + hstep + kstep, voffB);
        PG8_WAIT_V(6); PG8_BAR;
    } else {
        PG8_STAGE(PG8_SB(0, 0), cB, voffB); PG8_STAGE_A(PG8_SA(0, 0), cA, vAc, 0); PG8_STAGE(PG8_SB(0, 1), cB + hstep, voffB); PG8_STAGE_A(PG8_SA(0, 1), cA, vAc, 1);
        if (wr == 1) PG8_BAR;
        PG8_WAIT_V(4); PG8_BAR;
        PG8_STAGE(PG8_SB(1, 0), cB + kstep, voffB); PG8_STAGE_A(PG8_SA(1, 0), cA + kstep, vAc, 0); PG8_STAGE(PG8_SB(1, 1), cB + hstep + kstep, voffB);
        PG8_WAIT_V(6); PG8_BAR;
    }
    for (;;) {
        const bool has_next = S.next(ui + 1, nxt);
        const char* nA = has_next ? S.a_base(nxt) : cA; const char* nB = has_next ? S.b_base(nxt) : cB;
        if constexpr (Epi::TAB_N > 0) { if (wid < Epi::TAB_N / 64) __builtin_amdgcn_global_load_lds((const unsigned*)E.tab_src(cur, tid), (PG8_LAS unsigned*)(lds + STAGE_BYTES + 1024 + (ui & 1) * 2048 + wid * 256), 4, 0, 0); }
        if constexpr (GATHER) { if (has_next && wid < 4) __builtin_amdgcn_global_load_lds((const unsigned*)S.tok_src(nxt, tid), (PG8_LAS unsigned*)(lds + STAGE_BYTES + wid * 256), 4, 0, 0); }
        for (int t = 0; t < nt; t += 2) {
            const bool last = (t == nt - 2);
            const char* a1 = cA + (size_t)(t + 1) * kstep;
            const char* a2 = last ? nA : cA + (size_t)(t + 2) * kstep; const char* b2 = last ? nB : cB + (size_t)(t + 2) * kstep;
            const char* a3 = a2 + kstep; const char* b3 = b2 + kstep;
            if constexpr (GATHER) { if (last && has_next) {
#pragma unroll
                for (int h = 0; h < 2; ++h)
#pragma unroll
                    for (int i = 0; i < 2; ++i) vAn[h][i] = *(const PG8_LAS unsigned*)(lds + STAGE_BYTES + 4 * (Rr[i] + HALF * h)) * (unsigned)(K * 2) + (unsigned)Cc[i] * 2u; } }
            unsigned v2[2][2];
#pragma unroll
            for (int h = 0; h < 2; ++h)
#pragma unroll
                for (int i = 0; i < 2; ++i) v2[h][i] = GATHER ? (last ? vAn[h][i] : vAc[h][i]) : vAc[0][i];
            if constexpr (SP2) {
            PG8_LDB(B0, 0, 0); PG8_LDB(B1, 0, 1); PG8_SCHED; PG8_LDA(At, 0, 0); PG8_STAGE_A(PG8_SA(1, 1), a1, vAc, 1);
            PG8_WAIT_V(8); PG8_WAIT_L(0); PG8_BAR; PG8_MMA(0, 0, At, B0); PG8_MMA(0, 1, At, B1); PG8_BAR; PG8_SCHED;
            PG8_LDA(At, 0, 1); PG8_STAGE(PG8_SB(0, 0), b2, voffB); PG8_STAGE(PG8_SB(0, 1), b2 + hstep, voffB); PG8_STAGE_A(PG8_SA(0, 0), a2, v2, 0);
            PG8_WAIT_V(8); PG8_WAIT_L(0); PG8_BAR; PG8_MMA(1, 0, At, B0); PG8_MMA(1, 1, At, B1); PG8_BAR; PG8_SCHED;
            PG8_LDB(B0, 1, 0); PG8_LDB(B1, 1, 1); PG8_SCHED; PG8_LDA(At, 1, 0); PG8_STAGE_A(PG8_SA(0, 1), a2, v2, 1);
            PG8_WAIT_V(8); PG8_WAIT_L(0); PG8_BAR; PG8_MMA(0, 0, At, B0); PG8_MMA(0, 1, At, B1); PG8_BAR; PG8_SCHED;
            PG8_LDA(At, 1, 1); PG8_STAGE(PG8_SB(1, 0), b3, voffB); PG8_STAGE(PG8_SB(1, 1), b3 + hstep, voffB); PG8_STAGE_A(PG8_SA(1, 0), a3, v2, 0);
            PG8_WAIT_V(8); PG8_WAIT_L(0); PG8_BAR; PG8_MMA(1, 0, At, B0); PG8_MMA(1, 1, At, B1); PG8_BAR; PG8_SCHED;
            } else {
            PG8_LDB(B0, 0, 0); PG8_SCHED; PG8_LDA(At, 0, 0); PG8_STAGE_A(PG8_SA(1, 1), a1, vAc, 1);
            PG8_WAIT_L(8); PG8_BAR; PG8_WAIT_L(0); PG8_MMA(0, 0, At, B0); PG8_BAR; PG8_SCHED;
            PG8_LDB(B1, 0, 1); PG8_STAGE(PG8_SB(0, 0), b2, voffB);
            PG8_BAR; PG8_WAIT_L(0); PG8_MMA(0, 1, At, B1); PG8_BAR;
            PG8_LDA(At, 0, 1); PG8_STAGE_A(PG8_SA(0, 0), a2, v2, 0);
            PG8_BAR; PG8_WAIT_L(0); PG8_MMA(1, 0, At, B0); PG8_BAR; PG8_SCHED;
            PG8_STAGE(PG8_SB(0, 1), b2 + hstep, voffB);
            PG8_WAIT_V(6); PG8_BAR; PG8_MMA(1, 1, At, B1); PG8_BAR;
            PG8_LDB(B0, 1, 0); PG8_SCHED; PG8_LDA(At, 1, 0); PG8_STAGE_A(PG8_SA(0, 1), a2, v2, 1);
            PG8_WAIT_L(8); PG8_BAR; PG8_WAIT_L(0); PG8_MMA(0, 0, At, B0); PG8_BAR; PG8_SCHED;
            PG8_LDB(B1, 1, 1); PG8_STAGE(PG8_SB(1, 0), b3, voffB);
            PG8_BAR; PG8_WAIT_L(0); PG8_MMA(0, 1, At, B1); PG8_BAR;
            PG8_LDA(At, 1, 1); PG8_STAGE_A(PG8_SA(1, 0), a3, v2, 0);
            PG8_BAR; PG8_WAIT_L(0); PG8_MMA(1, 0, At, B0); PG8_BAR; PG8_SCHED;
            PG8_STAGE(PG8_SB(1, 1), b3 + hstep, voffB);
            PG8_WAIT_V(6); PG8_BAR; PG8_MMA(1, 1, At, B1); PG8_BAR;
            }
        }
        if constexpr (ALIGN_EPI) { if (wr == 0) PG8_BAR; }
        if constexpr (FP8) asm volatile("s_nop 15\n\ts_nop 15" ::: "memory");
        E(acc, cur, wr, wc, fr, fq, (const PG8_LAS float*)(lds + STAGE_BYTES + 1024 + (ui & 1) * 2048));
        if (!has_next) break;
#pragma unroll
        for (int a = 0; a < 2; ++a)
#pragma unroll
            for (int b = 0; b < 2; ++b)
#pragma unroll
                for (int m = 0; m < 4; ++m)
#pragma unroll
                    for (int n = 0; n < 2; ++n) acc[a][b][m][n] = (f32x4){0.f, 0.f, 0.f, 0.f};
        cur = nxt; cA = nA; cB = nB; ++ui;
#pragma unroll
        for (int h = 0; h < 2; ++h)
#pragma unroll
            for (int i = 0; i < 2; ++i) vAc[h][i] = vAn[h][i];
        if constexpr (ALIGN_EPI) { if (wr == 1) PG8_BAR; }
    }
    PG8_WAIT_V(0);
    if constexpr (!ALIGN_EPI) { if (wr == 0) PG8_BAR; }
    PG8_BAR;
#undef rd2
#undef PG8_SA
#undef PG8_SB
#undef PG8_STAGE
#undef PG8_STAGE_A
#undef PG8_LDA
#undef PG8_LDB
#undef PG8_MMA
#undef PG8_WAIT_V
#undef PG8_WAIT_L
#undef PG8_BAR
#undef PG8_SCHED
}
}

#define XB_TMO      128
#define XB_XCNT(j)  (256  + 64 * (j))
#define XB_XSUB(j)  (1280 + 64 * (j))
#define XB_XGEN(j)  (2304 + 64 * (j))
#define XB_TOP      3328
#define XB_TOPGEN   3392
#define XCD_BAR_WORDS 3456
#define XB_SPIN_CAP (1u << 18)
__device__ __forceinline__ unsigned xb_ld(unsigned* p)              { return __hip_atomic_load(p, __ATOMIC_RELAXED, __HIP_MEMORY_SCOPE_AGENT); }
__device__ __forceinline__ unsigned xb_add(unsigned* p, unsigned v) { return __hip_atomic_fetch_add(p, v, __ATOMIC_RELAXED, __HIP_MEMORY_SCOPE_AGENT); }
__device__ __forceinline__ unsigned xb_xcc_id() { return (unsigned)__builtin_amdgcn_s_getreg((3 << 11) | 20) & 0xFu; }
#define XB_SPIN(cond, bar) do { unsigned _sp = 0; while (cond) { __builtin_amdgcn_s_sleep(1); \
    if ((++_sp & 255u) == 0u) { if (xb_ld(&(bar)[XB_TMO])) break; if (_sp > XB_SPIN_CAP) { atomicAdd(&(bar)[XB_TMO], 1u); break; } } } } while (0)
struct XcdBarrier { unsigned* bar; unsigned x; volatile LAS unsigned* st; unsigned expect; };
__device__ __forceinline__ XcdBarrier xcd_barrier_post(unsigned* bar, volatile LAS unsigned* st, unsigned expect, bool member) {
    XcdBarrier b; b.bar = bar; b.x = xb_xcc_id(); b.st = st; b.expect = expect;
    if (member && threadIdx.x == 0) (void)xb_add(&bar[XB_XCNT(b.x)], 1u);
    return b;
}
__device__ __forceinline__ void xcd_barrier_complete(unsigned* bar, unsigned x, unsigned G, unsigned& nloc, unsigned& nx) {
    unsigned sum, cnt, mine, sp = 0u;
    for (;;) {
        sum = 0u; cnt = 0u; mine = 0u;
#pragma unroll
        for (unsigned j = 0; j < 16; ++j) { const unsigned c = xb_ld(&bar[XB_XCNT(j)]); sum += c; cnt += (c > 0u) ? 1u : 0u; mine = (j == x) ? c : mine; }
        if (sum == G) break;
        __builtin_amdgcn_s_sleep(1);
        if ((++sp & 255u) == 0u) { if (xb_ld(&bar[XB_TMO])) break; if (sp > XB_SPIN_CAP) { atomicAdd(&bar[XB_TMO], 1u); break; } }
    }
    nloc = mine > 0u ? mine : 1u; nx = cnt > 0u ? cnt : 1u;
}
__device__ __forceinline__ void xcd_barrier(const XcdBarrier& b) {
    asm volatile("s_waitcnt vmcnt(0)" ::: "memory");
    __syncthreads();
    if (threadIdx.x == 0) {
        unsigned* bar = b.bar;
        __builtin_amdgcn_s_waitcnt(0);
        unsigned nloc = b.st[0], nx = b.st[1];
        if (nloc == 0u) { xcd_barrier_complete(bar, b.x, b.expect, nloc, nx); b.st[0] = nloc; b.st[1] = nx; }
        const unsigned old = xb_add(&bar[XB_XSUB(b.x)], 1u);
        const unsigned gen = old / nloc;
        if (old + 1u == (gen + 1u) * nloc) {
            __builtin_amdgcn_fence(__ATOMIC_RELEASE, "agent");
            asm volatile("s_waitcnt vmcnt(0)" ::: "memory");
            const unsigned og = xb_add(&bar[XB_TOP], 1u);
            const unsigned tg = og / nx;
            if (og + 1u == (tg + 1u) * nx) xb_add(&bar[XB_TOPGEN], 1u);
            else XB_SPIN(xb_ld(&bar[XB_TOPGEN]) == tg, bar);
            __builtin_amdgcn_fence(__ATOMIC_ACQUIRE, "agent");
            xb_add(&bar[XB_XGEN(b.x)], 1u);
            asm volatile("s_waitcnt vmcnt(0)" ::: "memory");
        } else {
            XB_SPIN(xb_ld(&bar[XB_XGEN(b.x)]) == gen, bar);
            __builtin_amdgcn_fence(__ATOMIC_ACQUIRE, "agent");
            asm volatile("s_waitcnt vmcnt(0)" ::: "memory");
        }
    }
    __syncthreads();
}

struct Frame {
    LAS unsigned char* lds;
    volatile LAS unsigned* MISC;
    unsigned* ctl;
    int tid, lane, wave, G;
    int bid, nb;
    const float *x, *c, *ctx, *c_ctx, *w_mod, *b_mod, *g_mix, *w_in, *conv_a_w, *conv_a_b, *lru_w_r, *lru_b_r, *lru_w_i, *lru_b_i, *lru_lam, *conv_b_w, *g_out_a, *g_out_b, *w_out,
        *g_ffn, *w_router, *b_router, *w_gate, *b_gate, *w_up, *b_up, *w_down, *b_down, *g_final;
    float* out;
    float* MOD; bf16_t *WG, *WIN, *WOUT, *XN, *Gb, *XA, *BB, *P, *Y, *WGU, *WDN, *H, *O, *HS;
    f32x2* AGG; float* HIN; unsigned* ER; int* STOK; float* SLW; unsigned* CNT; unsigned char* XN2;
};

struct EpiInProj {
    static constexpr bool PERM = true; static constexpr int TAB_N = 0;
    __device__ __forceinline__ const float* tab_src(const pg8::Unit&, int) const { return nullptr; }
    unsigned char* ws; bf16_t* P;
    __device__ __forceinline__ void operator()(const f32x4 (&acc)[2][2][4][2], const pg8::Unit& u, int wr, int wc, int fr, int fq, const LAS float* tab) const {
        const int row0 = u.pm * 256 + wr * 64 + fr, cl = wc * 32 + 8 * fq, pn = u.pn;
        if (pn < 12) {
            const size_t woff = pn < 4 ? WS_G : (pn < 8 ? WS_XA : WS_BB); bf16_t* dst = (bf16_t*)(ws + woff); const int colt = (pn & 3) * 256;
#pragma unroll
            for (int ai = 0; ai < 2; ++ai)
#pragma unroll
                for (int m = 0; m < 4; ++m) { bf16_t* rowp = dst + (size_t)(row0 + ai * 128 + m * 16) * DA + colt + cl;
#pragma unroll
                    for (int bj = 0; bj < 2; ++bj) { f32x4 v0 = acc[ai][bj][m][0], v1 = acc[ai][bj][m][1];
                        if (pn < 4) {
#pragma unroll
                            for (int j = 0; j < 4; ++j) { v0[j] = gelu_tanh(v0[j]); v1[j] = gelu_tanh(v1[j]); } }
                        u32x4 w; w.x = cvt_pk_bf16(v0[0], v0[1]); w.y = cvt_pk_bf16(v0[2], v0[3]); w.z = cvt_pk_bf16(v1[0], v1[1]); w.w = cvt_pk_bf16(v1[2], v1[3]);
                        *(u32x4*)(rowp + bj * 128) = w; } }
        } else {
            const int j = pn - 12;
#pragma unroll
            for (int ai = 0; ai < 2; ++ai)
#pragma unroll
                for (int m = 0; m < 4; ++m) { bf16_t* rowp = P + (size_t)(row0 + ai * 128 + m * 16) * DA + j * 128 + cl;
                    const f32x4 v0 = acc[ai][0][m][0] * acc[ai][1][m][0], v1 = acc[ai][0][m][1] * acc[ai][1][m][1];
                    u32x4 w; w.x = cvt_pk_bf16(v0[0], v0[1]); w.y = cvt_pk_bf16(v0[2], v0[3]); w.z = cvt_pk_bf16(v1[0], v1[1]); w.w = cvt_pk_bf16(v1[2], v1[3]);
                    *(u32x4*)rowp = w; }
        }
    }
};
struct EpiOutProj {
    static constexpr bool PERM = true; static constexpr int TAB_N = 0;
    __device__ __forceinline__ const float* tab_src(const pg8::Unit&, int) const { return nullptr; }
    bf16_t* MX; const float* MOD;
    __device__ __forceinline__ void operator()(const f32x4 (&acc)[2][2][4][2], const pg8::Unit& u, int wr, int wc, int fr, int fq, const LAS float* tab) const {
        const int row0 = u.pm * 256 + wr * 64 + fr, col0 = u.pn * 256 + wc * 32 + 8 * fq, b = u.pm >> 5;
        f32x4 gt[2][2];
#pragma unroll
        for (int bj = 0; bj < 2; ++bj)
#pragma unroll
            for (int n = 0; n < 2; ++n) gt[bj][n] = *(const f32x4*)(MOD + b * 12288 + 4096 + col0 + bj * 128 + 4 * n);
#pragma unroll
        for (int ai = 0; ai < 2; ++ai)
#pragma unroll
            for (int m = 0; m < 4; ++m) { bf16_t* rowp = MX + (size_t)(row0 + ai * 128 + m * 16) * D + col0;
#pragma unroll
                for (int bj = 0; bj < 2; ++bj) { const f32x4 v0 = gt[bj][0] * acc[ai][bj][m][0], v1 = gt[bj][1] * acc[ai][bj][m][1];
                    u32x4 w; w.x = cvt_pk_bf16(v0[0], v0[1]); w.y = cvt_pk_bf16(v0[2], v0[3]); w.z = cvt_pk_bf16(v1[0], v1[1]); w.w = cvt_pk_bf16(v1[2], v1[3]);
                    *(u32x4*)(rowp + bj * 128) = w; } }
    }
};
struct EpiGU {
    static constexpr bool PERM = true; static constexpr int TAB_N = 256;
    bf16_t* H; const float *b_gate, *b_up;
    __device__ __forceinline__ const float* tab_src(const pg8::Unit& u, int t) const { return (t < 128 ? b_gate : b_up) + u.e * FF + u.pn * 128 + (t & 127); }
    __device__ __forceinline__ void operator()(const f32x4 (&acc)[2][2][4][2], const pg8::Unit& u, int wr, int wc, int fr, int fq, const LAS float* tab) const {
        const int row0 = u.pm * 256 + wr * 64 + fr, colg = u.pn * 128 + wc * 32 + 8 * fq;
        f32x4 bg[2], bu[2];
#pragma unroll
        for (int n = 0; n < 2; ++n) { bg[n] = *(const LAS f32x4*)(tab + wc * 32 + 8 * fq + 4 * n); bu[n] = *(const LAS f32x4*)(tab + 128 + wc * 32 + 8 * fq + 4 * n); }
#pragma unroll
        for (int ai = 0; ai < 2; ++ai)
#pragma unroll
            for (int m = 0; m < 4; ++m) { unsigned char* rowp = (unsigned char*)H + (size_t)(row0 + ai * 128 + m * 16) * FF + colg; f32x4 a[2];
#pragma unroll
                for (int n = 0; n < 2; ++n)
#pragma unroll
                    for (int j = 0; j < 4; j += 2) {
                        f32x2 g = (f32x2){acc[ai][0][m][n][j], acc[ai][0][m][n][j + 1]} * GU_INV + (f32x2){bg[n][j], bg[n][j + 1]};
                        f32x2 up = (f32x2){acc[ai][1][m][n][j], acc[ai][1][m][n][j + 1]} * GU_INV + (f32x2){bu[n][j], bu[n][j + 1]};
                        g.x = fminf(g.x, 7.0f); g.y = fminf(g.y, 7.0f); up.x = __builtin_amdgcn_fmed3f(up.x, -7.0f, 7.0f); up.y = __builtin_amdgcn_fmed3f(up.y, -7.0f, 7.0f);
                        const f32x2 t = g * (-1.702f * 1.44269504089f);
                        f32x2 d = (f32x2){__builtin_amdgcn_exp2f(t.x), __builtin_amdgcn_exp2f(t.y)} + 1.0f;
                        const f32x2 sg = {__builtin_amdgcn_rcpf(d.x), __builtin_amdgcn_rcpf(d.y)};
                        const f32x2 h = (up + 1.0f) * g * sg;
                        a[n][j] = h.x; a[n][j + 1] = h.y; }
                u32x2 w; w.x = pk4_fp8(a[0][0], a[0][1], a[0][2], a[0][3]); w.y = pk4_fp8(a[1][0], a[1][1], a[1][2], a[1][3]);
                *(u32x2*)rowp = w; }
    }
};
struct EpiDown {
    static constexpr bool PERM = true; static constexpr int TAB_N = 512;
    bf16_t* O; const float* b_down; const float* SLW; const LAS int* cnt;
    __device__ __forceinline__ const float* tab_src(const pg8::Unit& u, int t) const {
        if (t < 256) return b_down + u.e * D + u.pn * 256 + t;
        const int r = t - 256, nvalid = __builtin_amdgcn_readfirstlane(cnt[u.e]) - u.mt * 256; return SLW + (size_t)u.e * CAP + (r < nvalid ? u.mt * 256 + r : 0); }
    __device__ __forceinline__ void operator()(const f32x4 (&acc)[2][2][4][2], const pg8::Unit& u, int wr, int wc, int fr, int fq, const LAS float* tab) const {
        const int row0 = u.pm * 256 + wr * 64 + fr, cl = wc * 32 + 8 * fq, nvalid = __builtin_amdgcn_readfirstlane(cnt[u.e]) - u.mt * 256;
        f32x4 bd[2][2]; float wsl[2][4];
#pragma unroll
        for (int bj = 0; bj < 2; ++bj)
#pragma unroll
            for (int n = 0; n < 2; ++n) bd[bj][n] = *(const LAS f32x4*)(tab + bj * 128 + cl + 4 * n);
#pragma unroll
        for (int ai = 0; ai < 2; ++ai)
#pragma unroll
            for (int m = 0; m < 4; ++m) { const int r = ai * 128 + wr * 64 + m * 16 + fr; const float w = tab[256 + r]; wsl[ai][m] = r < nvalid ? w : 0.f; }
#pragma unroll
        for (int ai = 0; ai < 2; ++ai)
#pragma unroll
            for (int m = 0; m < 4; ++m) { const int r = ai * 128 + wr * 64 + m * 16 + fr; const float w8 = wsl[ai][m];
                unsigned char* rowp = (unsigned char*)O + (size_t)(row0 + ai * 128 + m * 16) * D + u.pn * 256 + cl;
#pragma unroll
                for (int bj = 0; bj < 2; ++bj) { const f32x4 v0 = (acc[ai][bj][m][0] * W8_INV + bd[bj][0]) * w8, v1 = (acc[ai][bj][m][1] * W8_INV + bd[bj][1]) * w8;
                    u32x2 w; w.x = pk4_fp8(v0[0] * O8_SCALE, v0[1] * O8_SCALE, v0[2] * O8_SCALE, v0[3] * O8_SCALE); w.y = pk4_fp8(v1[0] * O8_SCALE, v1[1] * O8_SCALE, v1[2] * O8_SCALE, v1[3] * O8_SCALE);
                    *(u32x2*)(rowp + bj * 128) = w; } }
    }
};

struct DenseOrder {
    int nM, nN, nwg, G, c, nX; const char *A, *Bt; size_t tstep;
    __device__ __forceinline__ bool next(int i, pg8::Unit& u) const {
        long L = (long)i * G + c; if (L >= nwg + nX) return false;
        u.e = 0; u.mt = 0;
        if (L < nX) { u.pm = 64 + (int)L / 4; u.pn = 4 + (int)L % 4; return true; }
        L -= nX;
        const int wgid = pg8::xcd_remap((int)L, nwg);
        const int nig = pg8::WGM * nN, gid = wgid / nig, fm = gid * pg8::WGM, gsz = (nM - fm) < pg8::WGM ? (nM - fm) : pg8::WGM;
        u.pm = fm + ((wgid % nig) % gsz); u.pn = (wgid % nig) / gsz; return true;
    }
    __device__ __forceinline__ const char* a_base(const pg8::Unit& u) const { return A + (size_t)u.pm * tstep; }
    __device__ __forceinline__ const char* b_base(const pg8::Unit& u) const { return Bt + (size_t)u.pn * tstep; }
    __device__ __forceinline__ unsigned gather_off(const pg8::Unit&, int) const { return 0u; }
    __device__ __forceinline__ const int* tok_src(const pg8::Unit&, int) const { return nullptr; }
};
struct MoeOrder {
    const LAS int* tab; int NT, G, c, nwg; const char *A, *Bt; const int* STOK; size_t bstep_e, tstep; bool gather;
    __device__ __forceinline__ bool next(int i, pg8::Unit& u) const {
        const int x = c & 7, npx = NT / 4, ng = NT / npx, mgn = 8 / ng, ngroup = x % ng, mgroup = x / ng, nbx = (G - x + 7) >> 3, q = i * nbx + (c >> 3);
        const int til = q / npx, ti = til * mgn + mgroup; if (ti >= nwg / NT) return false;
        u.pn = ngroup * npx + (q - til * npx);
        int e = 0;
        for (; e < NE - 1; ++e) if (ti < __builtin_amdgcn_readfirstlane(tab[16 + e + 1])) break;
        u.e = e; u.mt = ti - __builtin_amdgcn_readfirstlane(tab[16 + e]); u.pm = __builtin_amdgcn_readfirstlane(tab[64 + e]) + u.mt; return true;
    }
    __device__ __forceinline__ const char* a_base(const pg8::Unit& u) const { return gather ? A : A + (size_t)u.pm * tstep; }
    __device__ __forceinline__ const char* b_base(const pg8::Unit& u) const { return Bt + (size_t)u.e * bstep_e + (size_t)u.pn * tstep; }
    __device__ __forceinline__ const int* tok_src(const pg8::Unit& u, int row) const { const int idx = u.mt * 256 + row; return STOK + (size_t)u.e * CAP + (idx < __builtin_amdgcn_readfirstlane(tab[128 + u.e]) ? idx : 0); }
    __device__ __forceinline__ unsigned gather_off(const pg8::Unit& u, int row) const { return (unsigned)(*tok_src(u, row)) * (unsigned)D; }
};

__device__ __forceinline__ void transpose_item(const float* W, int K, int N, int k0, int n0, bf16_t* WT, int orow0, LAS float* scr, int lane) {
#pragma unroll 8
    for (int i = 0; i < 32; ++i) { const int kk = 2 * i + (lane >> 5); scr[kk * 33 + (lane & 31)] = W[(size_t)(k0 + kk) * N + n0 + (lane & 31)]; }
    asm volatile("s_waitcnt lgkmcnt(0)" ::: "memory");
    const int c = lane & 7;
#pragma unroll
    for (int j = 0; j < 4; ++j) { const int n = (lane >> 3) + 8 * j; const LAS float* s = scr + (8 * c) * 33 + n;
        u32x4 o; o.x = cvt_pk_bf16(s[0 * 33], s[1 * 33]); o.y = cvt_pk_bf16(s[2 * 33], s[3 * 33]); o.z = cvt_pk_bf16(s[4 * 33], s[5 * 33]); o.w = cvt_pk_bf16(s[6 * 33], s[7 * 33]);
        *(u32x4*)(WT + (size_t)(orow0 + n) * K + k0 + 8 * c) = o; }
    asm volatile("s_waitcnt lgkmcnt(0)" ::: "memory");
}

__device__ __forceinline__ void transpose_item_fp8(const float* W, int K, int N, int k0, int n0, unsigned char* WT, int orow0, LAS float* scr, int lane) {
#pragma unroll 8
    for (int i = 0; i < 64; ++i) { const int kk = 2 * i + (lane >> 5); scr[kk * 33 + (lane & 31)] = W[(size_t)(k0 + kk) * N + n0 + (lane & 31)]; }
    asm volatile("s_waitcnt lgkmcnt(0)" ::: "memory");
    const int c = lane & 7;
#pragma unroll
    for (int j = 0; j < 4; ++j) { const int n = (lane >> 3) + 8 * j; const LAS float* s = scr + (16 * c) * 33 + n;
        u32x4 o; o.x = pk4_fp8(s[0 * 33] * W8_SCALE, s[1 * 33] * W8_SCALE, s[2 * 33] * W8_SCALE, s[3 * 33] * W8_SCALE); o.y = pk4_fp8(s[4 * 33] * W8_SCALE, s[5 * 33] * W8_SCALE, s[6 * 33] * W8_SCALE, s[7 * 33] * W8_SCALE);
        o.z = pk4_fp8(s[8 * 33] * W8_SCALE, s[9 * 33] * W8_SCALE, s[10 * 33] * W8_SCALE, s[11 * 33] * W8_SCALE); o.w = pk4_fp8(s[12 * 33] * W8_SCALE, s[13 * 33] * W8_SCALE, s[14 * 33] * W8_SCALE, s[15 * 33] * W8_SCALE);
        *(u32x4*)(WT + (size_t)(orow0 + n) * K + k0 + 16 * c) = o; }
    asm volatile("s_waitcnt lgkmcnt(0)" ::: "memory");
}

__device__ __forceinline__ void ph0(Frame& F) {
    LAS float* sc = (LAS float*)(F.lds + 67584);
    LAS float* red = (LAS float*)(F.lds + 67584 + 24576);
    LAS float* scr = (LAS float*)(F.lds + F.wave * 8448);
    constexpr int I_IN = (D / 64) * (NIN / 32), I_OUT = (D / 64) * (D / 32), I_G = 32 * 8, NJOB = 128 + (I_IN + I_OUT + I_G) / 32;
    bool have_sc = false;
    for (;;) {
        __syncthreads();
        if (F.tid == 0) F.MISC[12] = atomicAdd(F.ctl + CW_Q0, 1u);
        __syncthreads();
        const int job = __builtin_amdgcn_readfirstlane((int)F.MISC[12]);
        if (job >= NJOB) break;
        if (job < 128) {
            if (!have_sc) { for (int idx = F.tid; idx < 3 * D; idx += 512) { const int r = idx >> 11, k = idx & 2047; const float v = r < 2 ? F.c[r * D + k] : F.c_ctx[k]; sc[idx] = v * fsigmoid(v); } have_sc = true; __syncthreads(); }
            const int cg = job, sub = F.lane / 24, c4 = F.lane % 24;
            f32x4 a0 = {0.f, 0.f, 0.f, 0.f}, a1 = a0, a2 = a0;
            if (F.lane < 48) {
                const float* wp = F.w_mod + (size_t)(F.wave * 2 + sub) * 12288 + cg * 96 + c4 * 4;
                for (int it = 0; it < 128; it += 8) {
                    f32x4 wv[8];
#pragma unroll
                    for (int u = 0; u < 8; ++u) wv[u] = __builtin_nontemporal_load((const f32x4*)(wp + (size_t)(it + u) * 16 * 12288));
#pragma unroll
                    for (int u = 0; u < 8; ++u) { const int k = (it + u) * 16 + F.wave * 2 + sub; a0 += sc[k] * wv[u]; a1 += sc[D + k] * wv[u]; a2 += sc[2 * D + k] * wv[u]; }
                }
                LAS float* rp = red + (F.wave * 2 + sub) * 288 + c4 * 4;
                *(LAS f32x4*)(rp) = a0; *(LAS f32x4*)(rp + 96) = a1; *(LAS f32x4*)(rp + 192) = a2;
            }
            __syncthreads();
            if (F.tid < 288) { const int r = F.tid / 96, cc = F.tid % 96; float s = F.b_mod[cg * 96 + cc];
#pragma unroll
                for (int p = 0; p < 16; ++p) s += red[p * 288 + r * 96 + cc];
                F.MOD[r * 12288 + cg * 96 + cc] = s; }
        } else {
#pragma unroll 1
            for (int q = 0; q < 4; ++q) {
                int r = (job - 128) * 32 + q * 8 + F.wave;
                if (r < I_IN) { const int nblk = NIN / 32, k0 = 64 * (r / nblk), n0 = 32 * (r % nblk); int orow0;
                    if (n0 < 3072) orow0 = n0; else if (n0 < 4096) { const int qq = n0 - 3072; orow0 = 3072 + (qq >> 7) * 256 + (qq & 127); } else { const int qq = n0 - 4096; orow0 = 3072 + (qq >> 7) * 256 + 128 + (qq & 127); }
                    transpose_item(F.w_in, D, NIN, k0, n0, F.WIN, orow0, scr, F.lane); continue; }
                r -= I_IN;
                if (r < I_OUT) { const int nblk = D / 32, k0 = 64 * (r / nblk), n0 = 32 * (r % nblk); transpose_item(F.w_out, D, D, k0, n0, F.WOUT, n0, scr, F.lane); continue; }
                r -= I_OUT;
                { const int mat = r >> 3, sub = r & 7, type = mat >> 4, dh = mat & 15; const int k0 = 64 * (sub >> 2), n0 = 32 * (sub & 3);
                  const float* W = (type ? F.lru_w_i : F.lru_w_r) + (size_t)dh * 16384; transpose_item(W, 128, 128, k0, n0, F.WG + (size_t)(type * 16 + dh) * 16384, n0, scr, F.lane); }
            }
        }
    }
}

struct CvItem { const GAS float* W; GAS unsigned char* WT; };
typedef float f32x16 __attribute__((ext_vector_type(16)));
typedef unsigned u32x6 __attribute__((ext_vector_type(6)));
constexpr int CV6_NSTRIP = 2 * 32 * 64, CV6_FQ_PITCH = 1040, CV6_TILE_BYTES = 4 * CV6_FQ_PITCH * 4;
__device__ __forceinline__ u32x6 cvt_fp6_32(const float (&v)[32], const float scale) {
    f32x16 p, q;
#pragma unroll
    for (int i = 0; i < 16; ++i) { p[i] = v[i] * scale; q[i] = v[16 + i] * scale; }
    return __builtin_amdgcn_cvt_scalef32_2xpk16_fp6_f32(p, q, 1.0f);
}
__device__ __forceinline__ CvItem cv6_decode(Frame& F, int strip, int kt) {
    const int which = strip >> 11, e = (strip >> 6) & 31, n0 = 32 * (strip & 63);
    const unsigned long long m0 = which == 0 ? ~0ull : 0ull;
    const unsigned long long wsel = ((unsigned long long)F.w_gate & m0) | ((unsigned long long)F.w_up & ~m0);
    const int orow0 = (n0 >> 7) * 256 + which * 128 + (n0 & 127);
    CvItem c; c.W = (const GAS float*)wsel + (size_t)e * D * FF + (size_t)(128 * kt) * 2048 + n0;
    c.WT = (GAS unsigned char*)F.WGU + (size_t)e * 4096 * D + (size_t)orow0 * 2048 + kt * 128;
    return c;
}
__device__ __forceinline__ void cv6_load(const CvItem& c, int lane, f32x4 (&v)[16]) {
    const GAS float* p = c.W + (size_t)(lane >> 3) * 2048 + 4 * (lane & 7);
#pragma unroll
    for (int i = 0; i < 16; ++i) v[i] = __builtin_nontemporal_load((const GAS f32x4*)(p + (size_t)(8 * i) * 2048));
}
__device__ __forceinline__ void cv6_store(const CvItem& c, int lane, const f32x4 (&v)[16], LAS float* scr) {
    const int r8 = lane >> 3, c4 = lane & 7;
    LAS float* wb = scr + (r8 >> 2) * 128 + 4 * c4 + (r8 & 3);
#pragma unroll
    for (int i = 0; i < 16; ++i)
#pragma unroll
        for (int nn = 0; nn < 4; ++nn) wb[(i >> 2) * CV6_FQ_PITCH + 2 * (i & 3) * 128 + 32 * nn] = v[i][nn];
    asm volatile("s_waitcnt lgkmcnt(0)" ::: "memory");
#pragma unroll
    for (int rd = 0; rd < 2; ++rd) {
        const int npp = 16 * rd + (lane >> 2), fq = lane & 3;
        const LAS float* rb = scr + fq * CV6_FQ_PITCH + 4 * npp;
        float f[32];
#pragma unroll
        for (int j = 0; j < 8; ++j) { const f32x4 t = *(const LAS f32x4*)(rb + j * 128); f[4 * j] = t.x; f[4 * j + 1] = t.y; f[4 * j + 2] = t.z; f[4 * j + 3] = t.w; }
        const u32x6 pk = cvt_fp6_32(f, W8_SCALE);
        const unsigned lo4 = (unsigned)__builtin_amdgcn_update_dpp(0, (int)pk[4], 0x114, 0xf, 0xf, false), lo5 = (unsigned)__builtin_amdgcn_update_dpp(0, (int)pk[5], 0x114, 0xf, 0xf, false);
        const unsigned hi4 = (unsigned)__builtin_amdgcn_update_dpp(0, (int)pk[4], 0x104, 0xf, 0xf, false), hi5 = (unsigned)__builtin_amdgcn_update_dpp(0, (int)pk[5], 0x104, 0xf, 0xf, false);
        const bool odd = (npp & 1) != 0;
        const int na = odd ? npp - 1 : npp, nb = odd ? npp : npp + 1;
        GAS unsigned char* oa = c.WT + (size_t)(4 * (na & 7) + (na >> 3)) * 2048 + 16 * fq + (odd ? 64 : 0);
        GAS unsigned char* ob = c.WT + (size_t)(4 * (nb & 7) + (nb >> 3)) * 2048 + 16 * fq + (odd ? 0 : 64);
        const u32x4 f1 = {pk[0], pk[1], pk[2], pk[3]}, slo = {lo4, lo5, lo4, lo5}, shi = {hi4, hi5, hi4, hi5};
        __builtin_nontemporal_store(odd ? slo : f1, (GAS u32x4*)oa);
        __builtin_nontemporal_store(odd ? f1 : shi, (GAS u32x4*)ob);
    }
    asm volatile("s_waitcnt lgkmcnt(0)" ::: "memory");
}
__device__ __forceinline__ int cv6_claim(Frame& F) { int s = 0; if (F.lane == 0) s = (int)atomicAdd(F.ctl + CW_QCV6, 1u); return __builtin_amdgcn_readfirstlane(s); }
__device__ __forceinline__ void ph_expert_conv6(Frame& F) {
    LAS float* scr = (LAS float*)(F.lds + F.wave * CV6_TILE_BYTES);
    int sc = cv6_claim(F), kb = 0;
    if (sc >= CV6_NSTRIP) return;
    f32x4 va[16], vb[16];
    cv6_load(cv6_decode(F, sc, kb), F.lane, va);
    for (;;) {
        int s1 = sc, k1 = kb + 1; if (k1 == 16) { s1 = cv6_claim(F); k1 = 0; }
        const bool h1 = s1 < CV6_NSTRIP;
        cv6_load(cv6_decode(F, h1 ? s1 : sc, h1 ? k1 : kb), F.lane, vb);
        cv6_store(cv6_decode(F, sc, kb), F.lane, va, scr);
        if (!h1) break;
        int s2 = s1, k2 = k1 + 1; if (k2 == 16) { s2 = cv6_claim(F); k2 = 0; }
        const bool h2 = s2 < CV6_NSTRIP;
        cv6_load(cv6_decode(F, h2 ? s2 : s1, h2 ? k2 : k1), F.lane, va);
        cv6_store(cv6_decode(F, s1, k1), F.lane, vb, scr);
        if (!h2) break;
        sc = s2; kb = k2;
    }
}

constexpr int CV_PK = 132, CV_TILE_BYTES = 8 * CV_PK * 4, CV_NSTRIP = 32 * 64, CV_KB = 16;
__device__ __forceinline__ CvItem cv_decode(Frame& F, int strip, int kb) {
    const int which = 2, e = (strip >> 6) & 31, n0 = 32 * (strip & 63), k0 = 128 * kb;
    const unsigned long long m0 = which == 0 ? ~0ull : 0ull, m1 = which == 1 ? ~0ull : 0ull, m2 = which == 2 ? ~0ull : 0ull;
    const unsigned long long wsel = ((unsigned long long)F.w_gate & m0) | ((unsigned long long)F.w_up & m1) | ((unsigned long long)F.w_down & m2);
    const unsigned long long osel = ((unsigned long long)F.WGU & (m0 | m1)) | ((unsigned long long)F.WDN & m2);
    const int orow0 = which == 2 ? n0 : (n0 >> 7) * 256 + which * 128 + (n0 & 127);
    const size_t ebytes = which == 2 ? (size_t)D * FF : (size_t)4096 * D;
    CvItem c; c.W = (const GAS float*)wsel + (size_t)e * D * FF + (size_t)k0 * 2048 + n0;
    c.WT = (GAS unsigned char*)osel + (size_t)e * ebytes + (size_t)orow0 * 2048 + k0;
    return c;
}
__device__ __forceinline__ void cv_load(const CvItem& c, int lane, f32x4 (&v)[16]) {
    const GAS float* p = c.W + (size_t)(lane >> 3) * 2048 + 4 * (lane & 7);
#pragma unroll
    for (int i = 0; i < 16; ++i) v[i] = __builtin_nontemporal_load((const GAS f32x4*)(p + (size_t)(8 * i) * 2048));
}
__device__ __forceinline__ void cv_store(const CvItem& c, int lane, const f32x4 (&v)[16], LAS float* scr) {
    LAS unsigned* sb = (LAS unsigned*)scr;
    const int r8 = lane >> 3, c4 = lane & 7;
#pragma unroll
    for (int i = 0; i < 16; ++i) { const f32x4 w = v[i] * W8_SCALE; sb[c4 * CV_PK + 8 * i + r8] = pk4_fp8(w.x, w.y, w.z, w.w); }
    asm volatile("s_waitcnt lgkmcnt(0)" ::: "memory");
    const int n4 = lane >> 3, kb = lane & 7;
    u32x4 dq[4];
#pragma unroll
    for (int g = 0; g < 4; ++g) dq[g] = *(const LAS u32x4*)(sb + n4 * CV_PK + 16 * kb + 4 * g);
    u32x4 o[4];
#pragma unroll
    for (int g = 0; g < 4; ++g) {
        const unsigned lo01 = __builtin_amdgcn_perm(dq[g].y, dq[g].x, 0x05010400u), hi01 = __builtin_amdgcn_perm(dq[g].y, dq[g].x, 0x07030602u);
        const unsigned lo23 = __builtin_amdgcn_perm(dq[g].w, dq[g].z, 0x05010400u), hi23 = __builtin_amdgcn_perm(dq[g].w, dq[g].z, 0x07030602u);
        o[0][g] = __builtin_amdgcn_perm(lo23, lo01, 0x05040100u); o[1][g] = __builtin_amdgcn_perm(lo23, lo01, 0x07060302u);
        o[2][g] = __builtin_amdgcn_perm(hi23, hi01, 0x05040100u); o[3][g] = __builtin_amdgcn_perm(hi23, hi01, 0x07060302u);
    }
#pragma unroll
    for (int j = 0; j < 4; ++j) __builtin_nontemporal_store(o[j], (GAS u32x4*)(c.WT + (size_t)(4 * n4 + j) * 2048 + 16 * kb));
    asm volatile("s_waitcnt lgkmcnt(0)" ::: "memory");
}
__device__ __forceinline__ int cv_claim(Frame& F) { int s = 0; if (F.lane == 0) s = (int)atomicAdd(F.ctl + CW_QCV, 1u); return __builtin_amdgcn_readfirstlane(s); }
__device__ __forceinline__ void ph_expert_conv(Frame& F) {
    LAS float* scr = (LAS float*)(F.lds + F.wave * CV6_TILE_BYTES);
    int sc = cv_claim(F), kb = 0;
    if (sc >= CV_NSTRIP) return;
    f32x4 va[16], vb[16];
    cv_load(cv_decode(F, sc, kb), F.lane, va);
    for (;;) {
        int s1 = sc, k1 = kb + 1; if (k1 == CV_KB) { s1 = cv_claim(F); k1 = 0; }
        const bool h1 = s1 < CV_NSTRIP;
        cv_load(cv_decode(F, h1 ? s1 : sc, h1 ? k1 : kb), F.lane, vb);
        cv_store(cv_decode(F, sc, kb), F.lane, va, scr);
        if (!h1) break;
        int s2 = s1, k2 = k1 + 1; if (k2 == CV_KB) { s2 = cv_claim(F); k2 = 0; }
        const bool h2 = s2 < CV_NSTRIP;
        cv_load(cv_decode(F, h2 ? s2 : s1, h2 ? k2 : k1), F.lane, va);
        cv_store(cv_decode(F, s1, k1), F.lane, vb, scr);
        if (!h2) break;
        sc = s2; kb = k2;
    }
}

constexpr int AT_STRIDE = 4112;
__device__ __forceinline__ void ph1(Frame& F) {
    LAS float* Ac = (LAS float*)F.lds; LAS float* Bc = Ac + D;
    const int gw = F.bid * 8 + F.wave, NGW = F.nb * 8;
    for (int seg = 0; seg < 3; ++seg) {
        __syncthreads();
        for (int cc = F.tid; cc < D; cc += 512) { const float sh = F.MOD[seg * 12288 + cc], sl = F.MOD[seg * 12288 + D + cc]; Ac[cc] = F.g_mix[cc] * (1.0f + sl); Bc[cc] = sh; }
        __syncthreads();
        if (seg < 2) {
            const float* in = F.x + (size_t)seg * SEQ * D; bf16_t* outp = F.XN + (size_t)(seg * SEQ) * D;
            for (int m = gw; m < SEQ; m += NGW) {
                const f32x4* xr = (const f32x4*)(in + (size_t)m * D) + F.lane; f32x4 v[8]; float s = 0.f;
#pragma unroll
                for (int j = 0; j < 8; ++j) { v[j] = __builtin_nontemporal_load(xr + 64 * j); s += (v[j].x * v[j].x + v[j].y * v[j].y) + (v[j].z * v[j].z + v[j].w * v[j].w); }
                const float rstd = 1.0f / sqrtf(wave_sum(s) * (1.0f / D) + EPS);
                unsigned long long* o8 = (unsigned long long*)(outp + (size_t)m * D) + F.lane;
#pragma unroll
                for (int j = 0; j < 8; ++j) { const f32x4 a = *(const LAS f32x4*)(Ac + 4 * (F.lane + 64 * j)), b = *(const LAS f32x4*)(Bc + 4 * (F.lane + 64 * j)); const f32x4 o = v[j] * rstd * a + b;
                    o8[64 * j] = (unsigned long long)cvt_pk_bf16(o.x, o.y) | ((unsigned long long)cvt_pk_bf16(o.z, o.w) << 32); }
            }
        } else {
            LAS unsigned char* AT = F.lds + 16384; LAS float* RED = (LAS float*)(F.lds + 16384 + 16 * AT_STRIDE + 256);
            for (int u = F.bid; u < 256; u += F.nb) {
                const int rg = u >> 3, cg = u & 7;
                __syncthreads();
#pragma unroll 1
                for (int rr = 0; rr < 2; ++rr) { const int r = F.wave * 2 + rr;
                    const f32x4* xr = (const f32x4*)(F.ctx + (size_t)(16 * rg + r) * D) + F.lane; f32x4 v[8]; float s = 0.f;
#pragma unroll
                    for (int j = 0; j < 8; ++j) { v[j] = xr[64 * j]; s += (v[j].x * v[j].x + v[j].y * v[j].y) + (v[j].z * v[j].z + v[j].w * v[j].w); }
                    const float rstd = 1.0f / sqrtf(wave_sum(s) * (1.0f / D) + EPS);
#pragma unroll
                    for (int j = 0; j < 8; ++j) { const f32x4 a = *(const LAS f32x4*)(Ac + 4 * (F.lane + 64 * j)), b = *(const LAS f32x4*)(Bc + 4 * (F.lane + 64 * j)); const f32x4 o = v[j] * rstd * a + b;
                        u32x2 w; w.x = cvt_pk_bf16(o.x, o.y); w.y = cvt_pk_bf16(o.z, o.w); *(LAS u32x2*)(AT + r * AT_STRIDE + 8 * (F.lane + 64 * j)) = w; } }
                __syncthreads();
                const int c16 = F.lane & 15, q = F.lane >> 4;
                f32x4 acc[8];
#pragma unroll
                for (int n = 0; n < 8; ++n) acc[n] = (f32x4){0.f, 0.f, 0.f, 0.f};
                const bf16_t* wb = F.WIN + (size_t)(DA + 128 * cg + c16) * D + 256 * F.wave + 8 * q;
#pragma unroll 2
                for (int ks = 0; ks < 8; ++ks) {
                    const bf16x8 af = *(const LAS bf16x8*)(AT + c16 * AT_STRIDE + (256 * F.wave + 32 * ks + 8 * q) * 2);
                    bf16x8 bfr[8];
#pragma unroll
                    for (int n = 0; n < 8; ++n) bfr[n] = *(const bf16x8*)(wb + (size_t)(16 * n) * D + 32 * ks);
#pragma unroll
                    for (int n = 0; n < 8; ++n) acc[n] = __builtin_amdgcn_mfma_f32_16x16x32_bf16(af, bfr[n], acc[n], 0, 0, 0);
                }
#pragma unroll
                for (int n = 0; n < 8; ++n)
#pragma unroll
                    for (int rg4 = 0; rg4 < 4; ++rg4) RED[(F.wave * 16 + 4 * q + rg4) * 128 + 16 * n + c16] = acc[n][rg4];
                __syncthreads();
                { const int tok = F.tid >> 5, c4 = (F.tid & 31) * 4; f32x4 sum = {0.f, 0.f, 0.f, 0.f};
#pragma unroll
                  for (int w = 0; w < 8; ++w) sum += *(const LAS f32x4*)(RED + (w * 16 + tok) * 128 + c4);
                  u32x2 o; o.x = cvt_pk_bf16(sum.x, sum.y); o.y = cvt_pk_bf16(sum.z, sum.w);
                  *(u32x2*)(F.XA + (size_t)(T + 16 * rg + tok) * DA + 128 * cg + c4) = o; }
            }
        }
    }
}

constexpr int XCT_STRIDE = 272;
template <bool FINAL>
__device__ __forceinline__ void gates_phase(Frame& F, const int nrep) {
    LAS unsigned char* xcT = F.lds; LAS unsigned char* hsT = F.lds + 64 * XCT_STRIDE;
    const int h = F.bid & 7, kb0 = F.bid >> 3, kstride = (F.nb - h + 7) >> 3;
    const int NU = FINAL ? 256 : 2 * NCHUNK;
    const int c16 = F.lane & 15, q = F.lane >> 4, jrow = F.wave * 16 + c16, ch = h * 128 + jrow;
    bf16x8 bfr[4][4];
#pragma unroll
    for (int ks = 0; ks < 4; ++ks)
#pragma unroll
        for (int td = 0; td < 4; ++td) bfr[ks][td] = *(const bf16x8*)(F.WG + (size_t)((td * 8 + h) * 128 + jrow) * 128 + ks * 32 + q * 8);
    const float brf = F.lru_b_r[ch], brb = F.lru_b_r[DA + ch], bif = F.lru_b_i[ch], bib = F.lru_b_i[DA + ch];
    const float cff = -8.0f * log1pf(expf(-F.lru_lam[ch])), cfb = -8.0f * log1pf(expf(-F.lru_lam[DA + ch]));
    const int cg = F.tid & 15, tok0 = F.tid >> 4, chc = h * 128 + cg * 8;
    LAS float* CW = (LAS float*)(F.lds + 128 * XCT_STRIDE);
    for (int i = F.tid; i < 640; i += 512) CW[i] = i < 512 ? F.conv_a_w[(i >> 7) * DA + h * 128 + (i & 127)] : F.conv_a_b[h * 128 + (i - 512)];
    u32x4 xr[2][4];
#define GU_DECODE(k, b_, ci_, grow0_, t0_, seqlen_) const int b_ = (k) / (FINAL ? 128 : NCHUNK), ci_ = (k) % (FINAL ? 128 : NCHUNK); \
        const bool ctxu_ = !FINAL && ci_ < 4; const int t0_ = ctxu_ ? ci_ * 64 : (FINAL ? ci_ : ci_ - 4) * 64, seqlen_ = ctxu_ ? CTXL : SEQ, grow0_ = ctxu_ ? T + b_ * CTXL + t0_ : b_ * SEQ + t0_;
#define GU_LOAD(k) do { GU_DECODE(k, b_, ci_, grow0_, t0_, seqlen_) (void)ci_; \
        _Pragma("unroll") for (int it = 0; it < 2; ++it) _Pragma("unroll") for (int kk = 0; kk < 4; ++kk) { const int tt = t0_ + tok0 + 32 * it + kk - 2; \
            xr[it][kk] = (tt >= 0 && tt < seqlen_) ? *(const u32x4*)(F.XA + (size_t)(grow0_ + tok0 + 32 * it + kk - 2) * DA + chc) : (u32x4){0u, 0u, 0u, 0u}; } } while (0)
#pragma unroll 1
    for (int rep = 0; rep < nrep; ++rep) {
    int k = kb0;
    if (k < NU) GU_LOAD(k);
    for (; k < NU; k += kstride) {
        GU_DECODE(k, b, ci, grow0, t0, seqlen) (void)t0; (void)seqlen;
        __syncthreads();
#pragma unroll
        for (int it = 0; it < 2; ++it) { f32x4 a0 = *(const LAS f32x4*)(CW + 512 + cg * 8), a1 = *(const LAS f32x4*)(CW + 512 + cg * 8 + 4);
#pragma unroll
            for (int kk = 0; kk < 4; ++kk) { float xf[8]; unpack8(xr[it][kk], xf); a0 += *(const LAS f32x4*)(CW + kk * 128 + cg * 8) * (f32x4){xf[0], xf[1], xf[2], xf[3]}; a1 += *(const LAS f32x4*)(CW + kk * 128 + cg * 8 + 4) * (f32x4){xf[4], xf[5], xf[6], xf[7]}; }
            u32x4 o; o.x = cvt_pk_bf16(a0.x, a0.y); o.y = cvt_pk_bf16(a0.z, a0.w); o.z = cvt_pk_bf16(a1.x, a1.y); o.w = cvt_pk_bf16(a1.z, a1.w);
            *(LAS u32x4*)(xcT + (tok0 + 32 * it) * XCT_STRIDE + cg * 16) = o; }
        { const int kn = k + kstride; if (kn < NU) GU_LOAD(kn); }
        __syncthreads();
        f32x4 acc[4][4];
#pragma unroll
        for (int m = 0; m < 4; ++m)
#pragma unroll
            for (int td = 0; td < 4; ++td) acc[m][td] = (f32x4){0.f, 0.f, 0.f, 0.f};
#pragma unroll
        for (int ks = 0; ks < 4; ++ks) {
#pragma unroll
            for (int m = 0; m < 4; ++m) { const int arow = 16 * (c16 >> 2) + 4 * m + (c16 & 3); const bf16x8 af = *(const LAS bf16x8*)(xcT + arow * XCT_STRIDE + (ks * 32 + q * 8) * 2);
#pragma unroll
                for (int td = 0; td < 4; ++td) acc[m][td] = __builtin_amdgcn_mfma_f32_16x16x32_bf16(af, bfr[ks][td], acc[m][td], 0, 0, 0); }
        }
#pragma unroll
        for (int m = 0; m < 4; ++m)
#pragma unroll
            for (int rg = 0; rg < 4; ++rg) { const int tok = 16 * q + 4 * m + rg; const float xcv = __uint_as_float((unsigned)(*(const LAS unsigned short*)(xcT + tok * XCT_STRIDE + jrow * 2)) << 16);
                { float ao, bo; gate_pair(acc[m][0][rg] + brf, acc[m][2][rg] + bif, cff, xcv, ao, bo); acc[m][0][rg] = ao; acc[m][2][rg] = bo; }
                { float ao, bo; gate_pair(acc[m][1][rg] + brb, acc[m][3][rg] + bib, cfb, xcv, ao, bo); acc[m][1][rg] = ao; acc[m][3][rg] = bo; } }
        float Af = 1.f, Bf = 0.f, Ab = 1.f, Bb = 0.f;
#pragma unroll
        for (int m = 0; m < 4; ++m)
#pragma unroll
            for (int rg = 0; rg < 4; ++rg) { Bf = acc[m][0][rg] * Bf + acc[m][2][rg]; Af *= acc[m][0][rg]; }
#pragma unroll
        for (int m = 3; m >= 0; --m)
#pragma unroll
            for (int rg = 3; rg >= 0; --rg) { Bb = acc[m][1][rg] * Bb + acc[m][3][rg]; Ab *= acc[m][1][rg]; }
        float A_[4], B_[4], Ab_[4], Bb_[4];
#pragma unroll
        for (int qq = 0; qq < 4; ++qq) { A_[qq] = __shfl(Af, c16 + 16 * qq); B_[qq] = __shfl(Bf, c16 + 16 * qq); Ab_[qq] = __shfl(Ab, c16 + 16 * qq); Bb_[qq] = __shfl(Bb, c16 + 16 * qq); }
        if constexpr (!FINAL) {
            const float At = (A_[0] * A_[1]) * (A_[2] * A_[3]), Bt = ((B_[0] * A_[1] + B_[1]) * A_[2] + B_[2]) * A_[3] + B_[3];
            const float Abt = (Ab_[0] * Ab_[1]) * (Ab_[2] * Ab_[3]), Bbt = ((Bb_[3] * Ab_[2] + Bb_[2]) * Ab_[1] + Bb_[1]) * Ab_[0] + Bb_[0];
            if (q == 0) { F.AGG[(size_t)((0 * 2 + b) * NCHUNK + ci) * DA + ch] = (f32x2){At, Bt}; F.AGG[(size_t)((1 * 2 + b) * NCHUNK + ci) * DA + ch] = (f32x2){Abt, Bbt}; }
        } else {
            float hf = F.HIN[(size_t)((0 * 2 + b) * 128 + ci) * DA + ch], hb = F.HIN[(size_t)((1 * 2 + b) * 128 + ci) * DA + ch];
#pragma unroll
            for (int qq = 0; qq < 4; ++qq) hf = (qq < q) ? A_[qq] * hf + B_[qq] : hf;
#pragma unroll
            for (int qq = 3; qq >= 0; --qq) hb = (qq > q) ? Ab_[qq] * hb + Bb_[qq] : hb;
            float hs[4][4]; float hh = hf;
#pragma unroll
            for (int m = 0; m < 4; ++m)
#pragma unroll
                for (int rg = 0; rg < 4; ++rg) { hh = acc[m][0][rg] * hh + acc[m][2][rg]; hs[m][rg] = hh; }
            hh = hb;
#pragma unroll
            for (int m = 3; m >= 0; --m)
#pragma unroll
                for (int rg = 3; rg >= 0; --rg) { hh = acc[m][1][rg] * hh + acc[m][3][rg]; hs[m][rg] += hh; }
#pragma unroll
            for (int m = 0; m < 4; ++m)
#pragma unroll
                for (int rg = 0; rg < 4; ++rg) { const int tok = 16 * q + 4 * m + rg; *(LAS unsigned short*)(hsT + tok * XCT_STRIDE + jrow * 2) = (unsigned short)(cvt_pk_bf16(hs[m][rg], 0.f) & 0xffffu); }
            __syncthreads();
#pragma unroll
            for (int it = 0; it < 2; ++it) { const int tok = tok0 + 32 * it; *(u32x4*)(F.HS + (size_t)(grow0 + tok) * DA + chc) = *(const LAS u32x4*)(hsT + tok * XCT_STRIDE + cg * 16); }
        }
    }
    }
#undef GU_DECODE
#undef GU_LOAD
}
__device__ __forceinline__ void ph4(Frame& F) {
    LAS f32x2* G = (LAS f32x2*)F.lds;
    for (int u = F.bid; u < 128; u += F.nb) {
        const int dir = u >> 6, b = (u >> 5) & 1, ch = (u & 31) * 32 + (F.tid & 31), g = F.tid >> 5;
        const f32x2* ag = F.AGG + (size_t)((dir * 2 + b) * NCHUNK) * DA + ch; float* hin = F.HIN + (size_t)((dir * 2 + b) * 128) * DA + ch;
        f32x2 v[12]; float A = 1.f, B = 0.f;
        __syncthreads();
        if (g < 11) {
#pragma unroll
            for (int j = 0; j < 12; ++j) { const int p = g * 12 + j, cidx = dir == 0 ? p : (p < 4 ? 3 - p : 135 - p); v[j] = ag[(size_t)cidx * DA]; }
#pragma unroll
            for (int j = 0; j < 12; ++j) { B = v[j].x * B + v[j].y; A *= v[j].x; }
            G[g * 32 + (F.tid & 31)] = (f32x2){A, B};
        }
        __syncthreads();
        if (g < 11) {
            float hcur = 0.f;
            for (int gg = 0; gg < g; ++gg) { const f32x2 t = G[gg * 32 + (F.tid & 31)]; hcur = t.x * hcur + t.y; }
#pragma unroll
            for (int j = 0; j < 12; ++j) { const int p = g * 12 + j, cidx = dir == 0 ? p : (p < 4 ? 3 - p : 135 - p); if (cidx >= 4) hin[(size_t)(cidx - 4) * DA] = hcur; hcur = v[j].x * hcur + v[j].y; }
        }
    }
}
__device__ __forceinline__ void p5b_load(Frame& F, int t, int c0, int c1, u32x4 (&v)[12]) {
    const int tl = t & (SEQ - 1), col = tl & 63, grow = tl >> 6; const size_t ro = (size_t)t * DA; const u32x4 zero = {0u, 0u, 0u, 0u};
    v[0] = __builtin_nontemporal_load((const u32x4*)(F.Gb + ro + c0)); v[1] = __builtin_nontemporal_load((const u32x4*)(F.Gb + ro + c1)); v[2] = __builtin_nontemporal_load((const u32x4*)(F.HS + ro + c0)); v[3] = __builtin_nontemporal_load((const u32x4*)(F.HS + ro + c1));
    v[4] = __builtin_nontemporal_load((const u32x4*)(F.BB + ro + c0)); v[5] = __builtin_nontemporal_load((const u32x4*)(F.BB + ro + c1)); v[6] = *(const u32x4*)(F.P + ro + c0); v[7] = *(const u32x4*)(F.P + ro + c1);
    v[8] = col > 0 ? *(const u32x4*)(F.P + ro - DA + c0) : zero; v[9] = col < 63 ? *(const u32x4*)(F.P + ro + DA + c0) : zero;
    v[10] = grow > 0 ? *(const u32x4*)(F.P + ro - 64 * DA + c1) : zero; v[11] = grow < 127 ? *(const u32x4*)(F.P + ro + 64 * DA + c1) : zero;
}
__device__ __forceinline__ void p5b_item(Frame& F, int t, int c0, int c1, const u32x4 (&v)[12], const f32x4 (&wa)[2][2], const f32x4 (&wb)[2][2], const f32x4 (&w0)[2][2], const f32x4 (&w1)[2][2], const f32x4 (&w2)[2][2]) {
    float ya[2][8], yb[2][8]; float sa = 0.f, sb = 0.f;
#pragma unroll
    for (int cc = 0; cc < 2; ++cc) { float gg[8], hh[8]; unpack8(v[cc], gg); unpack8(v[2 + cc], hh);
#pragma unroll
        for (int j = 0; j < 8; ++j) { const float y = gg[j] * hh[j]; sa += y * y; ya[cc][j] = y * wa[cc][j >> 2][j & 3]; } }
#pragma unroll
    for (int cc = 0; cc < 2; ++cc) { float bq[8], a[8], m[8], p[8]; unpack8(v[4 + cc], bq); unpack8(v[6 + cc], a); unpack8(v[8 + 2 * cc], m); unpack8(v[9 + 2 * cc], p);
#pragma unroll
        for (int j = 0; j < 8; ++j) { const float y = bq[j] * (w0[cc][j >> 2][j & 3] * m[j] + w1[cc][j >> 2][j & 3] * a[j] + w2[cc][j >> 2][j & 3] * p[j]); sb += y * y; yb[cc][j] = y * wb[cc][j >> 2][j & 3]; } }
    sa = wave_sum(sa); sb = wave_sum(sb);
    const float ra = 1.0f / sqrtf(sa * (1.0f / DA) + EPS), rb = 1.0f / sqrtf(sb * (1.0f / DA) + EPS);
    bf16_t* yo = F.Y + (size_t)t * D;
#pragma unroll
    for (int cc = 0; cc < 2; ++cc) { const int c = cc ? c1 : c0; u32x4 o;
        o.x = cvt_pk_bf16(ya[cc][0] * ra, ya[cc][1] * ra); o.y = cvt_pk_bf16(ya[cc][2] * ra, ya[cc][3] * ra); o.z = cvt_pk_bf16(ya[cc][4] * ra, ya[cc][5] * ra); o.w = cvt_pk_bf16(ya[cc][6] * ra, ya[cc][7] * ra);
        *(u32x4*)(yo + c) = o;
        o.x = cvt_pk_bf16(yb[cc][0] * rb, yb[cc][1] * rb); o.y = cvt_pk_bf16(yb[cc][2] * rb, yb[cc][3] * rb); o.z = cvt_pk_bf16(yb[cc][4] * rb, yb[cc][5] * rb); o.w = cvt_pk_bf16(yb[cc][6] * rb, yb[cc][7] * rb);
        *(u32x4*)(yo + DA + c) = o; }
}
__device__ __forceinline__ void ph5b(Frame& F) {
    const int gw = F.bid * 8 + F.wave, NGW = F.nb * 8, c0 = 8 * F.lane, c1 = 512 + 8 * F.lane;
    if (gw >= T) return;
    f32x4 wa[2][2], wb[2][2], w0[2][2], w1[2][2], w2[2][2];
#pragma unroll
    for (int cc = 0; cc < 2; ++cc)
#pragma unroll
        for (int hh = 0; hh < 2; ++hh) { const int c = (cc ? c1 : c0) + 4 * hh; wa[cc][hh] = *(const f32x4*)(F.g_out_a + c); wb[cc][hh] = *(const f32x4*)(F.g_out_b + c);
            w0[cc][hh] = *(const f32x4*)(F.conv_b_w + c); w1[cc][hh] = *(const f32x4*)(F.conv_b_w + DA + c); w2[cc][hh] = *(const f32x4*)(F.conv_b_w + 2 * DA + c); }
    u32x4 va[12], vb[12]; int t = gw;
    p5b_load(F, t, c0, c1, va);
    for (;;) {
        const int t1 = t + NGW; const bool h1 = t1 < T;
        p5b_load(F, h1 ? t1 : t, c0, c1, vb);
        p5b_item(F, t, c0, c1, va, wa, wb, w0, w1, w2);
        if (!h1) break;
        const int t2 = t1 + NGW; const bool h2 = t2 < T;
        p5b_load(F, h2 ? t2 : t1, c0, c1, va);
        p5b_item(F, t1, c0, c1, vb, wa, wb, w0, w1, w2);
        if (!h2) break;
        t = t2;
    }
}

constexpr int XT_STRIDE = 2052;
__device__ __forceinline__ void ph7(Frame& F) {
    LAS float* Ac = (LAS float*)F.lds; LAS float* Bc = Ac + D; LAS float* XT = (LAS float*)(F.lds + 16384); LAS float* RED = XT; LAS float* LG = (LAS float*)(F.lds + 16384 + 16 * XT_STRIDE * 4);
    int curb = -1;
    for (int g = F.bid; g < T / 16; g += F.nb) {
        const int row0 = 16 * g, b = row0 >> 13;
        __syncthreads();
        if (b != curb) { for (int cc = F.tid; cc < D; cc += 512) { const float sh = F.MOD[b * 12288 + 6144 + cc], sl = F.MOD[b * 12288 + 8192 + cc]; Ac[cc] = F.g_ffn[cc] * (1.0f + sl); Bc[cc] = sh; } curb = b; __syncthreads(); }
#pragma unroll 1
        for (int rr = 0; rr < 2; ++rr) { const int r = F.wave * 2 + rr; const size_t row = (size_t)row0 + r;
            const f32x4* xr = (const f32x4*)(F.x + row * D) + F.lane; const u32x2* mr = (const u32x2*)(F.XN + row * D) + F.lane; f32x4 v[8]; float s = 0.f;
#pragma unroll
            for (int j = 0; j < 8; ++j) { const u32x2 mw = __builtin_nontemporal_load(mr + 64 * j); v[j] = __builtin_nontemporal_load(xr + 64 * j) + (f32x4){bf_lo(mw.x), bf_hi(mw.x), bf_lo(mw.y), bf_hi(mw.y)}; s += (v[j].x * v[j].x + v[j].y * v[j].y) + (v[j].z * v[j].z + v[j].w * v[j].w); }
            const float rstd = 1.0f / sqrtf(wave_sum(s) * (1.0f / D) + EPS);
            unsigned char* o6 = F.XN2 + row * D + (F.lane >> 2) * 128 + (F.lane & 3) * 16;
            u32x2* x1o = (u32x2*)(F.Y + row * D) + F.lane;
#pragma unroll
            for (int j = 0; j < 8; ++j) { u32x2 xw; xw.x = cvt_pk_bf16(v[j].x, v[j].y); xw.y = cvt_pk_bf16(v[j].z, v[j].w); __builtin_nontemporal_store(xw, x1o + 64 * j); }
#pragma unroll
            for (int j = 0; j < 8; ++j) { const f32x4 a = *(const LAS f32x4*)(Ac + 4 * (F.lane + 64 * j)), bq = *(const LAS f32x4*)(Bc + 4 * (F.lane + 64 * j)); const f32x4 o = v[j] * rstd * a + bq;
                v[j] = o;
                *(LAS f32x4*)(XT + r * XT_STRIDE + 4 * (F.lane + 64 * j)) = o; }
            { float fv[32];
#pragma unroll
              for (int j = 0; j < 8; ++j) { const f32x4 t = *(const LAS f32x4*)(XT + r * XT_STRIDE + 32 * F.lane + 4 * j); fv[4 * j] = t.x; fv[4 * j + 1] = t.y; fv[4 * j + 2] = t.z; fv[4 * j + 3] = t.w; }
              const u32x6 pk = cvt_fp6_32(fv, X6_SCALE);
              *(u32x4*)o6 = (u32x4){pk[0], pk[1], pk[2], pk[3]}; *(u32x4*)(o6 + 64) = (u32x4){pk[4], pk[5], pk[4], pk[5]}; }
        }
        __syncthreads();
        {
            const int r = F.lane & 15, q = F.lane >> 4; f32x4 acc0 = {0.f, 0.f, 0.f, 0.f}, acc1 = acc0;
#pragma unroll 8
            for (int i = 0; i < 16; ++i) { const int kb = 256 * F.wave + 16 * i + 4 * q; const f32x4 a4 = *(const LAS f32x4*)(XT + r * XT_STRIDE + kb);
#pragma unroll
                for (int u = 0; u < 4; ++u) { const float b0 = F.w_router[(kb + u) * NE + r], b1 = F.w_router[(kb + u) * NE + 16 + r];
                    acc0 = __builtin_amdgcn_mfma_f32_16x16x4f32(a4[u], b0, acc0, 0, 0, 0); acc1 = __builtin_amdgcn_mfma_f32_16x16x4f32(a4[u], b1, acc1, 0, 0, 0); } }
            __syncthreads();
#pragma unroll
            for (int rg = 0; rg < 4; ++rg) { RED[(F.wave * 16 + 4 * q + rg) * 32 + r] = acc0[rg]; RED[(F.wave * 16 + 4 * q + rg) * 32 + 16 + r] = acc1[rg]; }
        }
        __syncthreads();
        { const int tok = F.tid >> 5, e = F.tid & 31; float s = F.b_router[e];
#pragma unroll
          for (int w = 0; w < 8; ++w) s += RED[(w * 16 + tok) * 32 + e];
          LG[tok * 33 + e] = s; }
        __syncthreads();
        if (F.tid < 16) { const int tok = F.tid; unsigned taken = 0u; float tv[4]; int te[4];
#pragma unroll
            for (int k = 0; k < 4; ++k) { float best = -3.0e38f; int bi = 0;
                for (int e = 0; e < NE; ++e) { const float v = LG[tok * 33 + e]; if (!((taken >> e) & 1u) && v > best) { best = v; bi = e; } }
                taken |= 1u << bi; tv[k] = best; te[k] = bi; }
            float ex[4], sum = 0.f;
#pragma unroll
            for (int k = 0; k < 4; ++k) { ex[k] = expf(tv[k] - tv[0]); sum += ex[k]; }
            const float inv = 1.0f / sum; const int token = row0 + tok;
            unsigned rank[4];
#pragma unroll
            for (int k = 0; k < 4; ++k) rank[k] = atomicAdd(F.CNT + te[k], 1u);
#pragma unroll
            for (int k = 0; k < 4; ++k) { F.STOK[(size_t)te[k] * CAP + rank[k]] = token; F.SLW[(size_t)te[k] * CAP + rank[k]] = ex[k] * inv; F.ER[token * 4 + k] = (unsigned)te[k] | (rank[k] << 8); }
        }
    }
}
__device__ __forceinline__ void moe_tables(Frame& F) {
    __syncthreads();
    if (F.tid == 0) { int acc = 0; for (int e = 0; e < NE; ++e) { const int c = (int)F.CNT[e]; F.MISC[128 + e] = (unsigned)c; F.MISC[16 + e] = (unsigned)acc; F.MISC[64 + e] = (unsigned)acc; acc += (c + 255) >> 8; } F.MISC[16 + NE] = (unsigned)acc; F.MISC[64 + NE] = (unsigned)acc; }
    __syncthreads();
}
__device__ __forceinline__ void ph11(Frame& F) {
    LAS float* GT = (LAS float*)F.lds; LAS float* GF = GT + 2 * D;
    for (int cc = F.tid; cc < D; cc += 512) { GT[cc] = F.MOD[10240 + cc]; GT[D + cc] = F.MOD[12288 + 10240 + cc]; GF[cc] = F.g_final[cc]; }
    moe_tables(F);
    const int gw = F.bid * 8 + F.wave, NGW = F.nb * 8;
    u32x4 ern = gw < T ? *(const u32x4*)(F.ER + (size_t)gw * 4) : (u32x4){0u, 0u, 0u, 0u};
    for (int t = gw; t < T; t += NGW) {
        const int b = t >> 13; size_t pos[4]; const u32x4 erc = ern;
        { const int tn = t + NGW; ern = *(const u32x4*)(F.ER + (size_t)(tn < T ? tn : t) * 4); }
#pragma unroll
        for (int k = 0; k < 4; ++k) { const unsigned er = erc[k]; pos[k] = ((size_t)F.MISC[64 + (er & 255u)] << 8) + (er >> 8); }
        float x2[4][8]; float ssq = 0.f;
#pragma unroll
        for (int j = 0; j < 4; ++j) { const int col = 8 * (F.lane + 64 * j);
            const u32x4 mw = __builtin_nontemporal_load((const u32x4*)(F.Y + (size_t)t * D + col));
            const f32x4 xa = {bf_lo(mw.x), bf_hi(mw.x), bf_lo(mw.y), bf_hi(mw.y)}, xb = {bf_lo(mw.z), bf_hi(mw.z), bf_lo(mw.w), bf_hi(mw.w)};
            float s8[8] = {0.f, 0.f, 0.f, 0.f, 0.f, 0.f, 0.f, 0.f};
#pragma unroll
            for (int k = 0; k < 4; ++k) { const u32x2 ov = __builtin_nontemporal_load((const u32x2*)((const unsigned char*)F.O + pos[k] * D + col));
                const f32x2 q0 = __builtin_amdgcn_cvt_pk_f32_fp8((int)ov.x, false), q1 = __builtin_amdgcn_cvt_pk_f32_fp8((int)ov.x, true), q2 = __builtin_amdgcn_cvt_pk_f32_fp8((int)ov.y, false), q3 = __builtin_amdgcn_cvt_pk_f32_fp8((int)ov.y, true);
                s8[0] += q0.x; s8[1] += q0.y; s8[2] += q1.x; s8[3] += q1.y; s8[4] += q2.x; s8[5] += q2.y; s8[6] += q3.x; s8[7] += q3.y; }
#pragma unroll
            for (int i = 0; i < 8; ++i) s8[i] *= O8_INV;
            const f32x4 ga = *(const LAS f32x4*)(GT + b * D + col), gb = *(const LAS f32x4*)(GT + b * D + col + 4);
            x2[j][0] = xa.x + ga.x * s8[0]; x2[j][1] = xa.y + ga.y * s8[1]; x2[j][2] = xa.z + ga.z * s8[2]; x2[j][3] = xa.w + ga.w * s8[3];
            x2[j][4] = xb.x + gb.x * s8[4]; x2[j][5] = xb.y + gb.y * s8[5]; x2[j][6] = xb.z + gb.z * s8[6]; x2[j][7] = xb.w + gb.w * s8[7];
#pragma unroll
            for (int i = 0; i < 8; ++i) ssq += x2[j][i] * x2[j][i]; }
        const float rstd = 1.0f / sqrtf(wave_sum(ssq) * (1.0f / D) + EPS);
#pragma unroll
        for (int j = 0; j < 4; ++j) { const int col = 8 * (F.lane + 64 * j); const f32x4 fa = *(const LAS f32x4*)(GF + col), fb = *(const LAS f32x4*)(GF + col + 4);
            __builtin_nontemporal_store((f32x4){x2[j][0] * rstd * fa.x, x2[j][1] * rstd * fa.y, x2[j][2] * rstd * fa.z, x2[j][3] * rstd * fa.w}, (f32x4*)(F.out + (size_t)t * D + col));
            __builtin_nontemporal_store((f32x4){x2[j][4] * rstd * fb.x, x2[j][5] * rstd * fb.y, x2[j][6] * rstd * fb.z, x2[j][7] * rstd * fb.w}, (f32x4*)(F.out + (size_t)t * D + col + 4)); }
    }
}

struct Args { const float* in[29]; float* out; unsigned char* ws; int ph_lo, ph_hi, li, pad; };
__global__ void __launch_bounds__(512, 2) fwd_kernel(Args args) {
    extern __shared__ __attribute__((aligned(16))) unsigned char lds[];
    Frame F;
    F.lds = (LAS unsigned char*)lds; F.MISC = (volatile LAS unsigned*)(F.lds + MISC_OFF);
    F.tid = threadIdx.x; F.lane = F.tid & 63; F.wave = __builtin_amdgcn_readfirstlane(F.tid >> 6); F.G = gridDim.x;
    unsigned char* ws = args.ws;
    F.ctl = (unsigned*)(ws + WS_CTL);
    F.x = args.in[0]; F.c = args.in[1]; F.ctx = args.in[2]; F.c_ctx = args.in[3]; F.w_mod = args.in[4]; F.b_mod = args.in[5]; F.g_mix = args.in[6]; F.w_in = args.in[7];
    F.conv_a_w = args.in[8]; F.conv_a_b = args.in[9]; F.lru_w_r = args.in[10]; F.lru_b_r = args.in[11]; F.lru_w_i = args.in[12]; F.lru_b_i = args.in[13]; F.lru_lam = args.in[14];
    F.conv_b_w = args.in[15]; F.g_out_a = args.in[16]; F.g_out_b = args.in[17]; F.w_out = args.in[18]; F.g_ffn = args.in[19]; F.w_router = args.in[20]; F.b_router = args.in[21];
    F.w_gate = args.in[22]; F.b_gate = args.in[23]; F.w_up = args.in[24]; F.b_up = args.in[25]; F.w_down = args.in[26]; F.b_down = args.in[27]; F.g_final = args.in[28];
    F.out = args.out;
    F.MOD = (float*)(ws + WS_MOD); F.WG = (bf16_t*)(ws + WS_WG); F.WIN = (bf16_t*)(ws + WS_WIN); F.WOUT = (bf16_t*)(ws + WS_WOUT); F.XN = (bf16_t*)(ws + WS_XN); F.Gb = (bf16_t*)(ws + WS_G);
    F.XA = (bf16_t*)(ws + WS_XA); F.BB = (bf16_t*)(ws + WS_BB); F.P = (bf16_t*)(ws + WS_P); F.Y = (bf16_t*)(ws + WS_Y); F.WGU = (bf16_t*)(ws + WS_WGU); F.WDN = (bf16_t*)(ws + WS_WDN);
    F.H = (bf16_t*)(ws + WS_H); F.O = (bf16_t*)(ws + WS_O); F.AGG = (f32x2*)(ws + WS_AGG); F.HIN = (float*)(ws + WS_HIN); F.ER = (unsigned*)(ws + WS_ER); F.STOK = (int*)(ws + WS_STOK);
    F.SLW = (float*)(ws + WS_SLW); F.CNT = F.ctl + CW_CNT; F.HS = (bf16_t*)(ws + WS_HS); F.XN2 = ws + WS_XN2;
    for (int u = F.tid; u < (LDS_BYTES - MISC_OFF) / 4; u += 512) F.MISC[u] = 0u;
    __syncthreads();
    const bool split = (F.G % 64) == 0 && NC8 > 0;
    const int row8 = (int)blockIdx.x >> 3;
    const bool conv_role = split && ((row8 & 7) < NC8);
    const int Gm = split ? (F.G / 8) * (8 - NC8) : F.G, Gc = split ? (F.G / 8) * NC8 : F.G;
    const int cm = split ? ((int)blockIdx.x & 7) + 8 * ((row8 >> 3) * (8 - NC8) + ((row8 & 7) - NC8)) : (int)blockIdx.x;
    const int cc = split ? ((int)blockIdx.x & 7) + 8 * ((row8 >> 3) * NC8 + (row8 & 7)) : (int)blockIdx.x;
    XcdBarrier bar = xcd_barrier_post(F.ctl + CW_BAR, F.MISC + 8, (unsigned)F.G, true);
    XcdBarrier barM = xcd_barrier_post(F.ctl + CW_BARM, F.MISC + 10, (unsigned)Gm, !conv_role);
#ifndef PH_MASK
#define PH_MASK 0xFFF
#endif
#define IN(k) ((PH_MASK >> (k)) & 1)
#define REP(k) ((REPEAT_MASK >> (k)) & 1)
#define NREP(k) (1 + (REP(k) ? args.pad : 0))

    if (conv_role) {
        F.bid = cc; F.nb = Gc;
        if (IN(8)) { ph_expert_conv6(F); ph_expert_conv(F); }
    } else {
        F.bid = cm; F.nb = Gm;
        if (IN(0)) ph0(F);
        xcd_barrier(barM);
        if (IN(1)) ph1(F);
        xcd_barrier(barM);
        if (IN(2)) {
            DenseOrder S; S.nM = 64; S.nN = 20; S.nwg = 1280; S.G = Gm; S.c = cm; S.nX = 0; S.A = (const char*)F.XN; S.Bt = (const char*)F.WIN; S.tstep = (size_t)256 * D * 2;
            EpiInProj E{args.ws, F.P};
            pg8::gemm_phase<EpiInProj, DenseOrder, false, true, true, false>(F.lds, D, S, E);
        }
        if (IN(8)) { ph_expert_conv6(F); ph_expert_conv(F); }
    }
    F.bid = blockIdx.x; F.nb = F.G;
    xcd_barrier(bar);
    if (IN(3)) { gates_phase<false>(F, NREP(3)); } xcd_barrier(bar);
    if (IN(4)) { for (int r = 0; r < NREP(4); ++r) { if (r) xcd_barrier(bar); ph4(F); } } xcd_barrier(bar);
    if (IN(5)) { gates_phase<true>(F, NREP(5)); } xcd_barrier(bar);
    if (IN(5)) { for (int r = 0; r < NREP(7); ++r) { if (r) xcd_barrier(bar); ph5b(F); } } xcd_barrier(bar);
    if (IN(6)) {
        DenseOrder S; S.nM = 64; S.nN = 8; S.nwg = 512; S.G = F.G; S.c = blockIdx.x; S.nX = 0; S.A = (const char*)F.Y; S.Bt = (const char*)F.WOUT; S.tstep = (size_t)256 * D * 2;
        EpiOutProj E{F.XN, F.MOD};
        for (int r = 0; r < NREP(6); ++r) { if (r) xcd_barrier(bar); pg8::gemm_phase<EpiOutProj, DenseOrder, false, true, true, false>(F.lds, D, S, E); }
    } xcd_barrier(bar);
    if (IN(7)) { ph7(F); } xcd_barrier(bar);
    if (IN(9)) {
        moe_tables(F);
        MoeOrder S; S.tab = (const LAS int*)F.MISC; S.NT = 16; S.G = F.G; S.c = blockIdx.x; S.nwg = __builtin_amdgcn_readfirstlane((int)F.MISC[16 + NE]) * 16; S.A = (const char*)F.XN2; S.Bt = (const char*)F.WGU; S.STOK = F.STOK;
        S.bstep_e = (size_t)4096 * D; S.tstep = (size_t)256 * D; S.gather = true;
        EpiGU E{F.H, F.b_gate, F.b_up};
        for (int r = 0; r < NREP(9); ++r) { if (r) xcd_barrier(bar); pg8::gemm_phase<EpiGU, MoeOrder, true, true, true, true, true>(F.lds, D / 2, S, E); }
    } xcd_barrier(bar);
    if (IN(10)) {
        moe_tables(F);
        MoeOrder S; S.tab = (const LAS int*)F.MISC; S.NT = 8; S.G = F.G; S.c = blockIdx.x; S.nwg = __builtin_amdgcn_readfirstlane((int)F.MISC[16 + NE]) * 8; S.A = (const char*)F.H; S.Bt = (const char*)F.WDN; S.STOK = F.STOK;
        S.bstep_e = (size_t)D * FF; S.tstep = (size_t)256 * FF; S.gather = false;
        EpiDown E{F.O, F.b_down, F.SLW, (const LAS int*)F.MISC + 128};
        for (int r = 0; r < NREP(10); ++r) { if (r) xcd_barrier(bar); pg8::gemm_phase<EpiDown, MoeOrder, false, true, true, true>(F.lds, FF / 2, S, E); }
    } xcd_barrier(bar);
    if (IN(11)) { ph11(F); }
#undef IN
#undef REP
}

extern "C" void kernel_launch(void* const* d_in, const int* in_sizes, int n_in, void* d_out, int out_size, void* d_ws, size_t ws_size, hipStream_t stream) {
    static int grid = 0;
    if (grid == 0) {
        if (n_in != 29 || in_sizes[0] != T * D || out_size != T * D || ws_size < WS_END) { fprintf(stderr, "kernel_launch: unexpected shapes (n_in %d, in0 %d, out %d, ws %zu); nothing launched\n", n_in, n_in > 0 ? in_sizes[0] : -1, out_size, ws_size); grid = -1; return; }
        int dev = 0, cus = 0, per_cu = 0;
        if (hipGetDevice(&dev) != hipSuccess || hipDeviceGetAttribute(&cus, hipDeviceAttributeMultiprocessorCount, dev) != hipSuccess) { grid = -1; return; }
        if (hipFuncSetAttribute((const void*)fwd_kernel, hipFuncAttributeMaxDynamicSharedMemorySize, LDS_BYTES) != hipSuccess) { fprintf(stderr, "kernel_launch: hipFuncSetAttribute failed\n"); grid = -1; return; }
        if (hipOccupancyMaxActiveBlocksPerMultiprocessor(&per_cu, (const void*)fwd_kernel, 512, LDS_BYTES) != hipSuccess || per_cu < 1) fprintf(stderr, "kernel_launch: occupancy query reports %d\n", per_cu);
        (void)hipGetLastError();
        grid = cus;
    }
    if (grid < 0) return;
    (void)hipMemsetAsync((char*)d_ws + WS_CTL, 0, CTL_ZERO_BYTES, stream);
    Args a{};
    for (int i = 0; i < 29; ++i) a.in[i] = (const float*)d_in[i];
    a.out = (float*)d_out; a.ws = (unsigned char*)d_ws;
    a.ph_lo = 0; a.ph_hi = NPH; a.li = 0; a.pad = REPEAT_MASK ? 1 : 0; hipLaunchKernelGGL(fwd_kernel, dim3(grid), dim3(512), LDS_BYTES, stream, a);
}
```

```cpp
#include <hip/hip_runtime.h>
#include <cstdio>
#include <cstdint>
#include <type_traits>

#ifndef MK_N_LAUNCHES
#define MK_N_LAUNCHES 1
#endif

#define GAS __attribute__((address_space(1)))
#define LAS __attribute__((address_space(3)))
typedef unsigned short bf16_t;
typedef short bf16x8 __attribute__((ext_vector_type(8)));
typedef float f32x4 __attribute__((ext_vector_type(4)));
typedef float f32x2 __attribute__((ext_vector_type(2)));
typedef unsigned u32x4 __attribute__((ext_vector_type(4)));
typedef unsigned u32x2 __attribute__((ext_vector_type(2)));

constexpr int T = 16384, SEQ = 8192, D = 2048, DA = 1024, NIN = 5120, CTXL = 256, NCTX = 512, MROWS = T + NCTX;
constexpr int NE = 32, FF = 2048, CAP = 16384, HROWS = 73728;
constexpr int NCHUNK = 132;
constexpr float EPS = 1e-6f;
constexpr int NPH = 12;
constexpr int N_LAUNCHES = MK_N_LAUNCHES;
#ifndef REPEAT_MASK
#define REPEAT_MASK 0
#endif
#ifndef MK_NC8
#define MK_NC8 3
#endif
constexpr int NC8 = MK_NC8;

constexpr size_t MiB = 1u << 20;
constexpr size_t WS_CTL = 0, CTL_ZERO_BYTES = 1 * MiB;
constexpr size_t WS_MOD = 1 * MiB;
constexpr size_t WS_WG = 2 * MiB;
constexpr size_t WS_WIN = 4 * MiB;
constexpr size_t WS_WOUT = 24 * MiB;
constexpr size_t WS_AGG = 32 * MiB;
constexpr size_t WS_HIN = 38 * MiB;
constexpr size_t WS_ER = 40 * MiB;
constexpr size_t WS_STOK = 41 * MiB;
constexpr size_t WS_SLW = 43 * MiB;
constexpr size_t WS_XN = 48 * MiB;
constexpr size_t WS_G = 116 * MiB;
constexpr size_t WS_XA = 148 * MiB;
constexpr size_t WS_BB = 182 * MiB;
constexpr size_t WS_P = 214 * MiB;
constexpr size_t WS_Y = 246 * MiB;
constexpr size_t WS_WGU = 320 * MiB;
constexpr size_t WS_WDN = 832 * MiB;
constexpr size_t WS_H = 1088 * MiB;
constexpr size_t WS_O = 1376 * MiB;
constexpr size_t WS_HS = 1664 * MiB;
constexpr size_t WS_XN2 = 1696 * MiB;
constexpr size_t WS_END = 1728 * MiB;
constexpr int CW_CNT = 64;
constexpr int CW_BAR = 4096;
constexpr int CW_BARM = 8192;
constexpr int CW_Q0 = 96;
constexpr int CW_QCV6 = 224;
constexpr int CW_QCV = 160;

constexpr int LDS_BYTES = 155648;
constexpr int MISC_OFF = 154624;

__device__ __forceinline__ unsigned cvt_pk_bf16(float lo, float hi) { unsigned r; asm volatile("v_cvt_pk_bf16_f32 %0, %1, %2" : "=v"(r) : "v"(lo), "v"(hi)); return r; }
constexpr float X6_SCALE = 1.5f, GU_INV = 1.0f / 96.0f;
constexpr float W8_SCALE = 64.0f, W8_INV = 1.0f / 64.0f, O8_SCALE = 16.0f, O8_INV = 1.0f / 16.0f;
__device__ __forceinline__ unsigned pk4_fp8(float a, float b, float c, float d) { int w = 0; w = __builtin_amdgcn_cvt_pk_fp8_f32(a, b, w, false); w = __builtin_amdgcn_cvt_pk_fp8_f32(c, d, w, true); return (unsigned)w; }
__device__ __forceinline__ float bf_lo(unsigned w) { return __uint_as_float(w << 16); }
__device__ __forceinline__ float bf_hi(unsigned w) { return __uint_as_float(w & 0xffff0000u); }
__device__ __forceinline__ float fexp(float x) { return __builtin_amdgcn_exp2f(x * 1.44269504089f); }
__device__ __forceinline__ float fsigmoid(float x) { return __builtin_amdgcn_rcpf(1.0f + fexp(-x)); }
__device__ __forceinline__ float gelu_tanh(float x) { const float u = 0.7978845608028654f * (x + 0.044715f * x * x * x); return x * __builtin_amdgcn_rcpf(1.0f + fexp(-2.0f * u)); }
__device__ __forceinline__ float one_minus_exp(float u) { const float ser = -u * (1.0f + 0.5f * u * (1.0f + (1.0f / 3.0f) * u * (1.0f + 0.25f * u))); const float dir = 1.0f - fexp(u); return u > -0.05f ? ser : dir; }
__device__ __forceinline__ void gate_pair(float xr, float xi, float cf, float xc, float& a_out, float& b_out) {
    const float er = 1.0f + fexp(-fmaxf(xr, -30.0f)), ei = 1.0f + fexp(-fmaxf(xi, -30.0f)), inv = __builtin_amdgcn_rcpf(er * ei);
    const float r = inv * ei, ig = inv * er, la = cf * r, a = fexp(la), u = 2.0f * la;
    const float ser = -u * (1.0f + 0.5f * u * (1.0f + (1.0f / 3.0f) * u * (1.0f + 0.25f * u))), dir = 1.0f - a * a;
    a_out = a; b_out = __builtin_amdgcn_sqrtf(u > -0.05f ? ser : dir) * ig * xc;
}
__device__ __forceinline__ float wave_sum(float v) {
#pragma unroll
    for (int o = 1; o < 64; o <<= 1) v += __shfl_xor(v, o);
    return v;
}
__device__ __forceinline__ void unpack8(const u32x4 w, float (&f)[8]) { f[0] = bf_lo(w.x); f[1] = bf_hi(w.x); f[2] = bf_lo(w.y); f[3] = bf_hi(w.y); f[4] = bf_lo(w.z); f[5] = bf_hi(w.z); f[6] = bf_lo(w.w); f[7] = bf_hi(w.w); }

namespace pg8 {
#define PG8_LAS __attribute__((address_space(3)))
constexpr int BM = 256, BK = 64, HALF = 128, HTB = HALF * BK * 2, STAGE_BYTES = 8 * HTB, NXCD = 8, WGM = 8;
__host__ __device__ __forceinline__ int lds_byte(int r, int c) { const int st = (r >> 4) * 2 + (c >> 5), rr = r & 15, cc = c & 31, ob = rr * 64 + cc * 2; return st * 1024 + (ob ^ (((ob >> 9) & 1) << 5)); }
__host__ __device__ __forceinline__ void stage_rc(int b, int& R, int& C) { const int st = b / 1024, sb = b % 1024, swz = sb ^ (((sb >> 9) & 1) << 5); R = (st >> 1) * 16 + swz / 64; C = (st & 1) * 32 + (swz % 64) / 2; }
__host__ __device__ __forceinline__ int perm32(int rho) { const int n = rho >> 4, i = rho & 15; return 8 * (i >> 2) + 4 * n + (i & 3); }

struct Unit { int pm, pn, e, mt; };

__device__ __forceinline__ int xcd_remap(int L, int nwg) { const int q = nwg / NXCD, r = nwg % NXCD, xcd = L % NXCD, off = L / NXCD; return (xcd < r ? xcd * (q + 1) : r * (q + 1) + (xcd - r) * q) + off; }

typedef int i32x4 __attribute__((ext_vector_type(4)));
typedef int i32x8 __attribute__((ext_vector_type(8)));
__device__ __forceinline__ i32x8 cat8(const bf16x8 a, const bf16x8 b) { return __builtin_shufflevector(__builtin_bit_cast(i32x4, a), __builtin_bit_cast(i32x4, b), 0, 1, 2, 3, 4, 5, 6, 7); }
__device__ __forceinline__ void mfma_fp8(f32x4& acc, const i32x8 a, const i32x8 b, const int sc) {
    (void)sc; asm volatile("v_mfma_f32_16x16x128_f8f6f4 %0, %1, %2, %0" : "+v"(acc) : "v"(a), "v"(b)); }
typedef int i32x6 __attribute__((ext_vector_type(6)));
typedef int i32x2 __attribute__((ext_vector_type(2)));
__device__ __forceinline__ void mfma_fp6(f32x4& acc, const i32x6 a, const i32x6 b) { asm volatile("v_mfma_f32_16x16x128_f8f6f4 %0, %1, %2, %0 cbsz:2 blgp:2" : "+v"(acc) : "v"(a), "v"(b)); }
__device__ __forceinline__ i32x6 cat6(const bf16x8 a, const i32x2 b) { return __builtin_shufflevector(__builtin_bit_cast(i32x4, a), __builtin_shufflevector(b, b, 0, 1, -1, -1), 0, 1, 2, 3, 4, 5); }
template <int OFF> __device__ __forceinline__ i32x2 lds_rd64(const PG8_LAS unsigned char* p) { i32x2 r; asm volatile("ds_read_b64 %0, %1 offset:%2" : "=v"(r) : "v"(p), "n"(OFF)); return r; }
template <class Epi, class Sched, bool GATHER, bool ALIGN_EPI, bool SP2, bool FP8, bool FP6 = false>
__device__ __forceinline__ void gemm_phase(PG8_LAS unsigned char* lds, const int K, const Sched& S, const Epi& E) {
    int tid = threadIdx.x; asm volatile("" : "+v"(tid));
    const int wid = __builtin_amdgcn_readfirstlane(tid >> 6), lane = tid & 63, wr = wid >> 2, wc = wid & 3, fr = lane & 15, fq = lane >> 4;
    const int nt = K / BK;
    int Rr[2], Cc[2]; unsigned voffB[2]; unsigned vAc[2][2], vAn[2][2];
#pragma unroll
    for (int i = 0; i < 2; ++i) { stage_rc(tid * 16 + i * 8192, Rr[i], Cc[i]); const int Rb = Epi::PERM ? ((Rr[i] & ~31) + perm32(Rr[i] & 31)) : Rr[i];
        voffB[i] = (unsigned)(Rb * K + Cc[i]) * 2u; }
    const size_t kstep = (size_t)(BK * 2);
    const size_t hstep = (size_t)HALF * K * 2;
    const unsigned ldsw = (unsigned)wid * 1024u;
    const int aoff = lds_byte(wr * 64 + fr, fq * 8), boff = lds_byte(wc * 32 + fr, fq * 8);
    const int dup8 = 8 * ((fr >> 2) & 1);
#define PG8_SA(b, h) (((b) * 2 + (h)) * HTB)
#define PG8_SB(b, h) ((4 + (b) * 2 + (h)) * HTB)
#define PG8_STAGE(bufoff, gbase, voff) do { _Pragma("unroll") for (int _i = 0; _i < 2; ++_i) \
        __builtin_amdgcn_global_load_lds((const unsigned*)((const char*)(gbase) + (voff)[_i]), (PG8_LAS unsigned*)(lds + (bufoff) + ldsw + _i * 8192), 16, 0, 0); } while (0)
#define PG8_STAGE_A(bufoff, gbase, VO, h) do { if constexpr (GATHER) { PG8_STAGE(bufoff, gbase, (VO)[h]); } else { PG8_STAGE(bufoff, (gbase) + (h) * hstep, (VO)[0]); } } while (0)
#define PG8_LDA(dst, b, h) do { _Pragma("unroll") for (int m = 0; m < 4; ++m) dst[m] = *(const PG8_LAS bf16x8*)(lds + PG8_SA(b, h) + aoff + m * 2048); \
        if constexpr (FP6) { dst##2[0] = rd2<PG8_SA(b, h) + 1024>(lds + aoff + dup8); dst##2[1] = rd2<PG8_SA(b, h) + 3072>(lds + aoff + dup8); dst##2[2] = rd2<PG8_SA(b, h) + 5120>(lds + aoff + dup8); dst##2[3] = rd2<PG8_SA(b, h) + 7168>(lds + aoff + dup8); } \
        else { _Pragma("unroll") for (int m = 0; m < 4; ++m) dst##2[m] = rd2v(lds + PG8_SA(b, h) + aoff + m * 2048 + 1024); } } while (0)
#define PG8_LDB(dst, b, h) do { _Pragma("unroll") for (int n = 0; n < 2; ++n) dst[n] = *(const PG8_LAS bf16x8*)(lds + PG8_SB(b, h) + boff + n * 2048); \
        if constexpr (FP6) { dst##2[0] = rd2<PG8_SB(b, h) - 65536 + 1024>(lds + 65536 + boff + dup8); dst##2[1] = rd2<PG8_SB(b, h) - 65536 + 3072>(lds + 65536 + boff + dup8); } \
        else { _Pragma("unroll") for (int n = 0; n < 2; ++n) dst##2[n] = rd2v(lds + PG8_SB(b, h) + boff + n * 2048 + 1024); } } while (0)
#define PG8_MMA(ai, bj, At, Bt) do { __builtin_amdgcn_s_setprio(1); _Pragma("unroll") for (int m = 0; m < 4; ++m) _Pragma("unroll") for (int n = 0; n < 2; ++n) { \
        if constexpr (FP6) mfma_fp6(acc[ai][bj][m][n], cat6(Bt[n], Bt##2[n]), cat6(At[m], At##2[m])); \
        else if constexpr (FP8) mfma_fp8(acc[ai][bj][m][n], cat8(Bt[n], Bt##2[n]), cat8(At[m], At##2[m]), sc1); \
        else { acc[ai][bj][m][n] = __builtin_amdgcn_mfma_f32_16x16x32_bf16(Bt[n], At[m], acc[ai][bj][m][n], 0, 0, 0); acc[ai][bj][m][n] = __builtin_amdgcn_mfma_f32_16x16x32_bf16(Bt##2[n], At##2[m], acc[ai][bj][m][n], 0, 0, 0); } } __builtin_amdgcn_s_setprio(0); } while (0)
#define PG8_WAIT_V(n) asm volatile("s_waitcnt vmcnt(" #n ")" ::: "memory")
#define PG8_WAIT_L(n) asm volatile("s_waitcnt lgkmcnt(" #n ")" ::: "memory")
#define PG8_BAR __builtin_amdgcn_s_barrier()
#define PG8_SCHED __builtin_amdgcn_sched_barrier(0)
    int sc1 = 0x7F7F7F7F; asm volatile("" : "+v"(sc1));
    Unit cur, nxt; int ui = 0;
    if (!S.next(0, cur)) return;
    f32x4 acc[2][2][4][2];
#pragma unroll
    for (int a = 0; a < 2; ++a)
#pragma unroll
        for (int b = 0; b < 2; ++b)
#pragma unroll
            for (int m = 0; m < 4; ++m)
#pragma unroll
                for (int n = 0; n < 2; ++n) acc[a][b][m][n] = (f32x4){0.f, 0.f, 0.f, 0.f};
    using S2 = typename std::conditional<FP6, i32x2, bf16x8>::type;
    auto rd2v = [](const PG8_LAS unsigned char* p) -> S2 { return *(const PG8_LAS S2*)p; };
#define rd2 lds_rd64
    bf16x8 At[4], B0[2], B1[2]; S2 At2[4], B02[2], B12[2];
    const char* cA = S.a_base(cur); const char* cB = S.b_base(cur);
#pragma unroll
    for (int h = 0; h < 2; ++h)
#pragma unroll
        for (int i = 0; i < 2; ++i) { if constexpr (GATHER) vAc[h][i] = S.gather_off(cur, Rr[i] + HALF * h) + (unsigned)Cc[i] * 2u; else vAc[h][i] = (unsigned)(Rr[i] * K + Cc[i]) * 2u; vAn[h][i] = vAc[h][i]; }
    if constexpr (SP2) {
        PG8_STAGE(PG8_SB(0, 0), cB, voffB); PG8_STAGE(PG8_SB(0, 1), cB + hstep, voffB); PG8_STAGE_A(PG8_SA(0, 0), cA, vAc, 0); PG8_STAGE_A(PG8_SA(0, 1), cA, vAc, 1);
        if (wr == 1) PG8_BAR;
        PG8_WAIT_V(2); PG8_BAR;
        PG8_STAGE(PG8_SB(1, 0), cB + kstep, voffB); PG8_STAGE_A(PG8_SA(1, 0), cA + kstep, vAc, 0); PG8_STAGE(PG8_SB(1, 1), cB + hstep + kstep, voffB);
        PG8_WAIT_V(6); PG8_BAR;
    } else {
        PG8_STAGE(PG8_SB(0, 0), cB, voffB); PG8_STAGE_A(PG8_SA(0, 0), cA, vAc, 0); PG8_STAGE(PG8_SB(0, 1), cB + hstep, voffB); PG8_STAGE_A(PG8_SA(0, 1), cA, vAc, 1);
        if (wr == 1) PG8_BAR;
        PG8_WAIT_V(4); PG8_BAR;
        PG8_STAGE(PG8_SB(1, 0), cB + kstep, voffB); PG8_STAGE_A(PG8_SA(1, 0), cA + kstep, vAc, 0); PG8_STAGE(PG8_SB(1, 1), cB + hstep + kstep, voffB);
        PG8_WAIT_V(6); PG8_BAR;
    }
    for (;;) {
        const bool has_next = S.next(ui + 1, nxt);
        const char* nA = has_next ? S.a_base(nxt) : cA; const char* nB = has_next ? S.b_base(nxt) : cB;
        if constexpr (Epi::TAB_N > 0) { if (wid < Epi::TAB_N / 64) __builtin_amdgcn_global_load_lds((const unsigned*)E.tab_src(cur, tid), (PG8_LAS unsigned*)(lds + STAGE_BYTES + 1024 + (ui & 1) * 2048 + wid * 256), 4, 0, 0); }
        if constexpr (GATHER) { if (has_next && wid < 4) __builtin_amdgcn_global_load_lds((const unsigned*)S.tok_src(nxt, tid), (PG8_LAS unsigned*)(lds + STAGE_BYTES + wid * 256), 4, 0, 0); }
        for (int t = 0; t < nt; t += 2) {
            const bool last = (t == nt - 2);
            const char* a1 = cA + (size_t)(t + 1) * kstep;
            const char* a2 = last ? nA : cA + (size_t)(t + 2) * kstep; const char* b2 = last ? nB : cB + (size_t)(t + 2) * kstep;
            const char* a3 = a2 + kstep; const char* b3 = b2 + kstep;
            if constexpr (GATHER) { if (last && has_next) {
#pragma unroll
                for (int h = 0; h < 2; ++h)
#pragma unroll
                    for (int i = 0; i < 2; ++i) vAn[h][i] = *(const PG8_LAS unsigned*)(lds + STAGE_BYTES + 4 * (Rr[i] + HALF * h)) * (unsigned)(K * 2) + (unsigned)Cc[i] * 2u; } }
            unsigned v2[2][2];
#pragma unroll
            for (int h = 0; h < 2; ++h)
#pragma unroll
                for (int i = 0; i < 2; ++i) v2[h][i] = GATHER ? (last ? vAn[h][i] : vAc[h][i]) : vAc[0][i];
            if constexpr (SP2) {
            PG8_LDB(B0, 0, 0); PG8_LDB(B1, 0, 1); PG8_SCHED; PG8_LDA(At, 0, 0); PG8_STAGE_A(PG8_SA(1, 1), a1, vAc, 1);
            PG8_WAIT_V(8); PG8_WAIT_L(0); PG8_BAR; PG8_MMA(0, 0, At, B0); PG8_MMA(0, 1, At, B1); PG8_BAR; PG8_SCHED;
            PG8_LDA(At, 0, 1); PG8_STAGE(PG8_SB(0, 0), b2, voffB); PG8_STAGE(PG8_SB(0, 1), b2 + hstep, voffB); PG8_STAGE_A(PG8_SA(0, 0), a2, v2, 0);
            PG8_WAIT_V(8); PG8_WAIT_L(0); PG8_BAR; PG8_MMA(1, 0, At, B0); PG8_MMA(1, 1, At, B1); PG8_BAR; PG8_SCHED;
            PG8_LDB(B0, 1, 0); PG8_LDB(B1, 1, 1); PG8_SCHED; PG8_LDA(At, 1, 0); PG8_STAGE_A(PG8_SA(0, 1), a2, v2, 1);
            PG8_WAIT_V(8); PG8_WAIT_L(0); PG8_BAR; PG8_MMA(0, 0, At, B0); PG8_MMA(0, 1, At, B1); PG8_BAR; PG8_SCHED;
            PG8_LDA(At, 1, 1); PG8_STAGE(PG8_SB(1, 0), b3, voffB); PG8_STAGE(PG8_SB(1, 1), b3 + hstep, voffB); PG8_STAGE_A(PG8_SA(1, 0), a3, v2, 0);
            PG8_WAIT_V(8); PG8_WAIT_L(0); PG8_BAR; PG8_MMA(1, 0, At, B0); PG8_MMA(1, 1, At, B1); PG8_BAR; PG8_SCHED;
            } else {
            PG8_LDB(B0, 0, 0); PG8_SCHED; PG8_LDA(At, 0, 0); PG8_STAGE_A(PG8_SA(1, 1), a1, vAc, 1);
            PG8_WAIT_L(8); PG8_BAR; PG8_WAIT_L(0); PG8_MMA(0, 0, At, B0); PG8_BAR; PG8_SCHED;
            PG8_LDB(B1, 0, 1); PG8_STAGE(PG8_SB(0, 0), b2, voffB);
            PG8_BAR; PG8_WAIT_L(0); PG8_MMA(0, 1, At, B1); PG8_BAR;
            PG8_LDA(At, 0, 1); PG8_STAGE_A(PG8_SA(0, 0), a2, v2, 0);
            PG8_BAR; PG8_WAIT_L(0); PG8_MMA(1, 0, At, B0); PG8_BAR; PG8_SCHED;
            PG8_STAGE(PG8_SB(0, 1), b2 + hstep, voffB);
            PG8_WAIT_V(6); PG8_BAR; PG8_MMA(1, 1, At, B1); PG8_BAR;
            PG8_LDB(B0, 1, 0); PG8_SCHED; PG8_LDA(At, 1, 0); PG8_STAGE_A(PG8_SA(0, 1), a2, v2, 1);
            PG8_WAIT_L(8); PG8_BAR; PG8_WAIT_L(0); PG8_MMA(0, 0, At, B0); PG8_BAR; PG8_SCHED;
            PG8_LDB(B1, 1, 1); PG8_STAGE(PG8_SB(1, 0), b3, voffB);
            PG8_BAR; PG8_WAIT_L(0); PG8_MMA(0, 1, At, B1); PG8_BAR;
            PG8_LDA(At, 1, 1); PG8_STAGE_A(PG8_SA(1, 0), a3, v2, 0);
            PG8_BAR; PG8_WAIT_L(0); PG8_MMA(1, 0, At, B0); PG8_BAR; PG8_SCHED;
            PG8_STAGE(PG8_SB(1, 1), b3 + hstep, voffB);
            PG8_WAIT_V(6); PG8_BAR; PG8_MMA(1, 1, At, B1); PG8_BAR;
            }
        }
        if constexpr (ALIGN_EPI) { if (wr == 0) PG8_BAR; }
        if constexpr (FP8) asm volatile("s_nop 15\n\ts_nop 15" ::: "memory");
        E(acc, cur, wr, wc, fr, fq, (const PG8_LAS float*)(lds + STAGE_BYTES + 1024 + (ui & 1) * 2048));
        if (!has_next) break;
#pragma unroll
        for (int a = 0; a < 2; ++a)
#pragma unroll
            for (int b = 0; b < 2; ++b)
#pragma unroll
                for (int m = 0; m < 4; ++m)
#pragma unroll
                    for (int n = 0; n < 2; ++n) acc[a][b][m][n] = (f32x4){0.f, 0.f, 0.f, 0.f};
        cur = nxt; cA = nA; cB = nB; ++ui;
#pragma unroll
        for (int h = 0; h < 2; ++h)
#pragma unroll
            for (int i = 0; i < 2; ++i) vAc[h][i] = vAn[h][i];
        if constexpr (ALIGN_EPI) { if (wr == 1) PG8_BAR; }
    }
    PG8_WAIT_V(0);
    if constexpr (!ALIGN_EPI) { if (wr == 0) PG8_BAR; }
    PG8_BAR;
#undef rd2
#undef PG8_SA
#undef PG8_SB
#undef PG8_STAGE
#undef PG8_STAGE_A
#undef PG8_LDA
#undef PG8_LDB
#undef PG8_MMA
#undef PG8_WAIT_V
#undef PG8_WAIT_L
#undef PG8_BAR
#undef PG8_SCHED
}
}

#define XB_TMO      128
#define XB_XCNT(j)  (256  + 64 * (j))
#define XB_XSUB(j)  (1280 + 64 * (j))
#define XB_XGEN(j)  (2304 + 64 * (j))
#define XB_TOP      3328
#define XB_TOPGEN   3392
#define XCD_BAR_WORDS 3456
#define XB_SPIN_CAP (1u << 18)
__device__ __forceinline__ unsigned xb_ld(unsigned* p)              { return __hip_atomic_load(p, __ATOMIC_RELAXED, __HIP_MEMORY_SCOPE_AGENT); }
__device__ __forceinline__ unsigned xb_add(unsigned* p, unsigned v) { return __hip_atomic_fetch_add(p, v, __ATOMIC_RELAXED, __HIP_MEMORY_SCOPE_AGENT); }
__device__ __forceinline__ unsigned xb_xcc_id() { return (unsigned)__builtin_amdgcn_s_getreg((3 << 11) | 20) & 0xFu; }
#define XB_SPIN(cond, bar) do { unsigned _sp = 0; while (cond) { __builtin_amdgcn_s_sleep(1); \
    if ((++_sp & 255u) == 0u) { if (xb_ld(&(bar)[XB_TMO])) break; if (_sp > XB_SPIN_CAP) { atomicAdd(&(bar)[XB_TMO], 1u); break; } } } } while (0)
struct XcdBarrier { unsigned* bar; unsigned x; volatile LAS unsigned* st; unsigned expect; };
__device__ __forceinline__ XcdBarrier xcd_barrier_post(unsigned* bar, volatile LAS unsigned* st, unsigned expect, bool member) {
    XcdBarrier b; b.bar = bar; b.x = xb_xcc_id(); b.st = st; b.expect = expect;
    if (member && threadIdx.x == 0) (void)xb_add(&bar[XB_XCNT(b.x)], 1u);
    return b;
}
__device__ __forceinline__ void xcd_barrier_complete(unsigned* bar, unsigned x, unsigned G, unsigned& nloc, unsigned& nx) {
    unsigned sum, cnt, mine, sp = 0u;
    for (;;) {
        sum = 0u; cnt = 0u; mine = 0u;
#pragma unroll
        for (unsigned j = 0; j < 16; ++j) { const unsigned c = xb_ld(&bar[XB_XCNT(j)]); sum += c; cnt += (c > 0u) ? 1u : 0u; mine = (j == x) ? c : mine; }
        if (sum == G) break;
        __builtin_amdgcn_s_sleep(1);
        if ((++sp & 255u) == 0u) { if (xb_ld(&bar[XB_TMO])) break; if (sp > XB_SPIN_CAP) { atomicAdd(&bar[XB_TMO], 1u); break; } }
    }
    nloc = mine > 0u ? mine : 1u; nx = cnt > 0u ? cnt : 1u;
}
__device__ __forceinline__ void xcd_barrier(const XcdBarrier& b) {
    asm volatile("s_waitcnt vmcnt(0)" ::: "memory");
    __syncthreads();
    if (threadIdx.x == 0) {
        unsigned* bar = b.bar;
        __builtin_amdgcn_s_waitcnt(0);
        unsigned nloc = b.st[0], nx = b.st[1];
        if (nloc == 0u) { xcd_barrier_complete(bar, b.x, b.expect, nloc, nx); b.st[0] = nloc; b.st[1] = nx; }
        const unsigned old = xb_add(&bar[XB_XSUB(b.x)], 1u);
        const unsigned gen = old / nloc;
        if (old + 1u == (gen + 1u) * nloc) {
            __builtin_amdgcn_fence(__ATOMIC_RELEASE, "agent");
            asm volatile("s_waitcnt vmcnt(0)" ::: "memory");
            const unsigned og = xb_add(&bar[XB_TOP], 1u);
            const unsigned tg = og / nx;
            if (og + 1u == (tg + 1u) * nx) xb_add(&bar[XB_TOPGEN], 1u);
            else XB_SPIN(xb_ld(&bar[XB_TOPGEN]) == tg, bar);
            __builtin_amdgcn_fence(__ATOMIC_ACQUIRE, "agent");
            xb_add(&bar[XB_XGEN(b.x)], 1u);
            asm volatile("s_waitcnt vmcnt(0)" ::: "memory");
        } else {
            XB_SPIN(xb_ld(&bar[XB_XGEN(b.x)]) == gen, bar);
            __builtin_amdgcn_fence(__ATOMIC_ACQUIRE, "agent");
            asm volatile("s_waitcnt vmcnt(0)" ::: "memory");
        }
    }
    __syncthreads();
}

struct Frame {
    LAS unsigned char* lds;
    volatile LAS unsigned* MISC;
    unsigned* ctl;
    int tid, lane, wave, G;
    int bid, nb;
    const float *x, *c, *ctx, *c_ctx, *w_mod, *b_mod, *g_mix, *w_in, *conv_a_w, *conv_a_b, *lru_w_r, *lru_b_r, *lru_w_i, *lru_b_i, *lru_lam, *conv_b_w, *g_out_a, *g_out_b, *w_out,
        *g_ffn, *w_router, *b_router, *w_gate, *b_gate, *w_up, *b_up, *w_down, *b_down, *g_final;
    float* out;
    float* MOD; bf16_t *WG, *WIN, *WOUT, *XN, *Gb, *XA, *BB, *P, *Y, *WGU, *WDN, *H, *O, *HS;
    f32x2* AGG; float* HIN; unsigned* ER; int* STOK; float* SLW; unsigned* CNT; unsigned char* XN2;
};

struct EpiInProj {
    static constexpr bool PERM = true; static constexpr int TAB_N = 0;
    __device__ __forceinline__ const float* tab_src(const pg8::Unit&, int) const { return nullptr; }
    unsigned char* ws; bf16_t* P;
    __device__ __forceinline__ void operator()(const f32x4 (&acc)[2][2][4][2], const pg8::Unit& u, int wr, int wc, int fr, int fq, const LAS float* tab) const {
        const int row0 = u.pm * 256 + wr * 64 + fr, cl = wc * 32 + 8 * fq, pn = u.pn;
        if (pn < 12) {
            const size_t woff = pn < 4 ? WS_G : (pn < 8 ? WS_XA : WS_BB); bf16_t* dst = (bf16_t*)(ws + woff); const int colt = (pn & 3) * 256;
#pragma unroll
            for (int ai = 0; ai < 2; ++ai)
#pragma unroll
                for (int m = 0; m < 4; ++m) { bf16_t* rowp = dst + (size_t)(row0 + ai * 128 + m * 16) * DA + colt + cl;
#pragma unroll
                    for (int bj = 0; bj < 2; ++bj) { f32x4 v0 = acc[ai][bj][m][0], v1 = acc[ai][bj][m][1];
                        if (pn < 4) {
#pragma unroll
                            for (int j = 0; j < 4; ++j) { v0[j] = gelu_tanh(v0[j]); v1[j] = gelu_tanh(v1[j]); } }
                        u32x4 w; w.x = cvt_pk_bf16(v0[0], v0[1]); w.y = cvt_pk_bf16(v0[2], v0[3]); w.z = cvt_pk_bf16(v1[0], v1[1]); w.w = cvt_pk_bf16(v1[2], v1[3]);
                        *(u32x4*)(rowp + bj * 128) = w; } }
        } else {
            const int j = pn - 12;
#pragma unroll
            for (int ai = 0; ai < 2; ++ai)
#pragma unroll
                for (int m = 0; m < 4; ++m) { bf16_t* rowp = P + (size_t)(row0 + ai * 128 + m * 16) * DA + j * 128 + cl;
                    const f32x4 v0 = acc[ai][0][m][0] * acc[ai][1][m][0], v1 = acc[ai][0][m][1] * acc[ai][1][m][1];
                    u32x4 w; w.x = cvt_pk_bf16(v0[0], v0[1]); w.y = cvt_pk_bf16(v0[2], v0[3]); w.z = cvt_pk_bf16(v1[0], v1[1]); w.w = cvt_pk_bf16(v1[2], v1[3]);
                    *(u32x4*)rowp = w; }
        }
    }
};
struct EpiOutProj {
    static constexpr bool PERM = true; static constexpr int TAB_N = 0;
    __device__ __forceinline__ const float* tab_src(const pg8::Unit&, int) const { return nullptr; }
    bf16_t* MX; const float* MOD;
    __device__ __forceinline__ void operator()(const f32x4 (&acc)[2][2][4][2], const pg8::Unit& u, int wr, int wc, int fr, int fq, const LAS float* tab) const {
        const int row0 = u.pm * 256 + wr * 64 + fr, col0 = u.pn * 256 + wc * 32 + 8 * fq, b = u.pm >> 5;
        f32x4 gt[2][2];
#pragma unroll
        for (int bj = 0; bj < 2; ++bj)
#pragma unroll
            for (int n = 0; n < 2; ++n) gt[bj][n] = *(const f32x4*)(MOD + b * 12288 + 4096 + col0 + bj * 128 + 4 * n);
#pragma unroll
        for (int ai = 0; ai < 2; ++ai)
#pragma unroll
            for (int m = 0; m < 4; ++m) { bf16_t* rowp = MX + (size_t)(row0 + ai * 128 + m * 16) * D + col0;
#pragma unroll
                for (int bj = 0; bj < 2; ++bj) { const f32x4 v0 = gt[bj][0] * acc[ai][bj][m][0], v1 = gt[bj][1] * acc[ai][bj][m][1];
                    u32x4 w; w.x = cvt_pk_bf16(v0[0], v0[1]); w.y = cvt_pk_bf16(v0[2], v0[3]); w.z = cvt_pk_bf16(v1[0], v1[1]); w.w = cvt_pk_bf16(v1[2], v1[3]);
                    *(u32x4*)(rowp + bj * 128) = w; } }
    }
};
struct EpiGU {
    static constexpr bool PERM = true; static constexpr int TAB_N = 256;
    bf16_t* H; const float *b_gate, *b_up;
    __device__ __forceinline__ const float* tab_src(const pg8::Unit& u, int t) const { return (t < 128 ? b_gate : b_up) + u.e * FF + u.pn * 128 + (t & 127); }
    __device__ __forceinline__ void operator()(const f32x4 (&acc)[2][2][4][2], const pg8::Unit& u, int wr, int wc, int fr, int fq, const LAS float* tab) const {
        const int row0 = u.pm * 256 + wr * 64 + fr, colg = u.pn * 128 + wc * 32 + 8 * fq;
        f32x4 bg[2], bu[2];
#pragma unroll
        for (int n = 0; n < 2; ++n) { bg[n] = *(const LAS f32x4*)(tab + wc * 32 + 8 * fq + 4 * n); bu[n] = *(const LAS f32x4*)(tab + 128 + wc * 32 + 8 * fq + 4 * n); }
#pragma unroll
        for (int ai = 0; ai < 2; ++ai)
#pragma unroll
            for (int m = 0; m < 4; ++m) { unsigned char* rowp = (unsigned char*)H + (size_t)(row0 + ai * 128 + m * 16) * FF + colg; f32x4 a[2];
#pragma unroll
                for (int n = 0; n < 2; ++n)
#pragma unroll
                    for (int j = 0; j < 4; j += 2) {
                        f32x2 g = (f32x2){acc[ai][0][m][n][j], acc[ai][0][m][n][j + 1]} * GU_INV + (f32x2){bg[n][j], bg[n][j + 1]};
                        f32x2 up = (f32x2){acc[ai][1][m][n][j], acc[ai][1][m][n][j + 1]} * GU_INV + (f32x2){bu[n][j], bu[n][j + 1]};
                        g.x = fminf(g.x, 7.0f); g.y = fminf(g.y, 7.0f); up.x = __builtin_amdgcn_fmed3f(up.x, -7.0f, 7.0f); up.y = __builtin_amdgcn_fmed3f(up.y, -7.0f, 7.0f);
                        const f32x2 t = g * (-1.702f * 1.44269504089f);
                        f32x2 d = (f32x2){__builtin_amdgcn_exp2f(t.x), __builtin_amdgcn_exp2f(t.y)} + 1.0f;
                        const f32x2 sg = {__builtin_amdgcn_rcpf(d.x), __builtin_amdgcn_rcpf(d.y)};
                        const f32x2 h = (up + 1.0f) * g * sg;
                        a[n][j] = h.x; a[n][j + 1] = h.y; }
                u32x2 w; w.x = pk4_fp8(a[0][0], a[0][1], a[0][2], a[0][3]); w.y = pk4_fp8(a[1][0], a[1][1], a[1][2], a[1][3]);
                *(u32x2*)rowp = w; }
    }
};
struct EpiDown {
    static constexpr bool PERM = true; static constexpr int TAB_N = 512;
    bf16_t* O; const float* b_down; const float* SLW; const LAS int* cnt;
    __device__ __forceinline__ const float* tab_src(const pg8::Unit& u, int t) const {
        if (t < 256) return b_down + u.e * D + u.pn * 256 + t;
        const int r = t - 256, nvalid = __builtin_amdgcn_readfirstlane(cnt[u.e]) - u.mt * 256; return SLW + (size_t)u.e * CAP + (r < nvalid ? u.mt * 256 + r : 0); }
    __device__ __forceinline__ void operator()(const f32x4 (&acc)[2][2][4][2], const pg8::Unit& u, int wr, int wc, int fr, int fq, const LAS float* tab) const {
        const int row0 = u.pm * 256 + wr * 64 + fr, cl = wc * 32 + 8 * fq, nvalid = __builtin_amdgcn_readfirstlane(cnt[u.e]) - u.mt * 256;
        f32x4 bd[2][2]; float wsl[2][4];
#pragma unroll
        for (int bj = 0; bj < 2; ++bj)
#pragma unroll
            for (int n = 0; n < 2; ++n) bd[bj][n] = *(const LAS f32x4*)(tab + bj * 128 + cl + 4 * n);
#pragma unroll
        for (int ai = 0; ai < 2; ++ai)
#pragma unroll
            for (int m = 0; m < 4; ++m) { const int r = ai * 128 + wr * 64 + m * 16 + fr; const float w = tab[256 + r]; wsl[ai][m] = r < nvalid ? w : 0.f; }
#pragma unroll
        for (int ai = 0; ai < 2; ++ai)
#pragma unroll
            for (int m = 0; m < 4; ++m) { const int r = ai * 128 + wr * 64 + m * 16 + fr; const float w8 = wsl[ai][m];
                unsigned char* rowp = (unsigned char*)O + (size_t)(row0 + ai * 128 + m * 16) * D + u.pn * 256 + cl;
#pragma unroll
                for (int bj = 0; bj < 2; ++bj) { const f32x4 v0 = (acc[ai][bj][m][0] * W8_INV + bd[bj][0]) * w8, v1 = (acc[ai][bj][m][1] * W8_INV + bd[bj][1]) * w8;
                    u32x2 w; w.x = pk4_fp8(v0[0] * O8_SCALE, v0[1] * O8_SCALE, v0[2] * O8_SCALE, v0[3] * O8_SCALE); w.y = pk4_fp8(v1[0] * O8_SCALE, v1[1] * O8_SCALE, v1[2] * O8_SCALE, v1[3] * O8_SCALE);
                    *(u32x2*)(rowp + bj * 128) = w; } }
    }
};

struct DenseOrder {
    int nM, nN, nwg, G, c, nX; const char *A, *Bt; size_t tstep;
    __device__ __forceinline__ bool next(int i, pg8::Unit& u) const {
        long L = (long)i * G + c; if (L >= nwg + nX) return false;
        u.e = 0; u.mt = 0;
        if (L < nX) { u.pm = 64 + (int)L / 4; u.pn = 4 + (int)L % 4; return true; }
        L -= nX;
        const int wgid = pg8::xcd_remap((int)L, nwg);
        const int nig = pg8::WGM * nN, gid = wgid / nig, fm = gid * pg8::WGM, gsz = (nM - fm) < pg8::WGM ? (nM - fm) : pg8::WGM;
        u.pm = fm + ((wgid % nig) % gsz); u.pn = (wgid % nig) / gsz; return true;
    }
    __device__ __forceinline__ const char* a_base(const pg8::Unit& u) const { return A + (size_t)u.pm * tstep; }
    __device__ __forceinline__ const char* b_base(const pg8::Unit& u) const { return Bt + (size_t)u.pn * tstep; }
    __device__ __forceinline__ unsigned gather_off(const pg8::Unit&, int) const { return 0u; }
    __device__ __forceinline__ const int* tok_src(const pg8::Unit&, int) const { return nullptr; }
};
struct MoeOrder {
    const LAS int* tab; int NT, G, c, nwg; const char *A, *Bt; const int* STOK; size_t bstep_e, tstep; bool gather;
    __device__ __forceinline__ bool next(int i, pg8::Unit& u) const {
        const int x = c & 7, npx = NT / 4, ng = NT / npx, mgn = 8 / ng, ngroup = x % ng, mgroup = x / ng, nbx = (G - x + 7) >> 3, q = i * nbx + (c >> 3);
        const int til = q / npx, ti = til * mgn + mgroup; if (ti >= nwg / NT) return false;
        u.pn = ngroup * npx + (q - til * npx);
        const int sl = (int)(threadIdx.x & 63), pv = tab[17 + (sl < NE - 1 ? sl : NE - 2)];
        const int e = (int)__popcll(__ballot(sl < NE - 1 && ti >= pv));
        u.e = e; u.mt = ti - __builtin_amdgcn_readfirstlane(tab[16 + e]); u.pm = __builtin_amdgcn_readfirstlane(tab[64 + e]) + u.mt; return true;
    }
    __device__ __forceinline__ const char* a_base(const pg8::Unit& u) const { return gather ? A : A + (size_t)u.pm * tstep; }
    __device__ __forceinline__ const char* b_base(const pg8::Unit& u) const { return Bt + (size_t)u.e * bstep_e + (size_t)u.pn * tstep; }
    __device__ __forceinline__ const int* tok_src(const pg8::Unit& u, int row) const { const int idx = u.mt * 256 + row; return STOK + (size_t)u.e * CAP + (idx < __builtin_amdgcn_readfirstlane(tab[128 + u.e]) ? idx : 0); }
    __device__ __forceinline__ unsigned gather_off(const pg8::Unit& u, int row) const { return (unsigned)(*tok_src(u, row)) * (unsigned)D; }
};

__device__ __forceinline__ void transpose_item(const float* W, int K, int N, int k0, int n0, bf16_t* WT, int orow0, LAS float* scr, int lane) {
#pragma unroll 8
    for (int i = 0; i < 32; ++i) { const int kk = 2 * i + (lane >> 5); scr[kk * 33 + (lane & 31)] = W[(size_t)(k0 + kk) * N + n0 + (lane & 31)]; }
    asm volatile("s_waitcnt lgkmcnt(0)" ::: "memory");
    const int c = lane & 7;
#pragma unroll
    for (int j = 0; j < 4; ++j) { const int n = (lane >> 3) + 8 * j; const LAS float* s = scr + (8 * c) * 33 + n;
        u32x4 o; o.x = cvt_pk_bf16(s[0 * 33], s[1 * 33]); o.y = cvt_pk_bf16(s[2 * 33], s[3 * 33]); o.z = cvt_pk_bf16(s[4 * 33], s[5 * 33]); o.w = cvt_pk_bf16(s[6 * 33], s[7 * 33]);
        *(u32x4*)(WT + (size_t)(orow0 + n) * K + k0 + 8 * c) = o; }
    asm volatile("s_waitcnt lgkmcnt(0)" ::: "memory");
}

__device__ __forceinline__ void transpose_item_fp8(const float* W, int K, int N, int k0, int n0, unsigned char* WT, int orow0, LAS float* scr, int lane) {
#pragma unroll 8
    for (int i = 0; i < 64; ++i) { const int kk = 2 * i + (lane >> 5); scr[kk * 33 + (lane & 31)] = W[(size_t)(k0 + kk) * N + n0 + (lane & 31)]; }
    asm volatile("s_waitcnt lgkmcnt(0)" ::: "memory");
    const int c = lane & 7;
#pragma unroll
    for (int j = 0; j < 4; ++j) { const int n = (lane >> 3) + 8 * j; const LAS float* s = scr + (16 * c) * 33 + n;
        u32x4 o; o.x = pk4_fp8(s[0 * 33] * W8_SCALE, s[1 * 33] * W8_SCALE, s[2 * 33] * W8_SCALE, s[3 * 33] * W8_SCALE); o.y = pk4_fp8(s[4 * 33] * W8_SCALE, s[5 * 33] * W8_SCALE, s[6 * 33] * W8_SCALE, s[7 * 33] * W8_SCALE);
        o.z = pk4_fp8(s[8 * 33] * W8_SCALE, s[9 * 33] * W8_SCALE, s[10 * 33] * W8_SCALE, s[11 * 33] * W8_SCALE); o.w = pk4_fp8(s[12 * 33] * W8_SCALE, s[13 * 33] * W8_SCALE, s[14 * 33] * W8_SCALE, s[15 * 33] * W8_SCALE);
        *(u32x4*)(WT + (size_t)(orow0 + n) * K + k0 + 16 * c) = o; }
    asm volatile("s_waitcnt lgkmcnt(0)" ::: "memory");
}

__device__ __forceinline__ void ph0(Frame& F) {
    LAS float* sc = (LAS float*)(F.lds + 67584);
    LAS float* red = (LAS float*)(F.lds + 67584 + 24576);
    LAS float* scr = (LAS float*)(F.lds + F.wave * 8448);
    constexpr int I_IN = (D / 64) * (NIN / 32), I_OUT = (D / 64) * (D / 32), I_G = 32 * 8, NJOB = 128 + (I_IN + I_OUT + I_G) / 32;
    bool have_sc = false;
    for (;;) {
        __syncthreads();
        if (F.tid == 0) F.MISC[12] = atomicAdd(F.ctl + CW_Q0, 1u);
        __syncthreads();
        const int job = __builtin_amdgcn_readfirstlane((int)F.MISC[12]);
        if (job >= NJOB) break;
        if (job < 128) {
            if (!have_sc) { for (int idx = F.tid; idx < 3 * D; idx += 512) { const int r = idx >> 11, k = idx & 2047; const float v = r < 2 ? F.c[r * D + k] : F.c_ctx[k]; sc[idx] = v * fsigmoid(v); } have_sc = true; __syncthreads(); }
            const int cg = job, sub = F.lane / 24, c4 = F.lane % 24;
            f32x4 a0 = {0.f, 0.f, 0.f, 0.f}, a1 = a0, a2 = a0;
            if (F.lane < 48) {
                const float* wp = F.w_mod + (size_t)(F.wave * 2 + sub) * 12288 + cg * 96 + c4 * 4;
                for (int it = 0; it < 128; it += 8) {
                    f32x4 wv[8];
#pragma unroll
                    for (int u = 0; u < 8; ++u) wv[u] = __builtin_nontemporal_load((const f32x4*)(wp + (size_t)(it + u) * 16 * 12288));
#pragma unroll
                    for (int u = 0; u < 8; ++u) { const int k = (it + u) * 16 + F.wave * 2 + sub; a0 += sc[k] * wv[u]; a1 += sc[D + k] * wv[u]; a2 += sc[2 * D + k] * wv[u]; }
                }
                LAS float* rp = red + (F.wave * 2 + sub) * 288 + c4 * 4;
                *(LAS f32x4*)(rp) = a0; *(LAS f32x4*)(rp + 96) = a1; *(LAS f32x4*)(rp + 192) = a2;
            }
            __syncthreads();
            if (F.tid < 288) { const int r = F.tid / 96, cc = F.tid % 96; float s = F.b_mod[cg * 96 + cc];
#pragma unroll
                for (int p = 0; p < 16; ++p) s += red[p * 288 + r * 96 + cc];
                F.MOD[r * 12288 + cg * 96 + cc] = s; }
        } else {
#pragma unroll 1
            for (int q = 0; q < 4; ++q) {
                int r = (job - 128) * 32 + q * 8 + F.wave;
                if (r < I_IN) { const int nblk = NIN / 32, k0 = 64 * (r / nblk), n0 = 32 * (r % nblk); int orow0;
                    if (n0 < 3072) orow0 = n0; else if (n0 < 4096) { const int qq = n0 - 3072; orow0 = 3072 + (qq >> 7) * 256 + (qq & 127); } else { const int qq = n0 - 4096; orow0 = 3072 + (qq >> 7) * 256 + 128 + (qq & 127); }
                    transpose_item(F.w_in, D, NIN, k0, n0, F.WIN, orow0, scr, F.lane); continue; }
                r -= I_IN;
                if (r < I_OUT) { const int nblk = D / 32, k0 = 64 * (r / nblk), n0 = 32 * (r % nblk); transpose_item(F.w_out, D, D, k0, n0, F.WOUT, n0, scr, F.lane); continue; }
                r -= I_OUT;
                { const int mat = r >> 3, sub = r & 7, type = mat >> 4, dh = mat & 15; const int k0 = 64 * (sub >> 2), n0 = 32 * (sub & 3);
                  const float* W = (type ? F.lru_w_i : F.lru_w_r) + (size_t)dh * 16384; transpose_item(W, 128, 128, k0, n0, F.WG + (size_t)(type * 16 + dh) * 16384, n0, scr, F.lane); }
            }
        }
    }
}

struct CvItem { const GAS float* W; GAS unsigned char* WT; };
typedef float f32x16 __attribute__((ext_vector_type(16)));
typedef unsigned u32x6 __attribute__((ext_vector_type(6)));
constexpr int CV6_NSTRIP = 2 * 32 * 64, CV6_FQ_PITCH = 1040, CV6_TILE_BYTES = 4 * CV6_FQ_PITCH * 4;
__device__ __forceinline__ u32x6 cvt_fp6_32(const float (&v)[32], const float scale) {
    f32x16 p, q;
#pragma unroll
    for (int i = 0; i < 16; ++i) { p[i] = v[i] * scale; q[i] = v[16 + i] * scale; }
    return __builtin_amdgcn_cvt_scalef32_2xpk16_fp6_f32(p, q, 1.0f);
}
__device__ __forceinline__ CvItem cv6_decode(Frame& F, int strip, int kt) {
    const int which = strip >> 11, e = (strip >> 6) & 31, n0 = 32 * (strip & 63);
    const unsigned long long m0 = which == 0 ? ~0ull : 0ull;
    const unsigned long long wsel = ((unsigned long long)F.w_gate & m0) | ((unsigned long long)F.w_up & ~m0);
    const int orow0 = (n0 >> 7) * 256 + which * 128 + (n0 & 127);
    CvItem c; c.W = (const GAS float*)wsel + (size_t)e * D * FF + (size_t)(128 * kt) * 2048 + n0;
    c.WT = (GAS unsigned char*)F.WGU + (size_t)e * 4096 * D + (size_t)orow0 * 2048 + kt * 128;
    return c;
}
__device__ __forceinline__ void cv6_load(const CvItem& c, int lane, f32x4 (&v)[16]) {
    const GAS float* p = c.W + (size_t)(lane >> 3) * 2048 + 4 * (lane & 7);
#pragma unroll
    for (int i = 0; i < 16; ++i) v[i] = __builtin_nontemporal_load((const GAS f32x4*)(p + (size_t)(8 * i) * 2048));
}
__device__ __forceinline__ void cv6_store(const CvItem& c, int lane, const f32x4 (&v)[16], LAS float* scr) {
    const int r8 = lane >> 3, c4 = lane & 7;
    LAS float* wb = scr + (r8 >> 2) * 128 + 4 * c4 + (r8 & 3);
#pragma unroll
    for (int i = 0; i < 16; ++i)
#pragma unroll
        for (int nn = 0; nn < 4; ++nn) wb[(i >> 2) * CV6_FQ_PITCH + 2 * (i & 3) * 128 + 32 * nn] = v[i][nn];
    asm volatile("s_waitcnt lgkmcnt(0)" ::: "memory");
#pragma unroll
    for (int rd = 0; rd < 2; ++rd) {
        const int npp = 16 * rd + (lane >> 2), fq = lane & 3;
        const LAS float* rb = scr + fq * CV6_FQ_PITCH + 4 * npp;
        float f[32];
#pragma unroll
        for (int j = 0; j < 8; ++j) { const f32x4 t = *(const LAS f32x4*)(rb + j * 128); f[4 * j] = t.x; f[4 * j + 1] = t.y; f[4 * j + 2] = t.z; f[4 * j + 3] = t.w; }
        const u32x6 pk = cvt_fp6_32(f, W8_SCALE);
        const unsigned lo4 = (unsigned)__builtin_amdgcn_update_dpp(0, (int)pk[4], 0x114, 0xf, 0xf, false), lo5 = (unsigned)__builtin_amdgcn_update_dpp(0, (int)pk[5], 0x114, 0xf, 0xf, false);
        const unsigned hi4 = (unsigned)__builtin_amdgcn_update_dpp(0, (int)pk[4], 0x104, 0xf, 0xf, false), hi5 = (unsigned)__builtin_amdgcn_update_dpp(0, (int)pk[5], 0x104, 0xf, 0xf, false);
        const bool odd = (npp & 1) != 0;
        const int na = odd ? npp - 1 : npp, nb = odd ? npp : npp + 1;
        GAS unsigned char* oa = c.WT + (size_t)(4 * (na & 7) + (na >> 3)) * 2048 + 16 * fq + (odd ? 64 : 0);
        GAS unsigned char* ob = c.WT + (size_t)(4 * (nb & 7) + (nb >> 3)) * 2048 + 16 * fq + (odd ? 0 : 64);
        const u32x4 f1 = {pk[0], pk[1], pk[2], pk[3]}, slo = {lo4, lo5, lo4, lo5}, shi = {hi4, hi5, hi4, hi5};
        __builtin_nontemporal_store(odd ? slo : f1, (GAS u32x4*)oa);
        __builtin_nontemporal_store(odd ? f1 : shi, (GAS u32x4*)ob);
    }
    asm volatile("s_waitcnt lgkmcnt(0)" ::: "memory");
}
__device__ __forceinline__ int cv6_claim(Frame& F) { int s = 0; if (F.lane == 0) s = (int)atomicAdd(F.ctl + CW_QCV6, 1u); return __builtin_amdgcn_readfirstlane(s); }
__device__ __forceinline__ void ph_expert_conv6(Frame& F) {
    LAS float* scr = (LAS float*)(F.lds + F.wave * CV6_TILE_BYTES);
    int sc = cv6_claim(F), kb = 0;
    if (sc >= CV6_NSTRIP) return;
    f32x4 va[16], vb[16];
    cv6_load(cv6_decode(F, sc, kb), F.lane, va);
    for (;;) {
        int s1 = sc, k1 = kb + 1; if (k1 == 16) { s1 = cv6_claim(F); k1 = 0; }
        const bool h1 = s1 < CV6_NSTRIP;
        cv6_load(cv6_decode(F, h1 ? s1 : sc, h1 ? k1 : kb), F.lane, vb);
        cv6_store(cv6_decode(F, sc, kb), F.lane, va, scr);
        if (!h1) break;
        int s2 = s1, k2 = k1 + 1; if (k2 == 16) { s2 = cv6_claim(F); k2 = 0; }
        const bool h2 = s2 < CV6_NSTRIP;
        cv6_load(cv6_decode(F, h2 ? s2 : s1, h2 ? k2 : k1), F.lane, va);
        cv6_store(cv6_decode(F, s1, k1), F.lane, vb, scr);
        if (!h2) break;
        sc = s2; kb = k2;
    }
}

constexpr int CV_PK = 132, CV_TILE_BYTES = 8 * CV_PK * 4, CV_NSTRIP = 32 * 64, CV_KB = 16;
__device__ __forceinline__ CvItem cv_decode(Frame& F, int strip, int kb) {
    const int which = 2, e = (strip >> 6) & 31, n0 = 32 * (strip & 63), k0 = 128 * kb;
    const unsigned long long m0 = which == 0 ? ~0ull : 0ull, m1 = which == 1 ? ~0ull : 0ull, m2 = which == 2 ? ~0ull : 0ull;
    const unsigned long long wsel = ((unsigned long long)F.w_gate & m0) | ((unsigned long long)F.w_up & m1) | ((unsigned long long)F.w_down & m2);
    const unsigned long long osel = ((unsigned long long)F.WGU & (m0 | m1)) | ((unsigned long long)F.WDN & m2);
    const int orow0 = which == 2 ? n0 : (n0 >> 7) * 256 + which * 128 + (n0 & 127);
    const size_t ebytes = which == 2 ? (size_t)D * FF : (size_t)4096 * D;
    CvItem c; c.W = (const GAS float*)wsel + (size_t)e * D * FF + (size_t)k0 * 2048 + n0;
    c.WT = (GAS unsigned char*)osel + (size_t)e * ebytes + (size_t)orow0 * 2048 + k0;
    return c;
}
__device__ __forceinline__ void cv_load(const CvItem& c, int lane, f32x4 (&v)[16]) {
    const GAS float* p = c.W + (size_t)(lane >> 3) * 2048 + 4 * (lane & 7);
#pragma unroll
    for (int i = 0; i < 16; ++i) v[i] = __builtin_nontemporal_load((const GAS f32x4*)(p + (size_t)(8 * i) * 2048));
}
__device__ __forceinline__ void cv_store(const CvItem& c, int lane, const f32x4 (&v)[16], LAS float* scr) {
    LAS unsigned* sb = (LAS unsigned*)scr;
    const int r8 = lane >> 3, c4 = lane & 7;
#pragma unroll
    for (int i = 0; i < 16; ++i) { const f32x4 w = v[i] * W8_SCALE; sb[c4 * CV_PK + 8 * i + r8] = pk4_fp8(w.x, w.y, w.z, w.w); }
    asm volatile("s_waitcnt lgkmcnt(0)" ::: "memory");
    const int n4 = lane >> 3, kb = lane & 7;
    u32x4 dq[4];
#pragma unroll
    for (int g = 0; g < 4; ++g) dq[g] = *(const LAS u32x4*)(sb + n4 * CV_PK + 16 * kb + 4 * g);
    u32x4 o[4];
#pragma unroll
    for (int g = 0; g < 4; ++g) {
        const unsigned lo01 = __builtin_amdgcn_perm(dq[g].y, dq[g].x, 0x05010400u), hi01 = __builtin_amdgcn_perm(dq[g].y, dq[g].x, 0x07030602u);
        const unsigned lo23 = __builtin_amdgcn_perm(dq[g].w, dq[g].z, 0x05010400u), hi23 = __builtin_amdgcn_perm(dq[g].w, dq[g].z, 0x07030602u);
        o[0][g] = __builtin_amdgcn_perm(lo23, lo01, 0x05040100u); o[1][g] = __builtin_amdgcn_perm(lo23, lo01, 0x07060302u);
        o[2][g] = __builtin_amdgcn_perm(hi23, hi01, 0x05040100u); o[3][g] = __builtin_amdgcn_perm(hi23, hi01, 0x07060302u);
    }
#pragma unroll
    for (int j = 0; j < 4; ++j) __builtin_nontemporal_store(o[j], (GAS u32x4*)(c.WT + (size_t)(4 * n4 + j) * 2048 + 16 * kb));
    asm volatile("s_waitcnt lgkmcnt(0)" ::: "memory");
}
__device__ __forceinline__ int cv_claim(Frame& F) { int s = 0; if (F.lane == 0) s = (int)atomicAdd(F.ctl + CW_QCV, 1u); return __builtin_amdgcn_readfirstlane(s); }
__device__ __forceinline__ void ph_expert_conv(Frame& F) {
    LAS float* scr = (LAS float*)(F.lds + F.wave * CV6_TILE_BYTES);
    int sc = cv_claim(F), kb = 0;
    if (sc >= CV_NSTRIP) return;
    f32x4 va[16], vb[16];
    cv_load(cv_decode(F, sc, kb), F.lane, va);
    for (;;) {
        int s1 = sc, k1 = kb + 1; if (k1 == CV_KB) { s1 = cv_claim(F); k1 = 0; }
        const bool h1 = s1 < CV_NSTRIP;
        cv_load(cv_decode(F, h1 ? s1 : sc, h1 ? k1 : kb), F.lane, vb);
        cv_store(cv_decode(F, sc, kb), F.lane, va, scr);
        if (!h1) break;
        int s2 = s1, k2 = k1 + 1; if (k2 == CV_KB) { s2 = cv_claim(F); k2 = 0; }
        const bool h2 = s2 < CV_NSTRIP;
        cv_load(cv_decode(F, h2 ? s2 : s1, h2 ? k2 : k1), F.lane, va);
        cv_store(cv_decode(F, s1, k1), F.lane, vb, scr);
        if (!h2) break;
        sc = s2; kb = k2;
    }
}

constexpr int AT_STRIDE = 4112;
__device__ __forceinline__ void ph1(Frame& F) {
    LAS float* Ac = (LAS float*)F.lds; LAS float* Bc = Ac + D;
    const int gw = F.bid * 8 + F.wave, NGW = F.nb * 8;
    for (int seg = 0; seg < 3; ++seg) {
        __syncthreads();
        for (int cc = F.tid; cc < D; cc += 512) { const float sh = F.MOD[seg * 12288 + cc], sl = F.MOD[seg * 12288 + D + cc]; Ac[cc] = F.g_mix[cc] * (1.0f + sl); Bc[cc] = sh; }
        __syncthreads();
        if (seg < 2) {
            const float* in = F.x + (size_t)seg * SEQ * D; bf16_t* outp = F.XN + (size_t)(seg * SEQ) * D;
            for (int m = gw; m < SEQ; m += NGW) {
                const f32x4* xr = (const f32x4*)(in + (size_t)m * D) + F.lane; f32x4 v[8]; float s = 0.f;
#pragma unroll
                for (int j = 0; j < 8; ++j) { v[j] = __builtin_nontemporal_load(xr + 64 * j); s += (v[j].x * v[j].x + v[j].y * v[j].y) + (v[j].z * v[j].z + v[j].w * v[j].w); }
                const float rstd = 1.0f / sqrtf(wave_sum(s) * (1.0f / D) + EPS);
                unsigned long long* o8 = (unsigned long long*)(outp + (size_t)m * D) + F.lane;
#pragma unroll
                for (int j = 0; j < 8; ++j) { const f32x4 a = *(const LAS f32x4*)(Ac + 4 * (F.lane + 64 * j)), b = *(const LAS f32x4*)(Bc + 4 * (F.lane + 64 * j)); const f32x4 o = v[j] * rstd * a + b;
                    o8[64 * j] = (unsigned long long)cvt_pk_bf16(o.x, o.y) | ((unsigned long long)cvt_pk_bf16(o.z, o.w) << 32); }
            }
        } else {
            LAS unsigned char* AT = F.lds + 16384; LAS float* RED = (LAS float*)(F.lds + 16384 + 16 * AT_STRIDE + 256);
            for (int u = F.bid; u < 256; u += F.nb) {
                const int rg = u >> 3, cg = u & 7;
                __syncthreads();
#pragma unroll 1
                for (int rr = 0; rr < 2; ++rr) { const int r = F.wave * 2 + rr;
                    const f32x4* xr = (const f32x4*)(F.ctx + (size_t)(16 * rg + r) * D) + F.lane; f32x4 v[8]; float s = 0.f;
#pragma unroll
                    for (int j = 0; j < 8; ++j) { v[j] = xr[64 * j]; s += (v[j].x * v[j].x + v[j].y * v[j].y) + (v[j].z * v[j].z + v[j].w * v[j].w); }
                    const float rstd = 1.0f / sqrtf(wave_sum(s) * (1.0f / D) + EPS);
#pragma unroll
                    for (int j = 0; j < 8; ++j) { const f32x4 a = *(const LAS f32x4*)(Ac + 4 * (F.lane + 64 * j)), b = *(const LAS f32x4*)(Bc + 4 * (F.lane + 64 * j)); const f32x4 o = v[j] * rstd * a + b;
                        u32x2 w; w.x = cvt_pk_bf16(o.x, o.y); w.y = cvt_pk_bf16(o.z, o.w); *(LAS u32x2*)(AT + r * AT_STRIDE + 8 * (F.lane + 64 * j)) = w; } }
                __syncthreads();
                const int c16 = F.lane & 15, q = F.lane >> 4;
                f32x4 acc[8];
#pragma unroll
                for (int n = 0; n < 8; ++n) acc[n] = (f32x4){0.f, 0.f, 0.f, 0.f};
                const bf16_t* wb = F.WIN + (size_t)(DA + 128 * cg + c16) * D + 256 * F.wave + 8 * q;
#pragma unroll 2
                for (int ks = 0; ks < 8; ++ks) {
                    const bf16x8 af = *(const LAS bf16x8*)(AT + c16 * AT_STRIDE + (256 * F.wave + 32 * ks + 8 * q) * 2);
                    bf16x8 bfr[8];
#pragma unroll
                    for (int n = 0; n < 8; ++n) bfr[n] = *(const bf16x8*)(wb + (size_t)(16 * n) * D + 32 * ks);
#pragma unroll
                    for (int n = 0; n < 8; ++n) acc[n] = __builtin_amdgcn_mfma_f32_16x16x32_bf16(af, bfr[n], acc[n], 0, 0, 0);
                }
#pragma unroll
                for (int n = 0; n < 8; ++n)
#pragma unroll
                    for (int rg4 = 0; rg4 < 4; ++rg4) RED[(F.wave * 16 + 4 * q + rg4) * 128 + 16 * n + c16] = acc[n][rg4];
                __syncthreads();
                { const int tok = F.tid >> 5, c4 = (F.tid & 31) * 4; f32x4 sum = {0.f, 0.f, 0.f, 0.f};
#pragma unroll
                  for (int w = 0; w < 8; ++w) sum += *(const LAS f32x4*)(RED + (w * 16 + tok) * 128 + c4);
                  u32x2 o; o.x = cvt_pk_bf16(sum.x, sum.y); o.y = cvt_pk_bf16(sum.z, sum.w);
                  *(u32x2*)(F.XA + (size_t)(T + 16 * rg + tok) * DA + 128 * cg + c4) = o; }
            }
        }
    }
}

constexpr int XCT_STRIDE = 272;
template <bool FINAL>
__device__ __forceinline__ void gates_phase(Frame& F, const int nrep) {
    LAS unsigned char* xcT = F.lds; LAS unsigned char* hsT = F.lds + 64 * XCT_STRIDE;
    const int h = F.bid & 7, kb0 = F.bid >> 3, kstride = (F.nb - h + 7) >> 3;
    const int NU = FINAL ? 256 : 2 * NCHUNK;
    const int c16 = F.lane & 15, q = F.lane >> 4, jrow = F.wave * 16 + c16, ch = h * 128 + jrow;
    bf16x8 bfr[4][4];
#pragma unroll
    for (int ks = 0; ks < 4; ++ks)
#pragma unroll
        for (int td = 0; td < 4; ++td) bfr[ks][td] = *(const bf16x8*)(F.WG + (size_t)((td * 8 + h) * 128 + jrow) * 128 + ks * 32 + q * 8);
    const float brf = F.lru_b_r[ch], brb = F.lru_b_r[DA + ch], bif = F.lru_b_i[ch], bib = F.lru_b_i[DA + ch];
    const float cff = -8.0f * log1pf(expf(-F.lru_lam[ch])), cfb = -8.0f * log1pf(expf(-F.lru_lam[DA + ch]));
    const int cg = F.tid & 15, tok0 = F.tid >> 4, chc = h * 128 + cg * 8;
    LAS float* CW = (LAS float*)(F.lds + 128 * XCT_STRIDE);
    for (int i = F.tid; i < 640; i += 512) CW[i] = i < 512 ? F.conv_a_w[(i >> 7) * DA + h * 128 + (i & 127)] : F.conv_a_b[h * 128 + (i - 512)];
    u32x4 xr[2][4];
#define GU_DECODE(k, b_, ci_, grow0_, t0_, seqlen_) const int b_ = (k) / (FINAL ? 128 : NCHUNK), ci_ = (k) % (FINAL ? 128 : NCHUNK); \
        const bool ctxu_ = !FINAL && ci_ < 4; const int t0_ = ctxu_ ? ci_ * 64 : (FINAL ? ci_ : ci_ - 4) * 64, seqlen_ = ctxu_ ? CTXL : SEQ, grow0_ = ctxu_ ? T + b_ * CTXL + t0_ : b_ * SEQ + t0_;
#define GU_LOAD(k) do { GU_DECODE(k, b_, ci_, grow0_, t0_, seqlen_) (void)ci_; \
        _Pragma("unroll") for (int it = 0; it < 2; ++it) _Pragma("unroll") for (int kk = 0; kk < 4; ++kk) { const int tt = t0_ + tok0 + 32 * it + kk - 2; \
            xr[it][kk] = (tt >= 0 && tt < seqlen_) ? *(const u32x4*)(F.XA + (size_t)(grow0_ + tok0 + 32 * it + kk - 2) * DA + chc) : (u32x4){0u, 0u, 0u, 0u}; } } while (0)
#pragma unroll 1
    for (int rep = 0; rep < nrep; ++rep) {
    int k = kb0;
    if (k < NU) GU_LOAD(k);
    for (; k < NU; k += kstride) {
        GU_DECODE(k, b, ci, grow0, t0, seqlen) (void)t0; (void)seqlen;
        __syncthreads();
#pragma unroll
        for (int it = 0; it < 2; ++it) { f32x4 a0 = *(const LAS f32x4*)(CW + 512 + cg * 8), a1 = *(const LAS f32x4*)(CW + 512 + cg * 8 + 4);
#pragma unroll
            for (int kk = 0; kk < 4; ++kk) { float xf[8]; unpack8(xr[it][kk], xf); a0 += *(const LAS f32x4*)(CW + kk * 128 + cg * 8) * (f32x4){xf[0], xf[1], xf[2], xf[3]}; a1 += *(const LAS f32x4*)(CW + kk * 128 + cg * 8 + 4) * (f32x4){xf[4], xf[5], xf[6], xf[7]}; }
            u32x4 o; o.x = cvt_pk_bf16(a0.x, a0.y); o.y = cvt_pk_bf16(a0.z, a0.w); o.z = cvt_pk_bf16(a1.x, a1.y); o.w = cvt_pk_bf16(a1.z, a1.w);
            *(LAS u32x4*)(xcT + (tok0 + 32 * it) * XCT_STRIDE + cg * 16) = o; }
        { const int kn = k + kstride; if (kn < NU) GU_LOAD(kn); }
        __syncthreads();
        f32x4 acc[4][4];
#pragma unroll
        for (int m = 0; m < 4; ++m)
#pragma unroll
            for (int td = 0; td < 4; ++td) acc[m][td] = (f32x4){0.f, 0.f, 0.f, 0.f};
#pragma unroll
        for (int ks = 0; ks < 4; ++ks) {
#pragma unroll
            for (int m = 0; m < 4; ++m) { const int arow = 16 * (c16 >> 2) + 4 * m + (c16 & 3); const bf16x8 af = *(const LAS bf16x8*)(xcT + arow * XCT_STRIDE + (ks * 32 + q * 8) * 2);
#pragma unroll
                for (int td = 0; td < 4; ++td) acc[m][td] = __builtin_amdgcn_mfma_f32_16x16x32_bf16(af, bfr[ks][td], acc[m][td], 0, 0, 0); }
        }
#pragma unroll
        for (int m = 0; m < 4; ++m)
#pragma unroll
            for (int rg = 0; rg < 4; ++rg) { const int tok = 16 * q + 4 * m + rg; const float xcv = __uint_as_float((unsigned)(*(const LAS unsigned short*)(xcT + tok * XCT_STRIDE + jrow * 2)) << 16);
                { float ao, bo; gate_pair(acc[m][0][rg] + brf, acc[m][2][rg] + bif, cff, xcv, ao, bo); acc[m][0][rg] = ao; acc[m][2][rg] = bo; }
                { float ao, bo; gate_pair(acc[m][1][rg] + brb, acc[m][3][rg] + bib, cfb, xcv, ao, bo); acc[m][1][rg] = ao; acc[m][3][rg] = bo; } }
        float Af = 1.f, Bf = 0.f, Ab = 1.f, Bb = 0.f;
#pragma unroll
        for (int m = 0; m < 4; ++m)
#pragma unroll
            for (int rg = 0; rg < 4; ++rg) { Bf = acc[m][0][rg] * Bf + acc[m][2][rg]; Af *= acc[m][0][rg]; }
#pragma unroll
        for (int m = 3; m >= 0; --m)
#pragma unroll
            for (int rg = 3; rg >= 0; --rg) { Bb = acc[m][1][rg] * Bb + acc[m][3][rg]; Ab *= acc[m][1][rg]; }
        float A_[4], B_[4], Ab_[4], Bb_[4];
#pragma unroll
        for (int qq = 0; qq < 4; ++qq) { A_[qq] = __shfl(Af, c16 + 16 * qq); B_[qq] = __shfl(Bf, c16 + 16 * qq); Ab_[qq] = __shfl(Ab, c16 + 16 * qq); Bb_[qq] = __shfl(Bb, c16 + 16 * qq); }
        if constexpr (!FINAL) {
            const float At = (A_[0] * A_[1]) * (A_[2] * A_[3]), Bt = ((B_[0] * A_[1] + B_[1]) * A_[2] + B_[2]) * A_[3] + B_[3];
            const float Abt = (Ab_[0] * Ab_[1]) * (Ab_[2] * Ab_[3]), Bbt = ((Bb_[3] * Ab_[2] + Bb_[2]) * Ab_[1] + Bb_[1]) * Ab_[0] + Bb_[0];
            if (q == 0) { F.AGG[(size_t)((0 * 2 + b) * NCHUNK + ci) * DA + ch] = (f32x2){At, Bt}; F.AGG[(size_t)((1 * 2 + b) * NCHUNK + ci) * DA + ch] = (f32x2){Abt, Bbt}; }
        } else {
            float hf = F.HIN[(size_t)((0 * 2 + b) * 128 + ci) * DA + ch], hb = F.HIN[(size_t)((1 * 2 + b) * 128 + ci) * DA + ch];
#pragma unroll
            for (int qq = 0; qq < 4; ++qq) hf = (qq < q) ? A_[qq] * hf + B_[qq] : hf;
#pragma unroll
            for (int qq = 3; qq >= 0; --qq) hb = (qq > q) ? Ab_[qq] * hb + Bb_[qq] : hb;
            float hs[4][4]; float hh = hf;
#pragma unroll
            for (int m = 0; m < 4; ++m)
#pragma unroll
                for (int rg = 0; rg < 4; ++rg) { hh = acc[m][0][rg] * hh + acc[m][2][rg]; hs[m][rg] = hh; }
            hh = hb;
#pragma unroll
            for (int m = 3; m >= 0; --m)
#pragma unroll
                for (int rg = 3; rg >= 0; --rg) { hh = acc[m][1][rg] * hh + acc[m][3][rg]; hs[m][rg] += hh; }
#pragma unroll
            for (int m = 0; m < 4; ++m)
#pragma unroll
                for (int rg = 0; rg < 4; ++rg) { const int tok = 16 * q + 4 * m + rg; *(LAS unsigned short*)(hsT + tok * XCT_STRIDE + jrow * 2) = (unsigned short)(cvt_pk_bf16(hs[m][rg], 0.f) & 0xffffu); }
            __syncthreads();
#pragma unroll
            for (int it = 0; it < 2; ++it) { const int tok = tok0 + 32 * it; *(u32x4*)(F.HS + (size_t)(grow0 + tok) * DA + chc) = *(const LAS u32x4*)(hsT + tok * XCT_STRIDE + cg * 16); }
        }
    }
    }
#undef GU_DECODE
#undef GU_LOAD
}
__device__ __forceinline__ void ph4(Frame& F) {
    LAS f32x2* G = (LAS f32x2*)F.lds;
    for (int u = F.bid; u < 128; u += F.nb) {
        const int dir = u >> 6, b = (u >> 5) & 1, ch = (u & 31) * 32 + (F.tid & 31), g = F.tid >> 5;
        const f32x2* ag = F.AGG + (size_t)((dir * 2 + b) * NCHUNK) * DA + ch; float* hin = F.HIN + (size_t)((dir * 2 + b) * 128) * DA + ch;
        f32x2 v[12]; float A = 1.f, B = 0.f;
        __syncthreads();
        if (g < 11) {
#pragma unroll
            for (int j = 0; j < 12; ++j) { const int p = g * 12 + j, cidx = dir == 0 ? p : (p < 4 ? 3 - p : 135 - p); v[j] = ag[(size_t)cidx * DA]; }
#pragma unroll
            for (int j = 0; j < 12; ++j) { B = v[j].x * B + v[j].y; A *= v[j].x; }
            G[g * 32 + (F.tid & 31)] = (f32x2){A, B};
        }
        __syncthreads();
        if (g < 11) {
            float hcur = 0.f;
            for (int gg = 0; gg < g; ++gg) { const f32x2 t = G[gg * 32 + (F.tid & 31)]; hcur = t.x * hcur + t.y; }
#pragma unroll
            for (int j = 0; j < 12; ++j) { const int p = g * 12 + j, cidx = dir == 0 ? p : (p < 4 ? 3 - p : 135 - p); if (cidx >= 4) hin[(size_t)(cidx - 4) * DA] = hcur; hcur = v[j].x * hcur + v[j].y; }
        }
    }
}
__device__ __forceinline__ void p5b_load(Frame& F, int t, int c0, int c1, u32x4 (&v)[12]) {
    const int tl = t & (SEQ - 1), col = tl & 63, grow = tl >> 6; const size_t ro = (size_t)t * DA; const u32x4 zero = {0u, 0u, 0u, 0u};
    v[0] = __builtin_nontemporal_load((const u32x4*)(F.Gb + ro + c0)); v[1] = __builtin_nontemporal_load((const u32x4*)(F.Gb + ro + c1)); v[2] = __builtin_nontemporal_load((const u32x4*)(F.HS + ro + c0)); v[3] = __builtin_nontemporal_load((const u32x4*)(F.HS + ro + c1));
    v[4] = __builtin_nontemporal_load((const u32x4*)(F.BB + ro + c0)); v[5] = __builtin_nontemporal_load((const u32x4*)(F.BB + ro + c1)); v[6] = *(const u32x4*)(F.P + ro + c0); v[7] = *(const u32x4*)(F.P + ro + c1);
    v[8] = col > 0 ? *(const u32x4*)(F.P + ro - DA + c0) : zero; v[9] = col < 63 ? *(const u32x4*)(F.P + ro + DA + c0) : zero;
    v[10] = grow > 0 ? *(const u32x4*)(F.P + ro - 64 * DA + c1) : zero; v[11] = grow < 127 ? *(const u32x4*)(F.P + ro + 64 * DA + c1) : zero;
}
__device__ __forceinline__ void p5b_item(Frame& F, int t, int c0, int c1, const u32x4 (&v)[12], const f32x4 (&wa)[2][2], const f32x4 (&wb)[2][2], const f32x4 (&w0)[2][2], const f32x4 (&w1)[2][2], const f32x4 (&w2)[2][2]) {
    float ya[2][8], yb[2][8]; float sa = 0.f, sb = 0.f;
#pragma unroll
    for (int cc = 0; cc < 2; ++cc) { float gg[8], hh[8]; unpack8(v[cc], gg); unpack8(v[2 + cc], hh);
#pragma unroll
        for (int j = 0; j < 8; ++j) { const float y = gg[j] * hh[j]; sa += y * y; ya[cc][j] = y * wa[cc][j >> 2][j & 3]; } }
#pragma unroll
    for (int cc = 0; cc < 2; ++cc) { float bq[8], a[8], m[8], p[8]; unpack8(v[4 + cc], bq); unpack8(v[6 + cc], a); unpack8(v[8 + 2 * cc], m); unpack8(v[9 + 2 * cc], p);
#pragma unroll
        for (int j = 0; j < 8; ++j) { const float y = bq[j] * (w0[cc][j >> 2][j & 3] * m[j] + w1[cc][j >> 2][j & 3] * a[j] + w2[cc][j >> 2][j & 3] * p[j]); sb += y * y; yb[cc][j] = y * wb[cc][j >> 2][j & 3]; } }
    sa = wave_sum(sa); sb = wave_sum(sb);
    const float ra = 1.0f / sqrtf(sa * (1.0f / DA) + EPS), rb = 1.0f / sqrtf(sb * (1.0f / DA) + EPS);
    bf16_t* yo = F.Y + (size_t)t * D;
#pragma unroll
    for (int cc = 0; cc < 2; ++cc) { const int c = cc ? c1 : c0; u32x4 o;
        o.x = cvt_pk_bf16(ya[cc][0] * ra, ya[cc][1] * ra); o.y = cvt_pk_bf16(ya[cc][2] * ra, ya[cc][3] * ra); o.z = cvt_pk_bf16(ya[cc][4] * ra, ya[cc][5] * ra); o.w = cvt_pk_bf16(ya[cc][6] * ra, ya[cc][7] * ra);
        *(u32x4*)(yo + c) = o;
        o.x = cvt_pk_bf16(yb[cc][0] * rb, yb[cc][1] * rb); o.y = cvt_pk_bf16(yb[cc][2] * rb, yb[cc][3] * rb); o.z = cvt_pk_bf16(yb[cc][4] * rb, yb[cc][5] * rb); o.w = cvt_pk_bf16(yb[cc][6] * rb, yb[cc][7] * rb);
        *(u32x4*)(yo + DA + c) = o; }
}
__device__ __forceinline__ void ph5b(Frame& F) {
    const int gw = F.bid * 8 + F.wave, NGW = F.nb * 8, c0 = 8 * F.lane, c1 = 512 + 8 * F.lane;
    if (gw >= T) return;
    f32x4 wa[2][2], wb[2][2], w0[2][2], w1[2][2], w2[2][2];
#pragma unroll
    for (int cc = 0; cc < 2; ++cc)
#pragma unroll
        for (int hh = 0; hh < 2; ++hh) { const int c = (cc ? c1 : c0) + 4 * hh; wa[cc][hh] = *(const f32x4*)(F.g_out_a + c); wb[cc][hh] = *(const f32x4*)(F.g_out_b + c);
            w0[cc][hh] = *(const f32x4*)(F.conv_b_w + c); w1[cc][hh] = *(const f32x4*)(F.conv_b_w + DA + c); w2[cc][hh] = *(const f32x4*)(F.conv_b_w + 2 * DA + c); }
    u32x4 va[12], vb[12]; int t = gw;
    p5b_load(F, t, c0, c1, va);
    for (;;) {
        const int t1 = t + NGW; const bool h1 = t1 < T;
        p5b_load(F, h1 ? t1 : t, c0, c1, vb);
        p5b_item(F, t, c0, c1, va, wa, wb, w0, w1, w2);
        if (!h1) break;
        const int t2 = t1 + NGW; const bool h2 = t2 < T;
        p5b_load(F, h2 ? t2 : t1, c0, c1, va);
        p5b_item(F, t1, c0, c1, vb, wa, wb, w0, w1, w2);
        if (!h2) break;
        t = t2;
    }
}

constexpr int XT_STRIDE = 2052;
__device__ __forceinline__ void ph7(Frame& F) {
    LAS float* Ac = (LAS float*)F.lds; LAS float* Bc = Ac + D; LAS float* XT = (LAS float*)(F.lds + 16384); LAS float* RED = XT; LAS float* LG = (LAS float*)(F.lds + 16384 + 16 * XT_STRIDE * 4);
    int curb = -1;
    for (int g = F.bid; g < T / 16; g += F.nb) {
        const int row0 = 16 * g, b = row0 >> 13;
        __syncthreads();
        if (b != curb) { for (int cc = F.tid; cc < D; cc += 512) { const float sh = F.MOD[b * 12288 + 6144 + cc], sl = F.MOD[b * 12288 + 8192 + cc]; Ac[cc] = F.g_ffn[cc] * (1.0f + sl); Bc[cc] = sh; } curb = b; __syncthreads(); }
#pragma unroll 1
        for (int rr = 0; rr < 2; ++rr) { const int r = F.wave * 2 + rr; const size_t row = (size_t)row0 + r;
            const f32x4* xr = (const f32x4*)(F.x + row * D) + F.lane; const u32x2* mr = (const u32x2*)(F.XN + row * D) + F.lane; f32x4 v[8]; float s = 0.f;
#pragma unroll
            for (int j = 0; j < 8; ++j) { const u32x2 mw = __builtin_nontemporal_load(mr + 64 * j); v[j] = __builtin_nontemporal_load(xr + 64 * j) + (f32x4){bf_lo(mw.x), bf_hi(mw.x), bf_lo(mw.y), bf_hi(mw.y)}; s += (v[j].x * v[j].x + v[j].y * v[j].y) + (v[j].z * v[j].z + v[j].w * v[j].w); }
            const float rstd = 1.0f / sqrtf(wave_sum(s) * (1.0f / D) + EPS);
            unsigned char* o6 = F.XN2 + row * D + (F.lane >> 2) * 128 + (F.lane & 3) * 16;
            u32x2* x1o = (u32x2*)(F.Y + row * D) + F.lane;
#pragma unroll
            for (int j = 0; j < 8; ++j) { u32x2 xw; xw.x = cvt_pk_bf16(v[j].x, v[j].y); xw.y = cvt_pk_bf16(v[j].z, v[j].w); __builtin_nontemporal_store(xw, x1o + 64 * j); }
#pragma unroll
            for (int j = 0; j < 8; ++j) { const f32x4 a = *(const LAS f32x4*)(Ac + 4 * (F.lane + 64 * j)), bq = *(const LAS f32x4*)(Bc + 4 * (F.lane + 64 * j)); const f32x4 o = v[j] * rstd * a + bq;
                v[j] = o;
                *(LAS f32x4*)(XT + r * XT_STRIDE + 4 * (F.lane + 64 * j)) = o; }
            { float fv[32];
#pragma unroll
              for (int j = 0; j < 8; ++j) { const f32x4 t = *(const LAS f32x4*)(XT + r * XT_STRIDE + 32 * F.lane + 4 * j); fv[4 * j] = t.x; fv[4 * j + 1] = t.y; fv[4 * j + 2] = t.z; fv[4 * j + 3] = t.w; }
              const u32x6 pk = cvt_fp6_32(fv, X6_SCALE);
              *(u32x4*)o6 = (u32x4){pk[0], pk[1], pk[2], pk[3]}; *(u32x4*)(o6 + 64) = (u32x4){pk[4], pk[5], pk[4], pk[5]}; }
        }
        __syncthreads();
        {
            const int r = F.lane & 15, q = F.lane >> 4; f32x4 acc0 = {0.f, 0.f, 0.f, 0.f}, acc1 = acc0;
#pragma unroll 8
            for (int i = 0; i < 16; ++i) { const int kb = 256 * F.wave + 16 * i + 4 * q; const f32x4 a4 = *(const LAS f32x4*)(XT + r * XT_STRIDE + kb);
#pragma unroll
                for (int u = 0; u < 4; ++u) { const float b0 = F.w_router[(kb + u) * NE + r], b1 = F.w_router[(kb + u) * NE + 16 + r];
                    acc0 = __builtin_amdgcn_mfma_f32_16x16x4f32(a4[u], b0, acc0, 0, 0, 0); acc1 = __builtin_amdgcn_mfma_f32_16x16x4f32(a4[u], b1, acc1, 0, 0, 0); } }
            __syncthreads();
#pragma unroll
            for (int rg = 0; rg < 4; ++rg) { RED[(F.wave * 16 + 4 * q + rg) * 32 + r] = acc0[rg]; RED[(F.wave * 16 + 4 * q + rg) * 32 + 16 + r] = acc1[rg]; }
        }
        __syncthreads();
        { const int tok = F.tid >> 5, e = F.tid & 31; float s = F.b_router[e];
#pragma unroll
          for (int w = 0; w < 8; ++w) s += RED[(w * 16 + tok) * 32 + e];
          LG[tok * 33 + e] = s; }
        __syncthreads();
        if (F.tid < 16) { const int tok = F.tid; unsigned taken = 0u; float tv[4]; int te[4];
#pragma unroll
            for (int k = 0; k < 4; ++k) { float best = -3.0e38f; int bi = 0;
                for (int e = 0; e < NE; ++e) { const float v = LG[tok * 33 + e]; if (!((taken >> e) & 1u) && v > best) { best = v; bi = e; } }
                taken |= 1u << bi; tv[k] = best; te[k] = bi; }
            float ex[4], sum = 0.f;
#pragma unroll
            for (int k = 0; k < 4; ++k) { ex[k] = expf(tv[k] - tv[0]); sum += ex[k]; }
            const float inv = 1.0f / sum; const int token = row0 + tok;
            unsigned rank[4];
#pragma unroll
            for (int k = 0; k < 4; ++k) rank[k] = atomicAdd(F.CNT + te[k], 1u);
#pragma unroll
            for (int k = 0; k < 4; ++k) { F.STOK[(size_t)te[k] * CAP + rank[k]] = token; F.SLW[(size_t)te[k] * CAP + rank[k]] = ex[k] * inv; F.ER[token * 4 + k] = (unsigned)te[k] | (rank[k] << 8); }
        }
    }
}
__device__ __forceinline__ void moe_tables(Frame& F) {
    __syncthreads();
    if (F.tid < 64) {
        const int e = F.tid, c = e < NE ? (int)F.CNT[e] : 0, tl = (c + 255) >> 8;
        int incl = tl;
#pragma unroll
        for (int d = 1; d < NE; d <<= 1) { const int o = __shfl_up(incl, d); if (e >= d) incl += o; }
        if (e < NE) { F.MISC[128 + e] = (unsigned)c; F.MISC[16 + e] = (unsigned)(incl - tl); F.MISC[64 + e] = (unsigned)(incl - tl); }
        if (e == NE - 1) { F.MISC[16 + NE] = (unsigned)incl; F.MISC[64 + NE] = (unsigned)incl; }
    }
    __syncthreads();
}
__device__ __forceinline__ void ph11(Frame& F) {
    LAS float* GT = (LAS float*)F.lds; LAS float* GF = GT + 2 * D;
    for (int cc = F.tid; cc < D; cc += 512) { GT[cc] = F.MOD[10240 + cc]; GT[D + cc] = F.MOD[12288 + 10240 + cc]; GF[cc] = F.g_final[cc]; }
    moe_tables(F);
    const int gw = F.bid * 8 + F.wave, NGW = F.nb * 8;
    u32x4 ern = gw < T ? *(const u32x4*)(F.ER + (size_t)gw * 4) : (u32x4){0u, 0u, 0u, 0u};
    for (int t = gw; t < T; t += NGW) {
        const int b = t >> 13; size_t pos[4]; const u32x4 erc = ern;
        { const int tn = t + NGW; ern = *(const u32x4*)(F.ER + (size_t)(tn < T ? tn : t) * 4); }
#pragma unroll
        for (int k = 0; k < 4; ++k) { const unsigned er = erc[k]; pos[k] = ((size_t)F.MISC[64 + (er & 255u)] << 8) + (er >> 8); }
        float x2[4][8]; float ssq = 0.f;
#pragma unroll
        for (int j = 0; j < 4; ++j) { const int col = 8 * (F.lane + 64 * j);
            const u32x4 mw = __builtin_nontemporal_load((const u32x4*)(F.Y + (size_t)t * D + col));
            const f32x4 xa = {bf_lo(mw.x), bf_hi(mw.x), bf_lo(mw.y), bf_hi(mw.y)}, xb = {bf_lo(mw.z), bf_hi(mw.z), bf_lo(mw.w), bf_hi(mw.w)};
            float s8[8] = {0.f, 0.f, 0.f, 0.f, 0.f, 0.f, 0.f, 0.f};
#pragma unroll
            for (int k = 0; k < 4; ++k) { const u32x2 ov = __builtin_nontemporal_load((const u32x2*)((const unsigned char*)F.O + pos[k] * D + col));
                const f32x2 q0 = __builtin_amdgcn_cvt_pk_f32_fp8((int)ov.x, false), q1 = __builtin_amdgcn_cvt_pk_f32_fp8((int)ov.x, true), q2 = __builtin_amdgcn_cvt_pk_f32_fp8((int)ov.y, false), q3 = __builtin_amdgcn_cvt_pk_f32_fp8((int)ov.y, true);
                s8[0] += q0.x; s8[1] += q0.y; s8[2] += q1.x; s8[3] += q1.y; s8[4] += q2.x; s8[5] += q2.y; s8[6] += q3.x; s8[7] += q3.y; }
#pragma unroll
            for (int i = 0; i < 8; ++i) s8[i] *= O8_INV;
            const f32x4 ga = *(const LAS f32x4*)(GT + b * D + col), gb = *(const LAS f32x4*)(GT + b * D + col + 4);
            x2[j][0] = xa.x + ga.x * s8[0]; x2[j][1] = xa.y + ga.y * s8[1]; x2[j][2] = xa.z + ga.z * s8[2]; x2[j][3] = xa.w + ga.w * s8[3];
            x2[j][4] = xb.x + gb.x * s8[4]; x2[j][5] = xb.y + gb.y * s8[5]; x2[j][6] = xb.z + gb.z * s8[6]; x2[j][7] = xb.w + gb.w * s8[7];
#pragma unroll
            for (int i = 0; i < 8; ++i) ssq += x2[j][i] * x2[j][i]; }
        const float rstd = 1.0f / sqrtf(wave_sum(ssq) * (1.0f / D) + EPS);
#pragma unroll
        for (int j = 0; j < 4; ++j) { const int col = 8 * (F.lane + 64 * j); const f32x4 fa = *(const LAS f32x4*)(GF + col), fb = *(const LAS f32x4*)(GF + col + 4);
            __builtin_nontemporal_store((f32x4){x2[j][0] * rstd * fa.x, x2[j][1] * rstd * fa.y, x2[j][2] * rstd * fa.z, x2[j][3] * rstd * fa.w}, (f32x4*)(F.out + (size_t)t * D + col));
            __builtin_nontemporal_store((f32x4){x2[j][4] * rstd * fb.x, x2[j][5] * rstd * fb.y, x2[j][6] * rstd * fb.z, x2[j][7] * rstd * fb.w}, (f32x4*)(F.out + (size_t)t * D + col + 4)); }
    }
}

struct Args { const float* in[29]; float* out; unsigned char* ws; int ph_lo, ph_hi, li, pad; };
__global__ void __launch_bounds__(512, 2) fwd_kernel(Args args) {
    extern __shared__ __attribute__((aligned(16))) unsigned char lds[];
    Frame F;
    F.lds = (LAS unsigned char*)lds; F.MISC = (volatile LAS unsigned*)(F.lds + MISC_OFF);
    F.tid = threadIdx.x; F.lane = F.tid & 63; F.wave = __builtin_amdgcn_readfirstlane(F.tid >> 6); F.G = gridDim.x;
    unsigned char* ws = args.ws;
    F.ctl = (unsigned*)(ws + WS_CTL);
    F.x = args.in[0]; F.c = args.in[1]; F.ctx = args.in[2]; F.c_ctx = args.in[3]; F.w_mod = args.in[4]; F.b_mod = args.in[5]; F.g_mix = args.in[6]; F.w_in = args.in[7];
    F.conv_a_w = args.in[8]; F.conv_a_b = args.in[9]; F.lru_w_r = args.in[10]; F.lru_b_r = args.in[11]; F.lru_w_i = args.in[12]; F.lru_b_i = args.in[13]; F.lru_lam = args.in[14];
    F.conv_b_w = args.in[15]; F.g_out_a = args.in[16]; F.g_out_b = args.in[17]; F.w_out = args.in[18]; F.g_ffn = args.in[19]; F.w_router = args.in[20]; F.b_router = args.in[21];
    F.w_gate = args.in[22]; F.b_gate = args.in[23]; F.w_up = args.in[24]; F.b_up = args.in[25]; F.w_down = args.in[26]; F.b_down = args.in[27]; F.g_final = args.in[28];
    F.out = args.out;
    F.MOD = (float*)(ws + WS_MOD); F.WG = (bf16_t*)(ws + WS_WG); F.WIN = (bf16_t*)(ws + WS_WIN); F.WOUT = (bf16_t*)(ws + WS_WOUT); F.XN = (bf16_t*)(ws + WS_XN); F.Gb = (bf16_t*)(ws + WS_G);
    F.XA = (bf16_t*)(ws + WS_XA); F.BB = (bf16_t*)(ws + WS_BB); F.P = (bf16_t*)(ws + WS_P); F.Y = (bf16_t*)(ws + WS_Y); F.WGU = (bf16_t*)(ws + WS_WGU); F.WDN = (bf16_t*)(ws + WS_WDN);
    F.H = (bf16_t*)(ws + WS_H); F.O = (bf16_t*)(ws + WS_O); F.AGG = (f32x2*)(ws + WS_AGG); F.HIN = (float*)(ws + WS_HIN); F.ER = (unsigned*)(ws + WS_ER); F.STOK = (int*)(ws + WS_STOK);
    F.SLW = (float*)(ws + WS_SLW); F.CNT = F.ctl + CW_CNT; F.HS = (bf16_t*)(ws + WS_HS); F.XN2 = ws + WS_XN2;
    for (int u = F.tid; u < (LDS_BYTES - MISC_OFF) / 4; u += 512) F.MISC[u] = 0u;
    __syncthreads();
    const bool split = (F.G % 64) == 0 && NC8 > 0;
    const int row8 = (int)blockIdx.x >> 3;
    const bool conv_role = split && ((row8 & 7) < NC8);
    const int Gm = split ? (F.G / 8) * (8 - NC8) : F.G, Gc = split ? (F.G / 8) * NC8 : F.G;
    const int cm = split ? ((int)blockIdx.x & 7) + 8 * ((row8 >> 3) * (8 - NC8) + ((row8 & 7) - NC8)) : (int)blockIdx.x;
    const int cc = split ? ((int)blockIdx.x & 7) + 8 * ((row8 >> 3) * NC8 + (row8 & 7)) : (int)blockIdx.x;
    XcdBarrier bar = xcd_barrier_post(F.ctl + CW_BAR, F.MISC + 8, (unsigned)F.G, true);
    XcdBarrier barM = xcd_barrier_post(F.ctl + CW_BARM, F.MISC + 10, (unsigned)Gm, !conv_role);
#ifndef PH_MASK
#define PH_MASK 0xFFF
#endif
#define IN(k) ((PH_MASK >> (k)) & 1)
#define REP(k) ((REPEAT_MASK >> (k)) & 1)
#define NREP(k) (1 + (REP(k) ? args.pad : 0))

    if (conv_role) {
        F.bid = cc; F.nb = Gc;
        if (IN(8)) { ph_expert_conv6(F); ph_expert_conv(F); }
    } else {
        F.bid = cm; F.nb = Gm;
        if (IN(0)) ph0(F);
        xcd_barrier(barM);
        if (IN(1)) ph1(F);
        xcd_barrier(barM);
        if (IN(2)) {
            DenseOrder S; S.nM = 64; S.nN = 20; S.nwg = 1280; S.G = Gm; S.c = cm; S.nX = 0; S.A = (const char*)F.XN; S.Bt = (const char*)F.WIN; S.tstep = (size_t)256 * D * 2;
            EpiInProj E{args.ws, F.P};
            pg8::gemm_phase<EpiInProj, DenseOrder, false, true, true, false>(F.lds, D, S, E);
        }
        if (IN(8)) { ph_expert_conv6(F); ph_expert_conv(F); }
    }
    F.bid = blockIdx.x; F.nb = F.G;
    xcd_barrier(bar);
    if (IN(3)) { gates_phase<false>(F, NREP(3)); } xcd_barrier(bar);
    if (IN(4)) { for (int r = 0; r < NREP(4); ++r) { if (r) xcd_barrier(bar); ph4(F); } } xcd_barrier(bar);
    if (IN(5)) { gates_phase<true>(F, NREP(5)); } xcd_barrier(bar);
    if (IN(5)) { for (int r = 0; r < NREP(7); ++r) { if (r) xcd_barrier(bar); ph5b(F); } } xcd_barrier(bar);
    if (IN(6)) {
        DenseOrder S; S.nM = 64; S.nN = 8; S.nwg = 512; S.G = F.G; S.c = blockIdx.x; S.nX = 0; S.A = (const char*)F.Y; S.Bt = (const char*)F.WOUT; S.tstep = (size_t)256 * D * 2;
        EpiOutProj E{F.XN, F.MOD};
        for (int r = 0; r < NREP(6); ++r) { if (r) xcd_barrier(bar); pg8::gemm_phase<EpiOutProj, DenseOrder, false, true, true, false>(F.lds, D, S, E); }
    } xcd_barrier(bar);
    if (IN(7)) { ph7(F); } xcd_barrier(bar);
    if (IN(9)) {
        moe_tables(F);
        MoeOrder S; S.tab = (const LAS int*)F.MISC; S.NT = 16; S.G = F.G; S.c = blockIdx.x; S.nwg = __builtin_amdgcn_readfirstlane((int)F.MISC[16 + NE]) * 16; S.A = (const char*)F.XN2; S.Bt = (const char*)F.WGU; S.STOK = F.STOK;
        S.bstep_e = (size_t)4096 * D; S.tstep = (size_t)256 * D; S.gather = true;
        EpiGU E{F.H, F.b_gate, F.b_up};
        for (int r = 0; r < NREP(9); ++r) { if (r) xcd_barrier(bar); pg8::gemm_phase<EpiGU, MoeOrder, true, true, true, true, true>(F.lds, D / 2, S, E); }
    } xcd_barrier(bar);
    if (IN(10)) {
        moe_tables(F);
        MoeOrder S; S.tab = (const LAS int*)F.MISC; S.NT = 8; S.G = F.G; S.c = blockIdx.x; S.nwg = __builtin_amdgcn_readfirstlane((int)F.MISC[16 + NE]) * 8; S.A = (const char*)F.H; S.Bt = (const char*)F.WDN; S.STOK = F.STOK;
        S.bstep_e = (size_t)D * FF; S.tstep = (size_t)256 * FF; S.gather = false;
        EpiDown E{F.O, F.b_down, F.SLW, (const LAS int*)F.MISC + 128};
        for (int r = 0; r < NREP(10); ++r) { if (r) xcd_barrier(bar); pg8::gemm_phase<EpiDown, MoeOrder, false, true, true, true>(F.lds, FF / 2, S, E); }
    } xcd_barrier(bar);
    if (IN(11)) { ph11(F); }
#undef IN
#undef REP
}

extern "C" void kernel_launch(void* const* d_in, const int* in_sizes, int n_in, void* d_out, int out_size, void* d_ws, size_t ws_size, hipStream_t stream) {
    static int grid = 0;
    if (grid == 0) {
        if (n_in != 29 || in_sizes[0] != T * D || out_size != T * D || ws_size < WS_END) { fprintf(stderr, "kernel_launch: unexpected shapes (n_in %d, in0 %d, out %d, ws %zu); nothing launched\n", n_in, n_in > 0 ? in_sizes[0] : -1, out_size, ws_size); grid = -1; return; }
        int dev = 0, cus = 0, per_cu = 0;
        if (hipGetDevice(&dev) != hipSuccess || hipDeviceGetAttribute(&cus, hipDeviceAttributeMultiprocessorCount, dev) != hipSuccess) { grid = -1; return; }
        if (hipFuncSetAttribute((const void*)fwd_kernel, hipFuncAttributeMaxDynamicSharedMemorySize, LDS_BYTES) != hipSuccess) { fprintf(stderr, "kernel_launch: hipFuncSetAttribute failed\n"); grid = -1; return; }
        if (hipOccupancyMaxActiveBlocksPerMultiprocessor(&per_cu, (const void*)fwd_kernel, 512, LDS_BYTES) != hipSuccess || per_cu < 1) fprintf(stderr, "kernel_launch: occupancy query reports %d\n", per_cu);
        (void)hipGetLastError();
        grid = cus;
    }
    if (grid < 0) return;
    (void)hipMemsetAsync((char*)d_ws + WS_CTL, 0, CTL_ZERO_BYTES, stream);
    Args a{};
    for (int i = 0; i < 29; ++i) a.in[i] = (const float*)d_in[i];
    a.out = (float*)d_out; a.ws = (unsigned char*)d_ws;
    a.ph_lo = 0; a.ph_hi = NPH; a.li = 0; a.pad = REPEAT_MASK ? 1 : 0; hipLaunchKernelGGL(fwd_kernel, dim3(grid), dim3(512), LDS_BYTES, stream, a);
}
```

```cpp
#include <hip/hip_runtime.h>
#include <cstdio>
#include <cstdint>
#include <type_traits>

#ifndef MK_N_LAUNCHES
#define MK_N_LAUNCHES 1
#endif

#define GAS __attribute__((address_space(1)))
#define LAS __attribute__((address_space(3)))
typedef unsigned short bf16_t;
typedef short bf16x8 __attribute__((ext_vector_type(8)));
typedef float f32x4 __attribute__((ext_vector_type(4)));
typedef float f32x2 __attribute__((ext_vector_type(2)));
typedef unsigned u32x4 __attribute__((ext_vector_type(4)));
typedef unsigned u32x2 __attribute__((ext_vector_type(2)));

constexpr int T = 16384, SEQ = 8192, D = 2048, DA = 1024, NIN = 5120, CTXL = 256, NCTX = 512, MROWS = T + NCTX;
constexpr int NE = 32, FF = 2048, CAP = 16384, HROWS = 73728;
constexpr int NCHUNK = 132;
constexpr float EPS = 1e-6f;
constexpr int NPH = 12;
constexpr int N_LAUNCHES = MK_N_LAUNCHES;
#ifndef REPEAT_MASK
#define REPEAT_MASK 0
#endif
#ifndef MK_NC8
#define MK_NC8 3
#endif
constexpr int NC8 = MK_NC8;

constexpr size_t MiB = 1u << 20;
constexpr size_t WS_CTL = 0, CTL_ZERO_BYTES = 1 * MiB;
constexpr size_t WS_MOD = 1 * MiB;
constexpr size_t WS_WG = 2 * MiB;
constexpr size_t WS_WIN = 4 * MiB;
constexpr size_t WS_WOUT = 24 * MiB;
constexpr size_t WS_AGG = 32 * MiB;
constexpr size_t WS_HIN = 38 * MiB;
constexpr size_t WS_ER = 40 * MiB;
constexpr size_t WS_STOK = 41 * MiB;
constexpr size_t WS_SLW = 43 * MiB;
constexpr size_t WS_XN = 48 * MiB;
constexpr size_t WS_G = 116 * MiB;
constexpr size_t WS_XA = 148 * MiB;
constexpr size_t WS_BB = 182 * MiB;
constexpr size_t WS_P = 214 * MiB;
constexpr size_t WS_Y = 246 * MiB;
constexpr size_t WS_WGU = 320 * MiB;
constexpr size_t WS_WDN = 832 * MiB;
constexpr size_t WS_H = 1088 * MiB;
constexpr size_t WS_O = 1376 * MiB;
constexpr size_t WS_HS = 1664 * MiB;
constexpr size_t WS_XN2 = 1696 * MiB;
constexpr size_t WS_END = 1728 * MiB;
constexpr int CW_CNT = 64;
constexpr int CW_BAR = 4096;
constexpr int CW_BARM = 8192;
constexpr int CW_Q0 = 96;
constexpr int CW_QCV6 = 224;
constexpr int CW_QCV = 160;

constexpr int LDS_BYTES = 155648;
constexpr int MISC_OFF = 154624;

__device__ __forceinline__ unsigned cvt_pk_bf16(float lo, float hi) { unsigned r; asm volatile("v_cvt_pk_bf16_f32 %0, %1, %2" : "=v"(r) : "v"(lo), "v"(hi)); return r; }
constexpr float X6_SCALE = 1.5f, GU_INV = 1.0f / 96.0f;
constexpr float W8_SCALE = 64.0f, W8_INV = 1.0f / 64.0f, O8_SCALE = 16.0f, O8_INV = 1.0f / 16.0f;
__device__ __forceinline__ unsigned pk4_fp8(float a, float b, float c, float d) { int w = 0; w = __builtin_amdgcn_cvt_pk_fp8_f32(a, b, w, false); w = __builtin_amdgcn_cvt_pk_fp8_f32(c, d, w, true); return (unsigned)w; }
__device__ __forceinline__ float bf_lo(unsigned w) { return __uint_as_float(w << 16); }
__device__ __forceinline__ float bf_hi(unsigned w) { return __uint_as_float(w & 0xffff0000u); }
__device__ __forceinline__ float fexp(float x) { return __builtin_amdgcn_exp2f(x * 1.44269504089f); }
__device__ __forceinline__ float fsigmoid(float x) { return __builtin_amdgcn_rcpf(1.0f + fexp(-x)); }
__device__ __forceinline__ float gelu_tanh(float x) { const float u = 0.7978845608028654f * (x + 0.044715f * x * x * x); return x * __builtin_amdgcn_rcpf(1.0f + fexp(-2.0f * u)); }
__device__ __forceinline__ float one_minus_exp(float u) { const float ser = -u * (1.0f + 0.5f * u * (1.0f + (1.0f / 3.0f) * u * (1.0f + 0.25f * u))); const float dir = 1.0f - fexp(u); return u > -0.05f ? ser : dir; }
__device__ __forceinline__ void gate_pair(float xr, float xi, float cf, float xc, float& a_out, float& b_out) {
    const float er = 1.0f + fexp(-fmaxf(xr, -30.0f)), ei = 1.0f + fexp(-fmaxf(xi, -30.0f)), inv = __builtin_amdgcn_rcpf(er * ei);
    const float r = inv * ei, ig = inv * er, la = cf * r, a = fexp(la), u = 2.0f * la;
    const float ser = -u * (1.0f + 0.5f * u * (1.0f + (1.0f / 3.0f) * u * (1.0f + 0.25f * u))), dir = 1.0f - a * a;
    a_out = a; b_out = __builtin_amdgcn_sqrtf(u > -0.05f ? ser : dir) * ig * xc;
}
__device__ __forceinline__ float wave_sum(float v) {
#pragma unroll
    for (int o = 1; o < 64; o <<= 1) v += __shfl_xor(v, o);
    return v;
}
__device__ __forceinline__ void unpack8(const u32x4 w, float (&f)[8]) { f[0] = bf_lo(w.x); f[1] = bf_hi(w.x); f[2] = bf_lo(w.y); f[3] = bf_hi(w.y); f[4] = bf_lo(w.z); f[5] = bf_hi(w.z); f[6] = bf_lo(w.w); f[7] = bf_hi(w.w); }

namespace pg8 {
#define PG8_LAS __attribute__((address_space(3)))
constexpr int BM = 256, BK = 64, HALF = 128, HTB = HALF * BK * 2, STAGE_BYTES = 8 * HTB, NXCD = 8, WGM = 8;
__host__ __device__ __forceinline__ int lds_byte(int r, int c) { const int st = (r >> 4) * 2 + (c >> 5), rr = r & 15, cc = c & 31, ob = rr * 64 + cc * 2; return st * 1024 + (ob ^ (((ob >> 9) & 1) << 5)); }
__host__ __device__ __forceinline__ void stage_rc(int b, int& R, int& C) { const int st = b / 1024, sb = b % 1024, swz = sb ^ (((sb >> 9) & 1) << 5); R = (st >> 1) * 16 + swz / 64; C = (st & 1) * 32 + (swz % 64) / 2; }
__host__ __device__ __forceinline__ int perm32(int rho) { const int n = rho >> 4, i = rho & 15; return 8 * (i >> 2) + 4 * n + (i & 3); }

struct Unit { int pm, pn, e, mt; };

__device__ __forceinline__ int xcd_remap(int L, int nwg) { const int q = nwg / NXCD, r = nwg % NXCD, xcd = L % NXCD, off = L / NXCD; return (xcd < r ? xcd * (q + 1) : r * (q + 1) + (xcd - r) * q) + off; }

typedef int i32x4 __attribute__((ext_vector_type(4)));
typedef int i32x8 __attribute__((ext_vector_type(8)));
__device__ __forceinline__ i32x8 cat8(const bf16x8 a, const bf16x8 b) { return __builtin_shufflevector(__builtin_bit_cast(i32x4, a), __builtin_bit_cast(i32x4, b), 0, 1, 2, 3, 4, 5, 6, 7); }
__device__ __forceinline__ void mfma_fp8(f32x4& acc, const i32x8 a, const i32x8 b, const int sc) {
    (void)sc; asm volatile("v_mfma_f32_16x16x128_f8f6f4 %0, %1, %2, %0" : "+v"(acc) : "v"(a), "v"(b)); }
typedef int i32x6 __attribute__((ext_vector_type(6)));
typedef int i32x2 __attribute__((ext_vector_type(2)));
__device__ __forceinline__ void mfma_fp6(f32x4& acc, const i32x6 a, const i32x6 b) { asm volatile("v_mfma_f32_16x16x128_f8f6f4 %0, %1, %2, %0 cbsz:2 blgp:2" : "+v"(acc) : "v"(a), "v"(b)); }
__device__ __forceinline__ i32x6 cat6(const bf16x8 a, const i32x2 b) { return __builtin_shufflevector(__builtin_bit_cast(i32x4, a), __builtin_shufflevector(b, b, 0, 1, -1, -1), 0, 1, 2, 3, 4, 5); }
template <int OFF> __device__ __forceinline__ i32x2 lds_rd64(const PG8_LAS unsigned char* p) { i32x2 r; asm volatile("ds_read_b64 %0, %1 offset:%2" : "=v"(r) : "v"(p), "n"(OFF)); return r; }
template <class Epi, class Sched, bool GATHER, bool ALIGN_EPI, bool SP2, bool FP8, bool FP6 = false>
__device__ __forceinline__ void gemm_phase(PG8_LAS unsigned char* lds, const int K, const Sched& S, const Epi& E) {
    int tid = threadIdx.x; asm volatile("" : "+v"(tid));
    const int wid = __builtin_amdgcn_readfirstlane(tid >> 6), lane = tid & 63, wr = wid >> 2, wc = wid & 3, fr = lane & 15, fq = lane >> 4;
    const int nt = K / BK;
    int Rr[2], Cc[2]; unsigned voffB[2]; unsigned vAc[2][2], vAn[2][2];
#pragma unroll
    for (int i = 0; i < 2; ++i) { stage_rc(tid * 16 + i * 8192, Rr[i], Cc[i]); const int Rb = Epi::PERM ? ((Rr[i] & ~31) + perm32(Rr[i] & 31)) : Rr[i];
        voffB[i] = (unsigned)(Rb * K + Cc[i]) * 2u; }
    const size_t kstep = (size_t)(BK * 2);
    const size_t hstep = (size_t)HALF * K * 2;
    const unsigned ldsw = (unsigned)wid * 1024u;
    const int aoff = lds_byte(wr * 64 + fr, fq * 8), boff = lds_byte(wc * 32 + fr, fq * 8);
    const int dup8 = 8 * ((fr >> 2) & 1);
#define PG8_SA(b, h) (((b) * 2 + (h)) * HTB)
#define PG8_SB(b, h) ((4 + (b) * 2 + (h)) * HTB)
#define PG8_STAGE(bufoff, gbase, voff) do { _Pragma("unroll") for (int _i = 0; _i < 2; ++_i) \
        __builtin_amdgcn_global_load_lds((const unsigned*)((const char*)(gbase) + (voff)[_i]), (PG8_LAS unsigned*)(lds + (bufoff) + ldsw + _i * 8192), 16, 0, 0); } while (0)
#define PG8_STAGE_A(bufoff, gbase, VO, h) do { if constexpr (GATHER) { PG8_STAGE(bufoff, gbase, (VO)[h]); } else { PG8_STAGE(bufoff, (gbase) + (h) * hstep, (VO)[0]); } } while (0)
#define PG8_LDA(dst, b, h) do { _Pragma("unroll") for (int m = 0; m < 4; ++m) dst[m] = *(const PG8_LAS bf16x8*)(lds + PG8_SA(b, h) + aoff + m * 2048); \
        if constexpr (FP6) { dst##2[0] = rd2<PG8_SA(b, h) + 1024>(lds + aoff + dup8); dst##2[1] = rd2<PG8_SA(b, h) + 3072>(lds + aoff + dup8); dst##2[2] = rd2<PG8_SA(b, h) + 5120>(lds + aoff + dup8); dst##2[3] = rd2<PG8_SA(b, h) + 7168>(lds + aoff + dup8); } \
        else { _Pragma("unroll") for (int m = 0; m < 4; ++m) dst##2[m] = rd2v(lds + PG8_SA(b, h) + aoff + m * 2048 + 1024); } } while (0)
#define PG8_LDB(dst, b, h) do { _Pragma("unroll") for (int n = 0; n < 2; ++n) dst[n] = *(const PG8_LAS bf16x8*)(lds + PG8_SB(b, h) + boff + n * 2048); \
        if constexpr (FP6) { dst##2[0] = rd2<PG8_SB(b, h) - 65536 + 1024>(lds + 65536 + boff + dup8); dst##2[1] = rd2<PG8_SB(b, h) - 65536 + 3072>(lds + 65536 + boff + dup8); } \
        else { _Pragma("unroll") for (int n = 0; n < 2; ++n) dst##2[n] = rd2v(lds + PG8_SB(b, h) + boff + n * 2048 + 1024); } } while (0)
#define PG8_MMA(ai, bj, At, Bt) do { __builtin_amdgcn_s_setprio(1); _Pragma("unroll") for (int m = 0; m < 4; ++m) _Pragma("unroll") for (int n = 0; n < 2; ++n) { \
        if constexpr (FP6) mfma_fp6(acc[ai][bj][m][n], cat6(Bt[n], Bt##2[n]), cat6(At[m], At##2[m])); \
        else if constexpr (FP8) mfma_fp8(acc[ai][bj][m][n], cat8(Bt[n], Bt##2[n]), cat8(At[m], At##2[m]), sc1); \
        else { acc[ai][bj][m][n] = __builtin_amdgcn_mfma_f32_16x16x32_bf16(Bt[n], At[m], acc[ai][bj][m][n], 0, 0, 0); acc[ai][bj][m][n] = __builtin_amdgcn_mfma_f32_16x16x32_bf16(Bt##2[n], At##2[m], acc[ai][bj][m][n], 0, 0, 0); } } __builtin_amdgcn_s_setprio(0); } while (0)
#define PG8_WAIT_V(n) asm volatile("s_waitcnt vmcnt(" #n ")" ::: "memory")
#define PG8_WAIT_L(n) asm volatile("s_waitcnt lgkmcnt(" #n ")" ::: "memory")
#define PG8_BAR __builtin_amdgcn_s_barrier()
#define PG8_SCHED __builtin_amdgcn_sched_barrier(0)
    int sc1 = 0x7F7F7F7F; asm volatile("" : "+v"(sc1));
    Unit cur, nxt; int ui = 0;
    if (!S.next(0, cur)) return;
    f32x4 acc[2][2][4][2];
#pragma unroll
    for (int a = 0; a < 2; ++a)
#pragma unroll
        for (int b = 0; b < 2; ++b)
#pragma unroll
            for (int m = 0; m < 4; ++m)
#pragma unroll
                for (int n = 0; n < 2; ++n) acc[a][b][m][n] = (f32x4){0.f, 0.f, 0.f, 0.f};
    using S2 = typename std::conditional<FP6, i32x2, bf16x8>::type;
    auto rd2v = [](const PG8_LAS unsigned char* p) -> S2 { return *(const PG8_LAS S2*)p; };
#define rd2 lds_rd64
    bf16x8 At[4], B0[2], B1[2]; S2 At2[4], B02[2], B12[2];
    const char* cA = S.a_base(cur); const char* cB = S.b_base(cur);
#pragma unroll
    for (int h = 0; h < 2; ++h)
#pragma unroll
        for (int i = 0; i < 2; ++i) { if constexpr (GATHER) vAc[h][i] = S.gather_off(cur, Rr[i] + HALF * h) + (unsigned)Cc[i] * 2u; else vAc[h][i] = (unsigned)(Rr[i] * K + Cc[i]) * 2u; vAn[h][i] = vAc[h][i]; }
    if constexpr (SP2) {
        PG8_STAGE(PG8_SB(0, 0), cB, voffB); PG8_STAGE(PG8_SB(0, 1), cB + hstep, voffB); PG8_STAGE_A(PG8_SA(0, 0), cA, vAc, 0); PG8_STAGE_A(PG8_SA(0, 1), cA, vAc, 1);
        if (wr == 1) PG8_BAR;
        PG8_WAIT_V(2); PG8_BAR;
        PG8_STAGE(PG8_SB(1, 0), cB + kstep, voffB); PG8_STAGE_A(PG8_SA(1, 0), cA + kstep, vAc, 0); PG8_STAGE(PG8_SB(1, 1), cB + hstep + kstep, voffB);
        PG8_WAIT_V(6); PG8_BAR;
    } else {
        PG8_STAGE(PG8_SB(0, 0), cB, voffB); PG8_STAGE_A(PG8_SA(0, 0), cA, vAc, 0); PG8_STAGE(PG8_SB(0, 1), cB + hstep, voffB); PG8_STAGE_A(PG8_SA(0, 1), cA, vAc, 1);
        if (wr == 1) PG8_BAR;
        PG8_WAIT_V(4); PG8_BAR;
        PG8_STAGE(PG8_SB(1, 0), cB + kstep, voffB); PG8_STAGE_A(PG8_SA(1, 0), cA + kstep, vAc, 0); PG8_STAGE(PG8_SB(1, 1), cB + hstep + kstep, voffB);
        PG8_WAIT_V(6); PG8_BAR;
    }
    for (;;) {
        const bool has_next = S.next(ui + 1, nxt);
        const char* nA = has_next ? S.a_base(nxt) : cA; const char* nB = has_next ? S.b_base(nxt) : cB;
        if constexpr (Epi::TAB_N > 0) { if (wid < Epi::TAB_N / 64) __builtin_amdgcn_global_load_lds((const unsigned*)E.tab_src(cur, tid), (PG8_LAS unsigned*)(lds + STAGE_BYTES + 1024 + (ui & 1) * 2048 + wid * 256), 4, 0, 0); }
        if constexpr (GATHER) { if (has_next && wid < 4) __builtin_amdgcn_global_load_lds((const unsigned*)S.tok_src(nxt, tid), (PG8_LAS unsigned*)(lds + STAGE_BYTES + wid * 256), 4, 0, 0); }
        for (int t = 0; t < nt; t += 2) {
            const bool last = (t == nt - 2);
            const char* a1 = cA + (size_t)(t + 1) * kstep;
            const char* a2 = last ? nA : cA + (size_t)(t + 2) * kstep; const char* b2 = last ? nB : cB + (size_t)(t + 2) * kstep;
            const char* a3 = a2 + kstep; const char* b3 = b2 + kstep;
            if constexpr (GATHER) { if (last && has_next) {
#pragma unroll
                for (int h = 0; h < 2; ++h)
#pragma unroll
                    for (int i = 0; i < 2; ++i) vAn[h][i] = *(const PG8_LAS unsigned*)(lds + STAGE_BYTES + 4 * (Rr[i] + HALF * h)) * (unsigned)(K * 2) + (unsigned)Cc[i] * 2u; } }
            unsigned v2[2][2];
#pragma unroll
            for (int h = 0; h < 2; ++h)
#pragma unroll
                for (int i = 0; i < 2; ++i) v2[h][i] = GATHER ? (last ? vAn[h][i] : vAc[h][i]) : vAc[0][i];
            if constexpr (SP2) {
            PG8_LDB(B0, 0, 0); PG8_LDB(B1, 0, 1); PG8_SCHED; PG8_LDA(At, 0, 0); PG8_STAGE_A(PG8_SA(1, 1), a1, vAc, 1);
            PG8_WAIT_V(8); PG8_WAIT_L(0); PG8_BAR; PG8_MMA(0, 0, At, B0); PG8_MMA(0, 1, At, B1); PG8_BAR; PG8_SCHED;
            PG8_LDA(At, 0, 1); PG8_STAGE(PG8_SB(0, 0), b2, voffB); PG8_STAGE(PG8_SB(0, 1), b2 + hstep, voffB); PG8_STAGE_A(PG8_SA(0, 0), a2, v2, 0);
            PG8_WAIT_V(8); PG8_WAIT_L(0); PG8_BAR; PG8_MMA(1, 0, At, B0); PG8_MMA(1, 1, At, B1); PG8_BAR; PG8_SCHED;
            PG8_LDB(B0, 1, 0); PG8_LDB(B1, 1, 1); PG8_SCHED; PG8_LDA(At, 1, 0); PG8_STAGE_A(PG8_SA(0, 1), a2, v2, 1);
            PG8_WAIT_V(8); PG8_WAIT_L(0); PG8_BAR; PG8_MMA(0, 0, At, B0); PG8_MMA(0, 1, At, B1); PG8_BAR; PG8_SCHED;
            PG8_LDA(At, 1, 1); PG8_STAGE(PG8_SB(1, 0), b3, voffB); PG8_STAGE(PG8_SB(1, 1), b3 + hstep, voffB); PG8_STAGE_A(PG8_SA(1, 0), a3, v2, 0);
            PG8_WAIT_V(8); PG8_WAIT_L(0); PG8_BAR; PG8_MMA(1, 0, At, B0); PG8_MMA(1, 1, At, B1); PG8_BAR; PG8_SCHED;
            } else {
            PG8_LDB(B0, 0, 0); PG8_SCHED; PG8_LDA(At, 0, 0); PG8_STAGE_A(PG8_SA(1, 1), a1, vAc, 1);
            PG8_WAIT_L(8); PG8_BAR; PG8_WAIT_L(0); PG8_MMA(0, 0, At, B0); PG8_BAR; PG8_SCHED;
            PG8_LDB(B1, 0, 1); PG8_STAGE(PG8_SB(0, 0), b2, voffB);
            PG8_BAR; PG8_WAIT_L(0); PG8_MMA(0, 1, At, B1); PG8_BAR;
            PG8_LDA(At, 0, 1); PG8_STAGE_A(PG8_SA(0, 0), a2, v2, 0);
            PG8_BAR; PG8_WAIT_L(0); PG8_MMA(1, 0, At, B0); PG8_BAR; PG8_SCHED;
            PG8_STAGE(PG8_SB(0, 1), b2 + hstep, voffB);
            PG8_WAIT_V(6); PG8_BAR; PG8_MMA(1, 1, At, B1); PG8_BAR;
            PG8_LDB(B0, 1, 0); PG8_SCHED; PG8_LDA(At, 1, 0); PG8_STAGE_A(PG8_SA(0, 1), a2, v2, 1);
            PG8_WAIT_L(8); PG8_BAR; PG8_WAIT_L(0); PG8_MMA(0, 0, At, B0); PG8_BAR; PG8_SCHED;
            PG8_LDB(B1, 1, 1); PG8_STAGE(PG8_SB(1, 0), b3, voffB);
            PG8_BAR; PG8_WAIT_L(0); PG8_MMA(0, 1, At, B1); PG8_BAR;
            PG8_LDA(At, 1, 1); PG8_STAGE_A(PG8_SA(1, 0), a3, v2, 0);
            PG8_BAR; PG8_WAIT_L(0); PG8_MMA(1, 0, At, B0); PG8_BAR; PG8_SCHED;
            PG8_STAGE(PG8_SB(1, 1), b3 + hstep, voffB);
            PG8_WAIT_V(6); PG8_BAR; PG8_MMA(1, 1, At, B1); PG8_BAR;
            }
        }
        if constexpr (ALIGN_EPI) { if (wr == 0) PG8_BAR; }
        if constexpr (FP8) asm volatile("s_nop 15\n\ts_nop 15" ::: "memory");
        E(acc, cur, wr, wc, fr, fq, (const PG8_LAS float*)(lds + STAGE_BYTES + 1024 + (ui & 1) * 2048));
        if (!has_next) break;
#pragma unroll
        for (int a = 0; a < 2; ++a)
#pragma unroll
            for (int b = 0; b < 2; ++b)
#pragma unroll
                for (int m = 0; m < 4; ++m)
#pragma unroll
                    for (int n = 0; n < 2; ++n) acc[a][b][m][n] = (f32x4){0.f, 0.f, 0.f, 0.f};
        cur = nxt; cA = nA; cB = nB; ++ui;
#pragma unroll
        for (int h = 0; h < 2; ++h)
#pragma unroll
            for (int i = 0; i < 2; ++i) vAc[h][i] = vAn[h][i];
        if constexpr (ALIGN_EPI) { if (wr == 1) PG8_BAR; }
    }
    PG8_WAIT_V(0);
    if constexpr (!ALIGN_EPI) { if (wr == 0) PG8_BAR; }
    PG8_BAR;
#undef rd2
#undef PG8_SA
#undef PG8_SB
#undef PG8_STAGE
#undef PG8_STAGE_A
#undef PG8_LDA
#undef PG8_LDB
#undef PG8_MMA
#undef PG8_WAIT_V
#undef PG8_WAIT_L
#undef PG8_BAR
#undef PG8_SCHED
}
}

#define XB_TMO      128
#define XB_XCNT(j)  (256  + 64 * (j))
#define XB_XSUB(j)  (1280 + 64 * (j))
#define XB_XGEN(j)  (2304 + 64 * (j))
#define XB_TOP      3328
#define XB_TOPGEN   3392
#define XCD_BAR_WORDS 3456
#define XB_SPIN_CAP (1u << 18)
__device__ __forceinline__ unsigned xb_ld(unsigned* p)              { return __hip_atomic_load(p, __ATOMIC_RELAXED, __HIP_MEMORY_SCOPE_AGENT); }
__device__ __forceinline__ unsigned xb_add(unsigned* p, unsigned v) { return __hip_atomic_fetch_add(p, v, __ATOMIC_RELAXED, __HIP_MEMORY_SCOPE_AGENT); }
__device__ __forceinline__ unsigned xb_xcc_id() { return (unsigned)__builtin_amdgcn_s_getreg((3 << 11) | 20) & 0xFu; }
#define XB_SPIN(cond, bar) do { unsigned _sp = 0; while (cond) { __builtin_amdgcn_s_sleep(1); \
    if ((++_sp & 255u) == 0u) { if (xb_ld(&(bar)[XB_TMO])) break; if (_sp > XB_SPIN_CAP) { atomicAdd(&(bar)[XB_TMO], 1u); break; } } } } while (0)
struct XcdBarrier { unsigned* bar; unsigned x; volatile LAS unsigned* st; unsigned expect; };
__device__ __forceinline__ XcdBarrier xcd_barrier_post(unsigned* bar, volatile LAS unsigned* st, unsigned expect, bool member) {
    XcdBarrier b; b.bar = bar; b.x = xb_xcc_id(); b.st = st; b.expect = expect;
    if (member && threadIdx.x == 0) (void)xb_add(&bar[XB_XCNT(b.x)], 1u);
    return b;
}
__device__ __forceinline__ void xcd_barrier_complete(unsigned* bar, unsigned x, unsigned G, unsigned& nloc, unsigned& nx) {
    unsigned sum, cnt, mine, sp = 0u;
    for (;;) {
        sum = 0u; cnt = 0u; mine = 0u;
#pragma unroll
        for (unsigned j = 0; j < 16; ++j) { const unsigned c = xb_ld(&bar[XB_XCNT(j)]); sum += c; cnt += (c > 0u) ? 1u : 0u; mine = (j == x) ? c : mine; }
        if (sum == G) break;
        __builtin_amdgcn_s_sleep(1);
        if ((++sp & 255u) == 0u) { if (xb_ld(&bar[XB_TMO])) break; if (sp > XB_SPIN_CAP) { atomicAdd(&bar[XB_TMO], 1u); break; } }
    }
    nloc = mine > 0u ? mine : 1u; nx = cnt > 0u ? cnt : 1u;
}
__device__ __forceinline__ void xcd_barrier(const XcdBarrier& b) {
    asm volatile("s_waitcnt vmcnt(0)" ::: "memory");
    __syncthreads();
    if (threadIdx.x == 0) {
        unsigned* bar = b.bar;
        __builtin_amdgcn_s_waitcnt(0);
        unsigned nloc = b.st[0], nx = b.st[1];
        if (nloc == 0u) { xcd_barrier_complete(bar, b.x, b.expect, nloc, nx); b.st[0] = nloc; b.st[1] = nx; }
        const unsigned old = xb_add(&bar[XB_XSUB(b.x)], 1u);
        const unsigned gen = old / nloc;
        if (old + 1u == (gen + 1u) * nloc) {
            __builtin_amdgcn_fence(__ATOMIC_RELEASE, "agent");
            asm volatile("s_waitcnt vmcnt(0)" ::: "memory");
            const unsigned og = xb_add(&bar[XB_TOP], 1u);
            const unsigned tg = og / nx;
            if (og + 1u == (tg + 1u) * nx) xb_add(&bar[XB_TOPGEN], 1u);
            else XB_SPIN(xb_ld(&bar[XB_TOPGEN]) == tg, bar);
            __builtin_amdgcn_fence(__ATOMIC_ACQUIRE, "agent");
            xb_add(&bar[XB_XGEN(b.x)], 1u);
            asm volatile("s_waitcnt vmcnt(0)" ::: "memory");
        } else {
            XB_SPIN(xb_ld(&bar[XB_XGEN(b.x)]) == gen, bar);
            __builtin_amdgcn_fence(__ATOMIC_ACQUIRE, "agent");
            asm volatile("s_waitcnt vmcnt(0)" ::: "memory");
        }
    }
    __syncthreads();
}

struct Frame {
    LAS unsigned char* lds;
    volatile LAS unsigned* MISC;
    unsigned* ctl;
    int tid, lane, wave, G;
    int bid, nb;
    const float *x, *c, *ctx, *c_ctx, *w_mod, *b_mod, *g_mix, *w_in, *conv_a_w, *conv_a_b, *lru_w_r, *lru_b_r, *lru_w_i, *lru_b_i, *lru_lam, *conv_b_w, *g_out_a, *g_out_b, *w_out,
        *g_ffn, *w_router, *b_router, *w_gate, *b_gate, *w_up, *b_up, *w_down, *b_down, *g_final;
    float* out;
    float* MOD; bf16_t *WG, *WIN, *WOUT, *XN, *Gb, *XA, *BB, *P, *Y, *WGU, *WDN, *H, *O, *HS;
    f32x2* AGG; float* HIN; unsigned* ER; int* STOK; float* SLW; unsigned* CNT; unsigned char* XN2;
};

struct EpiInProj {
    static constexpr bool PERM = true; static constexpr int TAB_N = 0;
    __device__ __forceinline__ const float* tab_src(const pg8::Unit&, int) const { return nullptr; }
    unsigned char* ws; bf16_t* P;
    __device__ __forceinline__ void operator()(const f32x4 (&acc)[2][2][4][2], const pg8::Unit& u, int wr, int wc, int fr, int fq, const LAS float* tab) const {
        const int row0 = u.pm * 256 + wr * 64 + fr, cl = wc * 32 + 8 * fq, pn = u.pn;
        if (pn < 12) {
            const size_t woff = pn < 4 ? WS_G : (pn < 8 ? WS_XA : WS_BB); bf16_t* dst = (bf16_t*)(ws + woff); const int colt = (pn & 3) * 256;
#pragma unroll
            for (int ai = 0; ai < 2; ++ai)
#pragma unroll
                for (int m = 0; m < 4; ++m) { bf16_t* rowp = dst + (size_t)(row0 + ai * 128 + m * 16) * DA + colt + cl;
#pragma unroll
                    for (int bj = 0; bj < 2; ++bj) { f32x4 v0 = acc[ai][bj][m][0], v1 = acc[ai][bj][m][1];
                        if (pn < 4) {
#pragma unroll
                            for (int j = 0; j < 4; ++j) { v0[j] = gelu_tanh(v0[j]); v1[j] = gelu_tanh(v1[j]); } }
                        u32x4 w; w.x = cvt_pk_bf16(v0[0], v0[1]); w.y = cvt_pk_bf16(v0[2], v0[3]); w.z = cvt_pk_bf16(v1[0], v1[1]); w.w = cvt_pk_bf16(v1[2], v1[3]);
                        *(u32x4*)(rowp + bj * 128) = w; } }
        } else {
            const int j = pn - 12;
#pragma unroll
            for (int ai = 0; ai < 2; ++ai)
#pragma unroll
                for (int m = 0; m < 4; ++m) { bf16_t* rowp = P + (size_t)(row0 + ai * 128 + m * 16) * DA + j * 128 + cl;
                    const f32x4 v0 = acc[ai][0][m][0] * acc[ai][1][m][0], v1 = acc[ai][0][m][1] * acc[ai][1][m][1];
                    u32x4 w; w.x = cvt_pk_bf16(v0[0], v0[1]); w.y = cvt_pk_bf16(v0[2], v0[3]); w.z = cvt_pk_bf16(v1[0], v1[1]); w.w = cvt_pk_bf16(v1[2], v1[3]);
                    *(u32x4*)rowp = w; }
        }
    }
};
struct EpiOutProj {
    static constexpr bool PERM = true; static constexpr int TAB_N = 0;
    __device__ __forceinline__ const float* tab_src(const pg8::Unit&, int) const { return nullptr; }
    bf16_t* MX; const float* MOD;
    __device__ __forceinline__ void operator()(const f32x4 (&acc)[2][2][4][2], const pg8::Unit& u, int wr, int wc, int fr, int fq, const LAS float* tab) const {
        const int row0 = u.pm * 256 + wr * 64 + fr, col0 = u.pn * 256 + wc * 32 + 8 * fq, b = u.pm >> 5;
        f32x4 gt[2][2];
#pragma unroll
        for (int bj = 0; bj < 2; ++bj)
#pragma unroll
            for (int n = 0; n < 2; ++n) gt[bj][n] = *(const f32x4*)(MOD + b * 12288 + 4096 + col0 + bj * 128 + 4 * n);
#pragma unroll
        for (int ai = 0; ai < 2; ++ai)
#pragma unroll
            for (int m = 0; m < 4; ++m) { bf16_t* rowp = MX + (size_t)(row0 + ai * 128 + m * 16) * D + col0;
#pragma unroll
                for (int bj = 0; bj < 2; ++bj) { const f32x4 v0 = gt[bj][0] * acc[ai][bj][m][0], v1 = gt[bj][1] * acc[ai][bj][m][1];
                    u32x4 w; w.x = cvt_pk_bf16(v0[0], v0[1]); w.y = cvt_pk_bf16(v0[2], v0[3]); w.z = cvt_pk_bf16(v1[0], v1[1]); w.w = cvt_pk_bf16(v1[2], v1[3]);
                    *(u32x4*)(rowp + bj * 128) = w; } }
    }
};
struct EpiGU {
    static constexpr bool PERM = true; static constexpr int TAB_N = 256;
    bf16_t* H; const float *b_gate, *b_up;
    __device__ __forceinline__ const float* tab_src(const pg8::Unit& u, int t) const { return (t < 128 ? b_gate : b_up) + u.e * FF + u.pn * 128 + (t & 127); }
    __device__ __forceinline__ void operator()(const f32x4 (&acc)[2][2][4][2], const pg8::Unit& u, int wr, int wc, int fr, int fq, const LAS float* tab) const {
        const int row0 = u.pm * 256 + wr * 64 + fr, colg = u.pn * 128 + wc * 32 + 8 * fq;
        f32x4 bg[2], bu[2];
#pragma unroll
        for (int n = 0; n < 2; ++n) { bg[n] = *(const LAS f32x4*)(tab + wc * 32 + 8 * fq + 4 * n); bu[n] = *(const LAS f32x4*)(tab + 128 + wc * 32 + 8 * fq + 4 * n); }
#pragma unroll
        for (int ai = 0; ai < 2; ++ai)
#pragma unroll
            for (int m = 0; m < 4; ++m) { unsigned char* rowp = (unsigned char*)H + (size_t)(row0 + ai * 128 + m * 16) * FF + colg; f32x4 a[2];
#pragma unroll
                for (int n = 0; n < 2; ++n)
#pragma unroll
                    for (int j = 0; j < 4; j += 2) {
                        f32x2 g = (f32x2){acc[ai][0][m][n][j], acc[ai][0][m][n][j + 1]} * GU_INV + (f32x2){bg[n][j], bg[n][j + 1]};
                        f32x2 up = (f32x2){acc[ai][1][m][n][j], acc[ai][1][m][n][j + 1]} * GU_INV + (f32x2){bu[n][j], bu[n][j + 1]};
                        g.x = fminf(g.x, 7.0f); g.y = fminf(g.y, 7.0f); up.x = __builtin_amdgcn_fmed3f(up.x, -7.0f, 7.0f); up.y = __builtin_amdgcn_fmed3f(up.y, -7.0f, 7.0f);
                        const f32x2 t = g * (-1.702f * 1.44269504089f);
                        f32x2 d = (f32x2){__builtin_amdgcn_exp2f(t.x), __builtin_amdgcn_exp2f(t.y)} + 1.0f;
                        const f32x2 sg = {__builtin_amdgcn_rcpf(d.x), __builtin_amdgcn_rcpf(d.y)};
                        const f32x2 h = (up + 1.0f) * g * sg;
                        a[n][j] = h.x; a[n][j + 1] = h.y; }
                u32x2 w; w.x = pk4_fp8(a[0][0], a[0][1], a[0][2], a[0][3]); w.y = pk4_fp8(a[1][0], a[1][1], a[1][2], a[1][3]);
                *(u32x2*)rowp = w; }
    }
};
struct EpiDown {
    static constexpr bool PERM = true; static constexpr int TAB_N = 512;
    bf16_t* O; const float* b_down; const float* SLW; const LAS int* cnt;
    __device__ __forceinline__ const float* tab_src(const pg8::Unit& u, int t) const {
        if (t < 256) return b_down + u.e * D + u.pn * 256 + t;
        const int r = t - 256, nvalid = __builtin_amdgcn_readfirstlane(cnt[u.e]) - u.mt * 256; return SLW + (size_t)u.e * CAP + (r < nvalid ? u.mt * 256 + r : 0); }
    __device__ __forceinline__ void operator()(const f32x4 (&acc)[2][2][4][2], const pg8::Unit& u, int wr, int wc, int fr, int fq, const LAS float* tab) const {
        const int row0 = u.pm * 256 + wr * 64 + fr, cl = wc * 32 + 8 * fq, nvalid = __builtin_amdgcn_readfirstlane(cnt[u.e]) - u.mt * 256;
        f32x4 bd[2][2]; float wsl[2][4];
#pragma unroll
        for (int bj = 0; bj < 2; ++bj)
#pragma unroll
            for (int n = 0; n < 2; ++n) bd[bj][n] = *(const LAS f32x4*)(tab + bj * 128 + cl + 4 * n);
#pragma unroll
        for (int ai = 0; ai < 2; ++ai)
#pragma unroll
            for (int m = 0; m < 4; ++m) { const int r = ai * 128 + wr * 64 + m * 16 + fr; const float w = tab[256 + r]; wsl[ai][m] = r < nvalid ? w : 0.f; }
#pragma unroll
        for (int ai = 0; ai < 2; ++ai)
#pragma unroll
            for (int m = 0; m < 4; ++m) { const int r = ai * 128 + wr * 64 + m * 16 + fr; const float w8 = wsl[ai][m];
                unsigned char* rowp = (unsigned char*)O + (size_t)(row0 + ai * 128 + m * 16) * D + u.pn * 256 + cl;
#pragma unroll
                for (int bj = 0; bj < 2; ++bj) { const f32x4 v0 = (acc[ai][bj][m][0] * W8_INV + bd[bj][0]) * w8, v1 = (acc[ai][bj][m][1] * W8_INV + bd[bj][1]) * w8;
                    u32x2 w; w.x = pk4_fp8(v0[0] * O8_SCALE, v0[1] * O8_SCALE, v0[2] * O8_SCALE, v0[3] * O8_SCALE); w.y = pk4_fp8(v1[0] * O8_SCALE, v1[1] * O8_SCALE, v1[2] * O8_SCALE, v1[3] * O8_SCALE);
                    *(u32x2*)(rowp + bj * 128) = w; } }
    }
};

struct DenseOrder {
    int nM, nN, nwg, G, c, nX; const char *A, *Bt; size_t tstep;
    __device__ __forceinline__ bool next(int i, pg8::Unit& u) const {
        long L = (long)i * G + c; if (L >= nwg + nX) return false;
        u.e = 0; u.mt = 0;
        if (L < nX) { u.pm = 64 + (int)L / 4; u.pn = 4 + (int)L % 4; return true; }
        L -= nX;
        const int wgid = pg8::xcd_remap((int)L, nwg);
        const int nig = pg8::WGM * nN, gid = wgid / nig, fm = gid * pg8::WGM, gsz = (nM - fm) < pg8::WGM ? (nM - fm) : pg8::WGM;
        u.pm = fm + ((wgid % nig) % gsz); u.pn = (wgid % nig) / gsz; return true;
    }
    __device__ __forceinline__ const char* a_base(const pg8::Unit& u) const { return A + (size_t)u.pm * tstep; }
    __device__ __forceinline__ const char* b_base(const pg8::Unit& u) const { return Bt + (size_t)u.pn * tstep; }
    __device__ __forceinline__ unsigned gather_off(const pg8::Unit&, int) const { return 0u; }
    __device__ __forceinline__ const int* tok_src(const pg8::Unit&, int) const { return nullptr; }
};
struct MoeOrder {
    const LAS int* tab; int NT, G, c, nwg; const char *A, *Bt; const int* STOK; size_t bstep_e, tstep; bool gather;
    __device__ __forceinline__ bool next(int i, pg8::Unit& u) const {
        const int x = c & 7, npx = NT / 4, ng = NT / npx, mgn = 8 / ng, ngroup = x % ng, mgroup = x / ng, nbx = (G - x + 7) >> 3, q = i * nbx + (c >> 3);
        const int til = q / npx, ti = til * mgn + mgroup; if (ti >= nwg / NT) return false;
        u.pn = ngroup * npx + (q - til * npx);
        const int sl = (int)(threadIdx.x & 63), pv = tab[17 + (sl < NE - 1 ? sl : NE - 2)];
        const int e = (int)__popcll(__ballot(sl < NE - 1 && ti >= pv));
        u.e = e; u.mt = ti - __builtin_amdgcn_readfirstlane(tab[16 + e]); u.pm = __builtin_amdgcn_readfirstlane(tab[64 + e]) + u.mt; return true;
    }
    __device__ __forceinline__ const char* a_base(const pg8::Unit& u) const { return gather ? A : A + (size_t)u.pm * tstep; }
    __device__ __forceinline__ const char* b_base(const pg8::Unit& u) const { return Bt + (size_t)u.e * bstep_e + (size_t)u.pn * tstep; }
    __device__ __forceinline__ const int* tok_src(const pg8::Unit& u, int row) const { const int idx = u.mt * 256 + row; return STOK + (size_t)u.e * CAP + (idx < __builtin_amdgcn_readfirstlane(tab[128 + u.e]) ? idx : 0); }
    __device__ __forceinline__ unsigned gather_off(const pg8::Unit& u, int row) const { return (unsigned)(*tok_src(u, row)) * (unsigned)D; }
};

__device__ __forceinline__ void transpose_item(const float* W, int K, int N, int k0, int n0, bf16_t* WT, int orow0, LAS float* scr, int lane) {
#pragma unroll 8
    for (int i = 0; i < 32; ++i) { const int kk = 2 * i + (lane >> 5); scr[kk * 33 + (lane & 31)] = W[(size_t)(k0 + kk) * N + n0 + (lane & 31)]; }
    asm volatile("s_waitcnt lgkmcnt(0)" ::: "memory");
    const int c = lane & 7;
#pragma unroll
    for (int j = 0; j < 4; ++j) { const int n = (lane >> 3) + 8 * j; const LAS float* s = scr + (8 * c) * 33 + n;
        u32x4 o; o.x = cvt_pk_bf16(s[0 * 33], s[1 * 33]); o.y = cvt_pk_bf16(s[2 * 33], s[3 * 33]); o.z = cvt_pk_bf16(s[4 * 33], s[5 * 33]); o.w = cvt_pk_bf16(s[6 * 33], s[7 * 33]);
        *(u32x4*)(WT + (size_t)(orow0 + n) * K + k0 + 8 * c) = o; }
    asm volatile("s_waitcnt lgkmcnt(0)" ::: "memory");
}

__device__ __forceinline__ void transpose_item_fp8(const float* W, int K, int N, int k0, int n0, unsigned char* WT, int orow0, LAS float* scr, int lane) {
#pragma unroll 8
    for (int i = 0; i < 64; ++i) { const int kk = 2 * i + (lane >> 5); scr[kk * 33 + (lane & 31)] = W[(size_t)(k0 + kk) * N + n0 + (lane & 31)]; }
    asm volatile("s_waitcnt lgkmcnt(0)" ::: "memory");
    const int c = lane & 7;
#pragma unroll
    for (int j = 0; j < 4; ++j) { const int n = (lane >> 3) + 8 * j; const LAS float* s = scr + (16 * c) * 33 + n;
        u32x4 o; o.x = pk4_fp8(s[0 * 33] * W8_SCALE, s[1 * 33] * W8_SCALE, s[2 * 33] * W8_SCALE, s[3 * 33] * W8_SCALE); o.y = pk4_fp8(s[4 * 33] * W8_SCALE, s[5 * 33] * W8_SCALE, s[6 * 33] * W8_SCALE, s[7 * 33] * W8_SCALE);
        o.z = pk4_fp8(s[8 * 33] * W8_SCALE, s[9 * 33] * W8_SCALE, s[10 * 33] * W8_SCALE, s[11 * 33] * W8_SCALE); o.w = pk4_fp8(s[12 * 33] * W8_SCALE, s[13 * 33] * W8_SCALE, s[14 * 33] * W8_SCALE, s[15 * 33] * W8_SCALE);
        *(u32x4*)(WT + (size_t)(orow0 + n) * K + k0 + 16 * c) = o; }
    asm volatile("s_waitcnt lgkmcnt(0)" ::: "memory");
}

__device__ __forceinline__ void ph0(Frame& F) {
    LAS float* sc = (LAS float*)(F.lds + 67584);
    LAS float* red = (LAS float*)(F.lds + 67584 + 24576);
    LAS float* scr = (LAS float*)(F.lds + F.wave * 8448);
    constexpr int I_IN = (D / 64) * (NIN / 32), I_OUT = (D / 64) * (D / 32), I_G = 32 * 8, NJOB = 128 + (I_IN + I_OUT + I_G) / 32;
    bool have_sc = false;
    for (;;) {
        __syncthreads();
        if (F.tid == 0) F.MISC[12] = atomicAdd(F.ctl + CW_Q0, 1u);
        __syncthreads();
        const int job = __builtin_amdgcn_readfirstlane((int)F.MISC[12]);
        if (job >= NJOB) break;
        if (job < 128) {
            if (!have_sc) { for (int idx = F.tid; idx < 3 * D; idx += 512) { const int r = idx >> 11, k = idx & 2047; const float v = r < 2 ? F.c[r * D + k] : F.c_ctx[k]; sc[idx] = v * fsigmoid(v); } have_sc = true; __syncthreads(); }
            const int cg = job, sub = F.lane / 24, c4 = F.lane % 24;
            f32x4 a0 = {0.f, 0.f, 0.f, 0.f}, a1 = a0, a2 = a0;
            if (F.lane < 48) {
                const float* wp = F.w_mod + (size_t)(F.wave * 2 + sub) * 12288 + cg * 96 + c4 * 4;
                for (int it = 0; it < 128; it += 8) {
                    f32x4 wv[8];
#pragma unroll
                    for (int u = 0; u < 8; ++u) wv[u] = __builtin_nontemporal_load((const f32x4*)(wp + (size_t)(it + u) * 16 * 12288));
#pragma unroll
                    for (int u = 0; u < 8; ++u) { const int k = (it + u) * 16 + F.wave * 2 + sub; a0 += sc[k] * wv[u]; a1 += sc[D + k] * wv[u]; a2 += sc[2 * D + k] * wv[u]; }
                }
                LAS float* rp = red + (F.wave * 2 + sub) * 288 + c4 * 4;
                *(LAS f32x4*)(rp) = a0; *(LAS f32x4*)(rp + 96) = a1; *(LAS f32x4*)(rp + 192) = a2;
            }
            __syncthreads();
            if (F.tid < 288) { const int r = F.tid / 96, cc = F.tid % 96; float s = F.b_mod[cg * 96 + cc];
#pragma unroll
                for (int p = 0; p < 16; ++p) s += red[p * 288 + r * 96 + cc];
                F.MOD[r * 12288 + cg * 96 + cc] = s; }
        } else {
#pragma unroll 1
            for (int q = 0; q < 4; ++q) {
                int r = (job - 128) * 32 + q * 8 + F.wave;
                if (r < I_IN) { const int nblk = NIN / 32, k0 = 64 * (r / nblk), n0 = 32 * (r % nblk); int orow0;
                    if (n0 < 3072) orow0 = n0; else if (n0 < 4096) { const int qq = n0 - 3072; orow0 = 3072 + (qq >> 7) * 256 + (qq & 127); } else { const int qq = n0 - 4096; orow0 = 3072 + (qq >> 7) * 256 + 128 + (qq & 127); }
                    transpose_item(F.w_in, D, NIN, k0, n0, F.WIN, orow0, scr, F.lane); continue; }
                r -= I_IN;
                if (r < I_OUT) { const int nblk = D / 32, k0 = 64 * (r / nblk), n0 = 32 * (r % nblk); transpose_item(F.w_out, D, D, k0, n0, F.WOUT, n0, scr, F.lane); continue; }
                r -= I_OUT;
                { const int mat = r >> 3, sub = r & 7, type = mat >> 4, dh = mat & 15; const int k0 = 64 * (sub >> 2), n0 = 32 * (sub & 3);
                  const float* W = (type ? F.lru_w_i : F.lru_w_r) + (size_t)dh * 16384; transpose_item(W, 128, 128, k0, n0, F.WG + (size_t)(type * 16 + dh) * 16384, n0, scr, F.lane); }
            }
        }
    }
}

struct CvItem { const GAS float* W; GAS unsigned char* WT; };
typedef float f32x16 __attribute__((ext_vector_type(16)));
typedef unsigned u32x6 __attribute__((ext_vector_type(6)));
constexpr int CV6_NSTRIP = 2 * 32 * 64, CV6_FQ_PITCH = 1040, CV6_TILE_BYTES = 4 * CV6_FQ_PITCH * 4;
__device__ __forceinline__ u32x6 cvt_fp6_32(const float (&v)[32], const float scale) {
    f32x16 p, q;
#pragma unroll
    for (int i = 0; i < 16; ++i) { p[i] = v[i] * scale; q[i] = v[16 + i] * scale; }
    return __builtin_amdgcn_cvt_scalef32_2xpk16_fp6_f32(p, q, 1.0f);
}
__device__ __forceinline__ CvItem cv6_decode(Frame& F, int strip, int kt) {
    const int which = strip >> 11, e = (strip >> 6) & 31, n0 = 32 * (strip & 63);
    const unsigned long long m0 = which == 0 ? ~0ull : 0ull;
    const unsigned long long wsel = ((unsigned long long)F.w_gate & m0) | ((unsigned long long)F.w_up & ~m0);
    const int orow0 = (n0 >> 7) * 256 + which * 128 + (n0 & 127);
    CvItem c; c.W = (const GAS float*)wsel + (size_t)e * D * FF + (size_t)(128 * kt) * 2048 + n0;
    c.WT = (GAS unsigned char*)F.WGU + (size_t)e * 4096 * D + (size_t)orow0 * 2048 + kt * 128;
    return c;
}
__device__ __forceinline__ void cv6_load(const CvItem& c, int lane, f32x4 (&v)[16]) {
    const GAS float* p = c.W + (size_t)(lane >> 3) * 2048 + 4 * (lane & 7);
#pragma unroll
    for (int i = 0; i < 16; ++i) v[i] = __builtin_nontemporal_load((const GAS f32x4*)(p + (size_t)(8 * i) * 2048));
}
__device__ __forceinline__ void cv6_store(const CvItem& c, int lane, const f32x4 (&v)[16], LAS float* scr) {
    const int r8 = lane >> 3, c4 = lane & 7;
    LAS float* wb = scr + (r8 >> 2) * 128 + 4 * c4 + (r8 & 3);
#pragma unroll
    for (int i = 0; i < 16; ++i)
#pragma unroll
        for (int nn = 0; nn < 4; ++nn) wb[(i >> 2) * CV6_FQ_PITCH + 2 * (i & 3) * 128 + 32 * nn] = v[i][nn];
    asm volatile("s_waitcnt lgkmcnt(0)" ::: "memory");
#pragma unroll
    for (int rd = 0; rd < 2; ++rd) {
        const int npp = 16 * rd + (lane >> 2), fq = lane & 3;
        const LAS float* rb = scr + fq * CV6_FQ_PITCH + 4 * npp;
        float f[32];
#pragma unroll
        for (int j = 0; j < 8; ++j) { const f32x4 t = *(const LAS f32x4*)(rb + j * 128); f[4 * j] = t.x; f[4 * j + 1] = t.y; f[4 * j + 2] = t.z; f[4 * j + 3] = t.w; }
        const u32x6 pk = cvt_fp6_32(f, W8_SCALE);
        const unsigned lo4 = (unsigned)__builtin_amdgcn_update_dpp(0, (int)pk[4], 0x114, 0xf, 0xf, false), lo5 = (unsigned)__builtin_amdgcn_update_dpp(0, (int)pk[5], 0x114, 0xf, 0xf, false);
        const unsigned hi4 = (unsigned)__builtin_amdgcn_update_dpp(0, (int)pk[4], 0x104, 0xf, 0xf, false), hi5 = (unsigned)__builtin_amdgcn_update_dpp(0, (int)pk[5], 0x104, 0xf, 0xf, false);
        const bool odd = (npp & 1) != 0;
        const int na = odd ? npp - 1 : npp, nb = odd ? npp : npp + 1;
        GAS unsigned char* oa = c.WT + (size_t)(4 * (na & 7) + (na >> 3)) * 2048 + 16 * fq + (odd ? 64 : 0);
        GAS unsigned char* ob = c.WT + (size_t)(4 * (nb & 7) + (nb >> 3)) * 2048 + 16 * fq + (odd ? 0 : 64);
        const u32x4 f1 = {pk[0], pk[1], pk[2], pk[3]}, slo = {lo4, lo5, lo4, lo5}, shi = {hi4, hi5, hi4, hi5};
        __builtin_nontemporal_store(odd ? slo : f1, (GAS u32x4*)oa);
        __builtin_nontemporal_store(odd ? f1 : shi, (GAS u32x4*)ob);
    }
    asm volatile("s_waitcnt lgkmcnt(0)" ::: "memory");
}
__device__ __forceinline__ int cv6_claim(Frame& F) { int s = 0; if (F.lane == 0) s = (int)atomicAdd(F.ctl + CW_QCV6, 1u); return __builtin_amdgcn_readfirstlane(s); }
__device__ __forceinline__ void ph_expert_conv6(Frame& F) {
    LAS float* scr = (LAS float*)(F.lds + F.wave * CV6_TILE_BYTES);
    int sc = cv6_claim(F), kb = 0;
    if (sc >= CV6_NSTRIP) return;
    f32x4 va[16], vb[16];
    cv6_load(cv6_decode(F, sc, kb), F.lane, va);
    for (;;) {
        int s1 = sc, k1 = kb + 1; if (k1 == 16) { s1 = cv6_claim(F); k1 = 0; }
        const bool h1 = s1 < CV6_NSTRIP;
        cv6_load(cv6_decode(F, h1 ? s1 : sc, h1 ? k1 : kb), F.lane, vb);
        cv6_store(cv6_decode(F, sc, kb), F.lane, va, scr);
        if (!h1) break;
        int s2 = s1, k2 = k1 + 1; if (k2 == 16) { s2 = cv6_claim(F); k2 = 0; }
        const bool h2 = s2 < CV6_NSTRIP;
        cv6_load(cv6_decode(F, h2 ? s2 : s1, h2 ? k2 : k1), F.lane, va);
        cv6_store(cv6_decode(F, s1, k1), F.lane, vb, scr);
        if (!h2) break;
        sc = s2; kb = k2;
    }
}

constexpr int CV_PK = 132, CV_TILE_BYTES = 8 * CV_PK * 4, CV_NSTRIP = 32 * 64, CV_KB = 16;
__device__ __forceinline__ CvItem cv_decode(Frame& F, int strip, int kb) {
    const int which = 2, e = (strip >> 6) & 31, n0 = 32 * (strip & 63), k0 = 128 * kb;
    const unsigned long long m0 = which == 0 ? ~0ull : 0ull, m1 = which == 1 ? ~0ull : 0ull, m2 = which == 2 ? ~0ull : 0ull;
    const unsigned long long wsel = ((unsigned long long)F.w_gate & m0) | ((unsigned long long)F.w_up & m1) | ((unsigned long long)F.w_down & m2);
    const unsigned long long osel = ((unsigned long long)F.WGU & (m0 | m1)) | ((unsigned long long)F.WDN & m2);
    const int orow0 = which == 2 ? n0 : (n0 >> 7) * 256 + which * 128 + (n0 & 127);
    const size_t ebytes = which == 2 ? (size_t)D * FF : (size_t)4096 * D;
    CvItem c; c.W = (const GAS float*)wsel + (size_t)e * D * FF + (size_t)k0 * 2048 + n0;
    c.WT = (GAS unsigned char*)osel + (size_t)e * ebytes + (size_t)orow0 * 2048 + k0;
    return c;
}
__device__ __forceinline__ void cv_load(const CvItem& c, int lane, f32x4 (&v)[16]) {
    const GAS float* p = c.W + (size_t)(lane >> 3) * 2048 + 4 * (lane & 7);
#pragma unroll
    for (int i = 0; i < 16; ++i) v[i] = __builtin_nontemporal_load((const GAS f32x4*)(p + (size_t)(8 * i) * 2048));
}
__device__ __forceinline__ void cv_store(const CvItem& c, int lane, const f32x4 (&v)[16], LAS float* scr) {
    LAS unsigned* sb = (LAS unsigned*)scr;
    const int r8 = lane >> 3, c4 = lane & 7;
#pragma unroll
    for (int i = 0; i < 16; ++i) { const f32x4 w = v[i] * W8_SCALE; sb[c4 * CV_PK + 8 * i + r8] = pk4_fp8(w.x, w.y, w.z, w.w); }
    asm volatile("s_waitcnt lgkmcnt(0)" ::: "memory");
    const int n4 = lane >> 3, kb = lane & 7;
    u32x4 dq[4];
#pragma unroll
    for (int g = 0; g < 4; ++g) dq[g] = *(const LAS u32x4*)(sb + n4 * CV_PK + 16 * kb + 4 * g);
    u32x4 o[4];
#pragma unroll
    for (int g = 0; g < 4; ++g) {
        const unsigned lo01 = __builtin_amdgcn_perm(dq[g].y, dq[g].x, 0x05010400u), hi01 = __builtin_amdgcn_perm(dq[g].y, dq[g].x, 0x07030602u);
        const unsigned lo23 = __builtin_amdgcn_perm(dq[g].w, dq[g].z, 0x05010400u), hi23 = __builtin_amdgcn_perm(dq[g].w, dq[g].z, 0x07030602u);
        o[0][g] = __builtin_amdgcn_perm(lo23, lo01, 0x05040100u); o[1][g] = __builtin_amdgcn_perm(lo23, lo01, 0x07060302u);
        o[2][g] = __builtin_amdgcn_perm(hi23, hi01, 0x05040100u); o[3][g] = __builtin_amdgcn_perm(hi23, hi01, 0x07060302u);
    }
#pragma unroll
    for (int j = 0; j < 4; ++j) __builtin_nontemporal_store(o[j], (GAS u32x4*)(c.WT + (size_t)(4 * n4 + j) * 2048 + 16 * kb));
    asm volatile("s_waitcnt lgkmcnt(0)" ::: "memory");
}
__device__ __forceinline__ int cv_claim(Frame& F) { int s = 0; if (F.lane == 0) s = (int)atomicAdd(F.ctl + CW_QCV, 1u); return __builtin_amdgcn_readfirstlane(s); }
__device__ __forceinline__ void ph_expert_conv(Frame& F) {
    LAS float* scr = (LAS float*)(F.lds + F.wave * CV6_TILE_BYTES);
    int sc = cv_claim(F), kb = 0;
    if (sc >= CV_NSTRIP) return;
    f32x4 va[16], vb[16];
    cv_load(cv_decode(F, sc, kb), F.lane, va);
    for (;;) {
        int s1 = sc, k1 = kb + 1; if (k1 == CV_KB) { s1 = cv_claim(F); k1 = 0; }
        const bool h1 = s1 < CV_NSTRIP;
        cv_load(cv_decode(F, h1 ? s1 : sc, h1 ? k1 : kb), F.lane, vb);
        cv_store(cv_decode(F, sc, kb), F.lane, va, scr);
        if (!h1) break;
        int s2 = s1, k2 = k1 + 1; if (k2 == CV_KB) { s2 = cv_claim(F); k2 = 0; }
        const bool h2 = s2 < CV_NSTRIP;
        cv_load(cv_decode(F, h2 ? s2 : s1, h2 ? k2 : k1), F.lane, va);
        cv_store(cv_decode(F, s1, k1), F.lane, vb, scr);
        if (!h2) break;
        sc = s2; kb = k2;
    }
}

constexpr int AT_STRIDE = 4112;
__device__ __forceinline__ void ph1(Frame& F) {
    LAS float* Ac = (LAS float*)F.lds; LAS float* Bc = Ac + D;
    const int gw = F.bid * 8 + F.wave, NGW = F.nb * 8;
    for (int seg = 0; seg < 3; ++seg) {
        __syncthreads();
        for (int cc = F.tid; cc < D; cc += 512) { const float sh = F.MOD[seg * 12288 + cc], sl = F.MOD[seg * 12288 + D + cc]; Ac[cc] = F.g_mix[cc] * (1.0f + sl); Bc[cc] = sh; }
        __syncthreads();
        if (seg < 2) {
            const float* in = F.x + (size_t)seg * SEQ * D; bf16_t* outp = F.XN + (size_t)(seg * SEQ) * D;
            for (int m = gw; m < SEQ; m += NGW) {
                const f32x4* xr = (const f32x4*)(in + (size_t)m * D) + F.lane; f32x4 v[8]; float s = 0.f;
#pragma unroll
                for (int j = 0; j < 8; ++j) { v[j] = __builtin_nontemporal_load(xr + 64 * j); s += (v[j].x * v[j].x + v[j].y * v[j].y) + (v[j].z * v[j].z + v[j].w * v[j].w); }
                const float rstd = 1.0f / sqrtf(wave_sum(s) * (1.0f / D) + EPS);
                unsigned long long* o8 = (unsigned long long*)(outp + (size_t)m * D) + F.lane;
#pragma unroll
                for (int j = 0; j < 8; ++j) { const f32x4 a = *(const LAS f32x4*)(Ac + 4 * (F.lane + 64 * j)), b = *(const LAS f32x4*)(Bc + 4 * (F.lane + 64 * j)); const f32x4 o = v[j] * rstd * a + b;
                    o8[64 * j] = (unsigned long long)cvt_pk_bf16(o.x, o.y) | ((unsigned long long)cvt_pk_bf16(o.z, o.w) << 32); }
            }
        } else {
            LAS unsigned char* AT = F.lds + 16384; LAS float* RED = (LAS float*)(F.lds + 16384 + 16 * AT_STRIDE + 256);
            for (int u = F.bid; u < 256; u += F.nb) {
                const int rg = u >> 3, cg = u & 7;
                __syncthreads();
#pragma unroll 1
                for (int rr = 0; rr < 2; ++rr) { const int r = F.wave * 2 + rr;
                    const f32x4* xr = (const f32x4*)(F.ctx + (size_t)(16 * rg + r) * D) + F.lane; f32x4 v[8]; float s = 0.f;
#pragma unroll
                    for (int j = 0; j < 8; ++j) { v[j] = xr[64 * j]; s += (v[j].x * v[j].x + v[j].y * v[j].y) + (v[j].z * v[j].z + v[j].w * v[j].w); }
                    const float rstd = 1.0f / sqrtf(wave_sum(s) * (1.0f / D) + EPS);
#pragma unroll
                    for (int j = 0; j < 8; ++j) { const f32x4 a = *(const LAS f32x4*)(Ac + 4 * (F.lane + 64 * j)), b = *(const LAS f32x4*)(Bc + 4 * (F.lane + 64 * j)); const f32x4 o = v[j] * rstd * a + b;
                        u32x2 w; w.x = cvt_pk_bf16(o.x, o.y); w.y = cvt_pk_bf16(o.z, o.w); *(LAS u32x2*)(AT + r * AT_STRIDE + 8 * (F.lane + 64 * j)) = w; } }
                __syncthreads();
                const int c16 = F.lane & 15, q = F.lane >> 4;
                f32x4 acc[8];
#pragma unroll
                for (int n = 0; n < 8; ++n) acc[n] = (f32x4){0.f, 0.f, 0.f, 0.f};
                const bf16_t* wb = F.WIN + (size_t)(DA + 128 * cg + c16) * D + 256 * F.wave + 8 * q;
                const bf16_t* wp[8];
#pragma unroll
                for (int n = 0; n < 8; ++n) wp[n] = wb + (size_t)(16 * n) * D;
                u32x4 bA[8], bB[8];
#define P1_LD(dst, ks) do { _Pragma("unroll") for (int n = 0; n < 8; ++n) asm volatile("global_load_dwordx4 %0, %1, off offset:%2" : "=v"(dst[n]) : "v"(wp[n]), "n"(64 * (ks))); } while (0)
#define P1_WAIT(dst, cnt) asm volatile("s_waitcnt vmcnt(" #cnt ")" : "+v"(dst[0]), "+v"(dst[1]), "+v"(dst[2]), "+v"(dst[3]), "+v"(dst[4]), "+v"(dst[5]), "+v"(dst[6]), "+v"(dst[7]) :: "memory")
#define P1_MMA(dst, ks) do { const bf16x8 af = *(const LAS bf16x8*)(AT + c16 * AT_STRIDE + (256 * F.wave + 32 * (ks) + 8 * q) * 2); \
                    _Pragma("unroll") for (int n = 0; n < 8; ++n) acc[n] = __builtin_amdgcn_mfma_f32_16x16x32_bf16(af, __builtin_bit_cast(bf16x8, dst[n]), acc[n], 0, 0, 0); } while (0)
                P1_LD(bA, 0);
                P1_LD(bB, 1); P1_WAIT(bA, 8); P1_MMA(bA, 0);
                P1_LD(bA, 2); P1_WAIT(bB, 8); P1_MMA(bB, 1);
                P1_LD(bB, 3); P1_WAIT(bA, 8); P1_MMA(bA, 2);
                P1_LD(bA, 4); P1_WAIT(bB, 8); P1_MMA(bB, 3);
                P1_LD(bB, 5); P1_WAIT(bA, 8); P1_MMA(bA, 4);
                P1_LD(bA, 6); P1_WAIT(bB, 8); P1_MMA(bB, 5);
                P1_LD(bB, 7); P1_WAIT(bA, 8); P1_MMA(bA, 6);
                P1_WAIT(bB, 0); P1_MMA(bB, 7);
#undef P1_LD
#undef P1_WAIT
#undef P1_MMA
#pragma unroll
                for (int n = 0; n < 8; ++n)
#pragma unroll
                    for (int rg4 = 0; rg4 < 4; ++rg4) RED[(F.wave * 16 + 4 * q + rg4) * 128 + 16 * n + c16] = acc[n][rg4];
                __syncthreads();
                { const int tok = F.tid >> 5, c4 = (F.tid & 31) * 4; f32x4 sum = {0.f, 0.f, 0.f, 0.f};
#pragma unroll
                  for (int w = 0; w < 8; ++w) sum += *(const LAS f32x4*)(RED + (w * 16 + tok) * 128 + c4);
                  u32x2 o; o.x = cvt_pk_bf16(sum.x, sum.y); o.y = cvt_pk_bf16(sum.z, sum.w);
                  *(u32x2*)(F.XA + (size_t)(T + 16 * rg + tok) * DA + 128 * cg + c4) = o; }
            }
        }
    }
}

constexpr int XCT_STRIDE = 272;
template <bool FINAL>
__device__ __forceinline__ void gates_phase(Frame& F, const int nrep) {
    LAS unsigned char* xcT = F.lds; LAS unsigned char* hsT = F.lds + 64 * XCT_STRIDE;
    const int h = F.bid & 7, kb0 = F.bid >> 3, kstride = (F.nb - h + 7) >> 3;
    const int NU = FINAL ? 256 : 2 * NCHUNK;
    const int c16 = F.lane & 15, q = F.lane >> 4, jrow = F.wave * 16 + c16, ch = h * 128 + jrow;
    bf16x8 bfr[4][4];
#pragma unroll
    for (int ks = 0; ks < 4; ++ks)
#pragma unroll
        for (int td = 0; td < 4; ++td) bfr[ks][td] = *(const bf16x8*)(F.WG + (size_t)((td * 8 + h) * 128 + jrow) * 128 + ks * 32 + q * 8);
    const float brf = F.lru_b_r[ch], brb = F.lru_b_r[DA + ch], bif = F.lru_b_i[ch], bib = F.lru_b_i[DA + ch];
    const float cff = -8.0f * log1pf(expf(-F.lru_lam[ch])), cfb = -8.0f * log1pf(expf(-F.lru_lam[DA + ch]));
    const int cg = F.tid & 15, tok0 = F.tid >> 4, chc = h * 128 + cg * 8;
    LAS float* CW = (LAS float*)(F.lds + 128 * XCT_STRIDE);
    for (int i = F.tid; i < 640; i += 512) CW[i] = i < 512 ? F.conv_a_w[(i >> 7) * DA + h * 128 + (i & 127)] : F.conv_a_b[h * 128 + (i - 512)];
    u32x4 xr[2][4];
#define GU_DECODE(k, b_, ci_, grow0_, t0_, seqlen_) const int b_ = (k) / (FINAL ? 128 : NCHUNK), ci_ = (k) % (FINAL ? 128 : NCHUNK); \
        const bool ctxu_ = !FINAL && ci_ < 4; const int t0_ = ctxu_ ? ci_ * 64 : (FINAL ? ci_ : ci_ - 4) * 64, seqlen_ = ctxu_ ? CTXL : SEQ, grow0_ = ctxu_ ? T + b_ * CTXL + t0_ : b_ * SEQ + t0_;
#define GU_LOAD(k) do { GU_DECODE(k, b_, ci_, grow0_, t0_, seqlen_) (void)ci_; \
        _Pragma("unroll") for (int it = 0; it < 2; ++it) _Pragma("unroll") for (int kk = 0; kk < 4; ++kk) { const int tt = t0_ + tok0 + 32 * it + kk - 2; \
            xr[it][kk] = (tt >= 0 && tt < seqlen_) ? *(const u32x4*)(F.XA + (size_t)(grow0_ + tok0 + 32 * it + kk - 2) * DA + chc) : (u32x4){0u, 0u, 0u, 0u}; } } while (0)
#pragma unroll 1
    for (int rep = 0; rep < nrep; ++rep) {
    int k = kb0;
    if (k < NU) GU_LOAD(k);
    for (; k < NU; k += kstride) {
        GU_DECODE(k, b, ci, grow0, t0, seqlen) (void)t0; (void)seqlen;
        __syncthreads();
#pragma unroll
        for (int it = 0; it < 2; ++it) { f32x4 a0 = *(const LAS f32x4*)(CW + 512 + cg * 8), a1 = *(const LAS f32x4*)(CW + 512 + cg * 8 + 4);
#pragma unroll
            for (int kk = 0; kk < 4; ++kk) { float xf[8]; unpack8(xr[it][kk], xf); a0 += *(const LAS f32x4*)(CW + kk * 128 + cg * 8) * (f32x4){xf[0], xf[1], xf[2], xf[3]}; a1 += *(const LAS f32x4*)(CW + kk * 128 + cg * 8 + 4) * (f32x4){xf[4], xf[5], xf[6], xf[7]}; }
            u32x4 o; o.x = cvt_pk_bf16(a0.x, a0.y); o.y = cvt_pk_bf16(a0.z, a0.w); o.z = cvt_pk_bf16(a1.x, a1.y); o.w = cvt_pk_bf16(a1.z, a1.w);
            *(LAS u32x4*)(xcT + (tok0 + 32 * it) * XCT_STRIDE + cg * 16) = o; }
        { const int kn = k + kstride; if (kn < NU) GU_LOAD(kn); }
        __syncthreads();
        f32x4 acc[4][4];
#pragma unroll
        for (int m = 0; m < 4; ++m)
#pragma unroll
            for (int td = 0; td < 4; ++td) acc[m][td] = (f32x4){0.f, 0.f, 0.f, 0.f};
#pragma unroll
        for (int ks = 0; ks < 4; ++ks) {
#pragma unroll
            for (int m = 0; m < 4; ++m) { const int arow = 16 * (c16 >> 2) + 4 * m + (c16 & 3); const bf16x8 af = *(const LAS bf16x8*)(xcT + arow * XCT_STRIDE + (ks * 32 + q * 8) * 2);
#pragma unroll
                for (int td = 0; td < 4; ++td) acc[m][td] = __builtin_amdgcn_mfma_f32_16x16x32_bf16(af, bfr[ks][td], acc[m][td], 0, 0, 0); }
        }
#pragma unroll
        for (int m = 0; m < 4; ++m)
#pragma unroll
            for (int rg = 0; rg < 4; ++rg) { const int tok = 16 * q + 4 * m + rg; const float xcv = __uint_as_float((unsigned)(*(const LAS unsigned short*)(xcT + tok * XCT_STRIDE + jrow * 2)) << 16);
                { float ao, bo; gate_pair(acc[m][0][rg] + brf, acc[m][2][rg] + bif, cff, xcv, ao, bo); acc[m][0][rg] = ao; acc[m][2][rg] = bo; }
                { float ao, bo; gate_pair(acc[m][1][rg] + brb, acc[m][3][rg] + bib, cfb, xcv, ao, bo); acc[m][1][rg] = ao; acc[m][3][rg] = bo; } }
        float Af = 1.f, Bf = 0.f, Ab = 1.f, Bb = 0.f;
#pragma unroll
        for (int m = 0; m < 4; ++m)
#pragma unroll
            for (int rg = 0; rg < 4; ++rg) { Bf = acc[m][0][rg] * Bf + acc[m][2][rg]; Af *= acc[m][0][rg]; }
#pragma unroll
        for (int m = 3; m >= 0; --m)
#pragma unroll
            for (int rg = 3; rg >= 0; --rg) { Bb = acc[m][1][rg] * Bb + acc[m][3][rg]; Ab *= acc[m][1][rg]; }
        float A_[4], B_[4], Ab_[4], Bb_[4];
#pragma unroll
        for (int qq = 0; qq < 4; ++qq) { A_[qq] = __shfl(Af, c16 + 16 * qq); B_[qq] = __shfl(Bf, c16 + 16 * qq); Ab_[qq] = __shfl(Ab, c16 + 16 * qq); Bb_[qq] = __shfl(Bb, c16 + 16 * qq); }
        if constexpr (!FINAL) {
            const float At = (A_[0] * A_[1]) * (A_[2] * A_[3]), Bt = ((B_[0] * A_[1] + B_[1]) * A_[2] + B_[2]) * A_[3] + B_[3];
            const float Abt = (Ab_[0] * Ab_[1]) * (Ab_[2] * Ab_[3]), Bbt = ((Bb_[3] * Ab_[2] + Bb_[2]) * Ab_[1] + Bb_[1]) * Ab_[0] + Bb_[0];
            if (q == 0) { F.AGG[(size_t)((0 * 2 + b) * NCHUNK + ci) * DA + ch] = (f32x2){At, Bt}; F.AGG[(size_t)((1 * 2 + b) * NCHUNK + ci) * DA + ch] = (f32x2){Abt, Bbt}; }
        } else {
            float hf = F.HIN[(size_t)((0 * 2 + b) * 128 + ci) * DA + ch], hb = F.HIN[(size_t)((1 * 2 + b) * 128 + ci) * DA + ch];
#pragma unroll
            for (int qq = 0; qq < 4; ++qq) hf = (qq < q) ? A_[qq] * hf + B_[qq] : hf;
#pragma unroll
            for (int qq = 3; qq >= 0; --qq) hb = (qq > q) ? Ab_[qq] * hb + Bb_[qq] : hb;
            float hs[4][4]; float hh = hf;
#pragma unroll
            for (int m = 0; m < 4; ++m)
#pragma unroll
                for (int rg = 0; rg < 4; ++rg) { hh = acc[m][0][rg] * hh + acc[m][2][rg]; hs[m][rg] = hh; }
            hh = hb;
#pragma unroll
            for (int m = 3; m >= 0; --m)
#pragma unroll
                for (int rg = 3; rg >= 0; --rg) { hh = acc[m][1][rg] * hh + acc[m][3][rg]; hs[m][rg] += hh; }
#pragma unroll
            for (int m = 0; m < 4; ++m)
#pragma unroll
                for (int rg = 0; rg < 4; ++rg) { const int tok = 16 * q + 4 * m + rg; *(LAS unsigned short*)(hsT + tok * XCT_STRIDE + jrow * 2) = (unsigned short)(cvt_pk_bf16(hs[m][rg], 0.f) & 0xffffu); }
            __syncthreads();
#pragma unroll
            for (int it = 0; it < 2; ++it) { const int tok = tok0 + 32 * it; *(u32x4*)(F.HS + (size_t)(grow0 + tok) * DA + chc) = *(const LAS u32x4*)(hsT + tok * XCT_STRIDE + cg * 16); }
        }
    }
    }
#undef GU_DECODE
#undef GU_LOAD
}
__device__ __forceinline__ void ph4(Frame& F) {
    LAS f32x2* G = (LAS f32x2*)F.lds;
    for (int u = F.bid; u < 128; u += F.nb) {
        const int dir = u >> 6, b = (u >> 5) & 1, ch = (u & 31) * 32 + (F.tid & 31), g = F.tid >> 5;
        const f32x2* ag = F.AGG + (size_t)((dir * 2 + b) * NCHUNK) * DA + ch; float* hin = F.HIN + (size_t)((dir * 2 + b) * 128) * DA + ch;
        f32x2 v[12]; float A = 1.f, B = 0.f;
        __syncthreads();
        if (g < 11) {
#pragma unroll
            for (int j = 0; j < 12; ++j) { const int p = g * 12 + j, cidx = dir == 0 ? p : (p < 4 ? 3 - p : 135 - p); v[j] = ag[(size_t)cidx * DA]; }
#pragma unroll
            for (int j = 0; j < 12; ++j) { B = v[j].x * B + v[j].y; A *= v[j].x; }
            G[g * 32 + (F.tid & 31)] = (f32x2){A, B};
        }
        __syncthreads();
        if (g < 11) {
            float hcur = 0.f;
            for (int gg = 0; gg < g; ++gg) { const f32x2 t = G[gg * 32 + (F.tid & 31)]; hcur = t.x * hcur + t.y; }
#pragma unroll
            for (int j = 0; j < 12; ++j) { const int p = g * 12 + j, cidx = dir == 0 ? p : (p < 4 ? 3 - p : 135 - p); if (cidx >= 4) hin[(size_t)(cidx - 4) * DA] = hcur; hcur = v[j].x * hcur + v[j].y; }
        }
    }
}
__device__ __forceinline__ void p5b_load(Frame& F, int t, int c0, int c1, u32x4 (&v)[12]) {
    const int tl = t & (SEQ - 1), col = tl & 63, grow = tl >> 6; const size_t ro = (size_t)t * DA; const u32x4 zero = {0u, 0u, 0u, 0u};
    v[0] = __builtin_nontemporal_load((const u32x4*)(F.Gb + ro + c0)); v[1] = __builtin_nontemporal_load((const u32x4*)(F.Gb + ro + c1)); v[2] = __builtin_nontemporal_load((const u32x4*)(F.HS + ro + c0)); v[3] = __builtin_nontemporal_load((const u32x4*)(F.HS + ro + c1));
    v[4] = __builtin_nontemporal_load((const u32x4*)(F.BB + ro + c0)); v[5] = __builtin_nontemporal_load((const u32x4*)(F.BB + ro + c1)); v[6] = *(const u32x4*)(F.P + ro + c0); v[7] = *(const u32x4*)(F.P + ro + c1);
    v[8] = col > 0 ? *(const u32x4*)(F.P + ro - DA + c0) : zero; v[9] = col < 63 ? *(const u32x4*)(F.P + ro + DA + c0) : zero;
    v[10] = grow > 0 ? *(const u32x4*)(F.P + ro - 64 * DA + c1) : zero; v[11] = grow < 127 ? *(const u32x4*)(F.P + ro + 64 * DA + c1) : zero;
}
__device__ __forceinline__ void p5b_item(Frame& F, int t, int c0, int c1, const u32x4 (&v)[12], const f32x4 (&wa)[2][2], const f32x4 (&wb)[2][2], const f32x4 (&w0)[2][2], const f32x4 (&w1)[2][2], const f32x4 (&w2)[2][2]) {
    float ya[2][8], yb[2][8]; float sa = 0.f, sb = 0.f;
#pragma unroll
    for (int cc = 0; cc < 2; ++cc) { float gg[8], hh[8]; unpack8(v[cc], gg); unpack8(v[2 + cc], hh);
#pragma unroll
        for (int j = 0; j < 8; ++j) { const float y = gg[j] * hh[j]; sa += y * y; ya[cc][j] = y * wa[cc][j >> 2][j & 3]; } }
#pragma unroll
    for (int cc = 0; cc < 2; ++cc) { float bq[8], a[8], m[8], p[8]; unpack8(v[4 + cc], bq); unpack8(v[6 + cc], a); unpack8(v[8 + 2 * cc], m); unpack8(v[9 + 2 * cc], p);
#pragma unroll
        for (int j = 0; j < 8; ++j) { const float y = bq[j] * (w0[cc][j >> 2][j & 3] * m[j] + w1[cc][j >> 2][j & 3] * a[j] + w2[cc][j >> 2][j & 3] * p[j]); sb += y * y; yb[cc][j] = y * wb[cc][j >> 2][j & 3]; } }
    sa = wave_sum(sa); sb = wave_sum(sb);
    const float ra = 1.0f / sqrtf(sa * (1.0f / DA) + EPS), rb = 1.0f / sqrtf(sb * (1.0f / DA) + EPS);
    bf16_t* yo = F.Y + (size_t)t * D;
#pragma unroll
    for (int cc = 0; cc < 2; ++cc) { const int c = cc ? c1 : c0; u32x4 o;
        o.x = cvt_pk_bf16(ya[cc][0] * ra, ya[cc][1] * ra); o.y = cvt_pk_bf16(ya[cc][2] * ra, ya[cc][3] * ra); o.z = cvt_pk_bf16(ya[cc][4] * ra, ya[cc][5] * ra); o.w = cvt_pk_bf16(ya[cc][6] * ra, ya[cc][7] * ra);
        *(u32x4*)(yo + c) = o;
        o.x = cvt_pk_bf16(yb[cc][0] * rb, yb[cc][1] * rb); o.y = cvt_pk_bf16(yb[cc][2] * rb, yb[cc][3] * rb); o.z = cvt_pk_bf16(yb[cc][4] * rb, yb[cc][5] * rb); o.w = cvt_pk_bf16(yb[cc][6] * rb, yb[cc][7] * rb);
        *(u32x4*)(yo + DA + c) = o; }
}
__device__ __forceinline__ void ph5b(Frame& F) {
    const int gw = F.bid * 8 + F.wave, NGW = F.nb * 8, c0 = 8 * F.lane, c1 = 512 + 8 * F.lane;
    if (gw >= T) return;
    f32x4 wa[2][2], wb[2][2], w0[2][2], w1[2][2], w2[2][2];
#pragma unroll
    for (int cc = 0; cc < 2; ++cc)
#pragma unroll
        for (int hh = 0; hh < 2; ++hh) { const int c = (cc ? c1 : c0) + 4 * hh; wa[cc][hh] = *(const f32x4*)(F.g_out_a + c); wb[cc][hh] = *(const f32x4*)(F.g_out_b + c);
            w0[cc][hh] = *(const f32x4*)(F.conv_b_w + c); w1[cc][hh] = *(const f32x4*)(F.conv_b_w + DA + c); w2[cc][hh] = *(const f32x4*)(F.conv_b_w + 2 * DA + c); }
    u32x4 va[12], vb[12]; int t = gw;
    p5b_load(F, t, c0, c1, va);
    for (;;) {
        const int t1 = t + NGW; const bool h1 = t1 < T;
        p5b_load(F, h1 ? t1 : t, c0, c1, vb);
        p5b_item(F, t, c0, c1, va, wa, wb, w0, w1, w2);
        if (!h1) break;
        const int t2 = t1 + NGW; const bool h2 = t2 < T;
        p5b_load(F, h2 ? t2 : t1, c0, c1, va);
        p5b_item(F, t1, c0, c1, vb, wa, wb, w0, w1, w2);
        if (!h2) break;
        t = t2;
    }
}

constexpr int XT_STRIDE = 2052;
__device__ __forceinline__ void ph7(Frame& F) {
    LAS float* Ac = (LAS float*)F.lds; LAS float* Bc = Ac + D; LAS float* XT = (LAS float*)(F.lds + 16384); LAS float* RED = XT; LAS float* LG = (LAS float*)(F.lds + 16384 + 16 * XT_STRIDE * 4);
    int curb = -1;
    for (int g = F.bid; g < T / 16; g += F.nb) {
        const int row0 = 16 * g, b = row0 >> 13;
        __syncthreads();
        if (b != curb) { for (int cc = F.tid; cc < D; cc += 512) { const float sh = F.MOD[b * 12288 + 6144 + cc], sl = F.MOD[b * 12288 + 8192 + cc]; Ac[cc] = F.g_ffn[cc] * (1.0f + sl); Bc[cc] = sh; } curb = b; __syncthreads(); }
#pragma unroll 1
        for (int rr = 0; rr < 2; ++rr) { const int r = F.wave * 2 + rr; const size_t row = (size_t)row0 + r;
            const f32x4* xr = (const f32x4*)(F.x + row * D) + F.lane; const u32x2* mr = (const u32x2*)(F.XN + row * D) + F.lane; f32x4 v[8]; float s = 0.f;
#pragma unroll
            for (int j = 0; j < 8; ++j) { const u32x2 mw = __builtin_nontemporal_load(mr + 64 * j); v[j] = __builtin_nontemporal_load(xr + 64 * j) + (f32x4){bf_lo(mw.x), bf_hi(mw.x), bf_lo(mw.y), bf_hi(mw.y)}; s += (v[j].x * v[j].x + v[j].y * v[j].y) + (v[j].z * v[j].z + v[j].w * v[j].w); }
            const float rstd = 1.0f / sqrtf(wave_sum(s) * (1.0f / D) + EPS);
            unsigned char* o6 = F.XN2 + row * D + (F.lane >> 2) * 128 + (F.lane & 3) * 16;
            u32x2* x1o = (u32x2*)(F.Y + row * D) + F.lane;
#pragma unroll
            for (int j = 0; j < 8; ++j) { u32x2 xw; xw.x = cvt_pk_bf16(v[j].x, v[j].y); xw.y = cvt_pk_bf16(v[j].z, v[j].w); __builtin_nontemporal_store(xw, x1o + 64 * j); }
#pragma unroll
            for (int j = 0; j < 8; ++j) { const f32x4 a = *(const LAS f32x4*)(Ac + 4 * (F.lane + 64 * j)), bq = *(const LAS f32x4*)(Bc + 4 * (F.lane + 64 * j)); const f32x4 o = v[j] * rstd * a + bq;
                v[j] = o;
                *(LAS f32x4*)(XT + r * XT_STRIDE + 4 * (F.lane + 64 * j)) = o; }
            { float fv[32];
#pragma unroll
              for (int j = 0; j < 8; ++j) { const f32x4 t = *(const LAS f32x4*)(XT + r * XT_STRIDE + 32 * F.lane + 4 * j); fv[4 * j] = t.x; fv[4 * j + 1] = t.y; fv[4 * j + 2] = t.z; fv[4 * j + 3] = t.w; }
              const u32x6 pk = cvt_fp6_32(fv, X6_SCALE);
              *(u32x4*)o6 = (u32x4){pk[0], pk[1], pk[2], pk[3]}; *(u32x4*)(o6 + 64) = (u32x4){pk[4], pk[5], pk[4], pk[5]}; }
        }
        __syncthreads();
        {
            const int r = F.lane & 15, q = F.lane >> 4; f32x4 acc0 = {0.f, 0.f, 0.f, 0.f}, acc1 = acc0;
#pragma unroll 8
            for (int i = 0; i < 16; ++i) { const int kb = 256 * F.wave + 16 * i + 4 * q; const f32x4 a4 = *(const LAS f32x4*)(XT + r * XT_STRIDE + kb);
#pragma unroll
                for (int u = 0; u < 4; ++u) { const float b0 = F.w_router[(kb + u) * NE + r], b1 = F.w_router[(kb + u) * NE + 16 + r];
                    acc0 = __builtin_amdgcn_mfma_f32_16x16x4f32(a4[u], b0, acc0, 0, 0, 0); acc1 = __builtin_amdgcn_mfma_f32_16x16x4f32(a4[u], b1, acc1, 0, 0, 0); } }
            __syncthreads();
#pragma unroll
            for (int rg = 0; rg < 4; ++rg) { RED[(F.wave * 16 + 4 * q + rg) * 32 + r] = acc0[rg]; RED[(F.wave * 16 + 4 * q + rg) * 32 + 16 + r] = acc1[rg]; }
        }
        __syncthreads();
        { const int tok = F.tid >> 5, e = F.tid & 31; float s = F.b_router[e];
#pragma unroll
          for (int w = 0; w < 8; ++w) s += RED[(w * 16 + tok) * 32 + e];
          LG[tok * 33 + e] = s; }
        __syncthreads();
        if (F.tid < 16) { const int tok = F.tid; unsigned taken = 0u; float tv[4]; int te[4];
#pragma unroll
            for (int k = 0; k < 4; ++k) { float best = -3.0e38f; int bi = 0;
                for (int e = 0; e < NE; ++e) { const float v = LG[tok * 33 + e]; if (!((taken >> e) & 1u) && v > best) { best = v; bi = e; } }
                taken |= 1u << bi; tv[k] = best; te[k] = bi; }
            float ex[4], sum = 0.f;
#pragma unroll
            for (int k = 0; k < 4; ++k) { ex[k] = expf(tv[k] - tv[0]); sum += ex[k]; }
            const float inv = 1.0f / sum; const int token = row0 + tok;
            unsigned rank[4];
#pragma unroll
            for (int k = 0; k < 4; ++k) rank[k] = atomicAdd(F.CNT + te[k], 1u);
#pragma unroll
            for (int k = 0; k < 4; ++k) { F.STOK[(size_t)te[k] * CAP + rank[k]] = token; F.SLW[(size_t)te[k] * CAP + rank[k]] = ex[k] * inv; F.ER[token * 4 + k] = (unsigned)te[k] | (rank[k] << 8); }
        }
    }
}
__device__ __forceinline__ void moe_tables(Frame& F) {
    __syncthreads();
    if (F.tid < 64) {
        const int e = F.tid, c = e < NE ? (int)F.CNT[e] : 0, tl = (c + 255) >> 8;
        int incl = tl;
#pragma unroll
        for (int d = 1; d < NE; d <<= 1) { const int o = __shfl_up(incl, d); if (e >= d) incl += o; }
        if (e < NE) { F.MISC[128 + e] = (unsigned)c; F.MISC[16 + e] = (unsigned)(incl - tl); F.MISC[64 + e] = (unsigned)(incl - tl); }
        if (e == NE - 1) { F.MISC[16 + NE] = (unsigned)incl; F.MISC[64 + NE] = (unsigned)incl; }
    }
    __syncthreads();
}
__device__ __forceinline__ void ph11(Frame& F) {
    LAS float* GT = (LAS float*)F.lds; LAS float* GF = GT + 2 * D;
    for (int cc = F.tid; cc < D; cc += 512) { GT[cc] = F.MOD[10240 + cc]; GT[D + cc] = F.MOD[12288 + 10240 + cc]; GF[cc] = F.g_final[cc]; }
    moe_tables(F);
    const int gw = F.bid * 8 + F.wave, NGW = F.nb * 8;
    u32x4 ern = gw < T ? *(const u32x4*)(F.ER + (size_t)gw * 4) : (u32x4){0u, 0u, 0u, 0u};
    for (int t = gw; t < T; t += NGW) {
        const int b = t >> 13; size_t pos[4]; const u32x4 erc = ern;
        { const int tn = t + NGW; ern = *(const u32x4*)(F.ER + (size_t)(tn < T ? tn : t) * 4); }
#pragma unroll
        for (int k = 0; k < 4; ++k) { const unsigned er = erc[k]; pos[k] = ((size_t)F.MISC[64 + (er & 255u)] << 8) + (er >> 8); }
        float x2[4][8]; float ssq = 0.f;
#pragma unroll
        for (int j = 0; j < 4; ++j) { const int col = 8 * (F.lane + 64 * j);
            const u32x4 mw = __builtin_nontemporal_load((const u32x4*)(F.Y + (size_t)t * D + col));
            const f32x4 xa = {bf_lo(mw.x), bf_hi(mw.x), bf_lo(mw.y), bf_hi(mw.y)}, xb = {bf_lo(mw.z), bf_hi(mw.z), bf_lo(mw.w), bf_hi(mw.w)};
            float s8[8] = {0.f, 0.f, 0.f, 0.f, 0.f, 0.f, 0.f, 0.f};
#pragma unroll
            for (int k = 0; k < 4; ++k) { const u32x2 ov = __builtin_nontemporal_load((const u32x2*)((const unsigned char*)F.O + pos[k] * D + col));
                const f32x2 q0 = __builtin_amdgcn_cvt_pk_f32_fp8((int)ov.x, false), q1 = __builtin_amdgcn_cvt_pk_f32_fp8((int)ov.x, true), q2 = __builtin_amdgcn_cvt_pk_f32_fp8((int)ov.y, false), q3 = __builtin_amdgcn_cvt_pk_f32_fp8((int)ov.y, true);
                s8[0] += q0.x; s8[1] += q0.y; s8[2] += q1.x; s8[3] += q1.y; s8[4] += q2.x; s8[5] += q2.y; s8[6] += q3.x; s8[7] += q3.y; }
#pragma unroll
            for (int i = 0; i < 8; ++i) s8[i] *= O8_INV;
            const f32x4 ga = *(const LAS f32x4*)(GT + b * D + col), gb = *(const LAS f32x4*)(GT + b * D + col + 4);
            x2[j][0] = xa.x + ga.x * s8[0]; x2[j][1] = xa.y + ga.y * s8[1]; x2[j][2] = xa.z + ga.z * s8[2]; x2[j][3] = xa.w + ga.w * s8[3];
            x2[j][4] = xb.x + gb.x * s8[4]; x2[j][5] = xb.y + gb.y * s8[5]; x2[j][6] = xb.z + gb.z * s8[6]; x2[j][7] = xb.w + gb.w * s8[7];
#pragma unroll
            for (int i = 0; i < 8; ++i) ssq += x2[j][i] * x2[j][i]; }
        const float rstd = 1.0f / sqrtf(wave_sum(ssq) * (1.0f / D) + EPS);
#pragma unroll
        for (int j = 0; j < 4; ++j) { const int col = 8 * (F.lane + 64 * j); const f32x4 fa = *(const LAS f32x4*)(GF + col), fb = *(const LAS f32x4*)(GF + col + 4);
            __builtin_nontemporal_store((f32x4){x2[j][0] * rstd * fa.x, x2[j][1] * rstd * fa.y, x2[j][2] * rstd * fa.z, x2[j][3] * rstd * fa.w}, (f32x4*)(F.out + (size_t)t * D + col));
            __builtin_nontemporal_store((f32x4){x2[j][4] * rstd * fb.x, x2[j][5] * rstd * fb.y, x2[j][6] * rstd * fb.z, x2[j][7] * rstd * fb.w}, (f32x4*)(F.out + (size_t)t * D + col + 4)); }
    }
}

struct Args { const float* in[29]; float* out; unsigned char* ws; int ph_lo, ph_hi, li, pad; };
__global__ void __launch_bounds__(512, 2) fwd_kernel(Args args) {
    extern __shared__ __attribute__((aligned(16))) unsigned char lds[];
    Frame F;
    F.lds = (LAS unsigned char*)lds; F.MISC = (volatile LAS unsigned*)(F.lds + MISC_OFF);
    F.tid = threadIdx.x; F.lane = F.tid & 63; F.wave = __builtin_amdgcn_readfirstlane(F.tid >> 6); F.G = gridDim.x;
    unsigned char* ws = args.ws;
    F.ctl = (unsigned*)(ws + WS_CTL);
    F.x = args.in[0]; F.c = args.in[1]; F.ctx = args.in[2]; F.c_ctx = args.in[3]; F.w_mod = args.in[4]; F.b_mod = args.in[5]; F.g_mix = args.in[6]; F.w_in = args.in[7];
    F.conv_a_w = args.in[8]; F.conv_a_b = args.in[9]; F.lru_w_r = args.in[10]; F.lru_b_r = args.in[11]; F.lru_w_i = args.in[12]; F.lru_b_i = args.in[13]; F.lru_lam = args.in[14];
    F.conv_b_w = args.in[15]; F.g_out_a = args.in[16]; F.g_out_b = args.in[17]; F.w_out = args.in[18]; F.g_ffn = args.in[19]; F.w_router = args.in[20]; F.b_router = args.in[21];
    F.w_gate = args.in[22]; F.b_gate = args.in[23]; F.w_up = args.in[24]; F.b_up = args.in[25]; F.w_down = args.in[26]; F.b_down = args.in[27]; F.g_final = args.in[28];
    F.out = args.out;
    F.MOD = (float*)(ws + WS_MOD); F.WG = (bf16_t*)(ws + WS_WG); F.WIN = (bf16_t*)(ws + WS_WIN); F.WOUT = (bf16_t*)(ws + WS_WOUT); F.XN = (bf16_t*)(ws + WS_XN); F.Gb = (bf16_t*)(ws + WS_G);
    F.XA = (bf16_t*)(ws + WS_XA); F.BB = (bf16_t*)(ws + WS_BB); F.P = (bf16_t*)(ws + WS_P); F.Y = (bf16_t*)(ws + WS_Y); F.WGU = (bf16_t*)(ws + WS_WGU); F.WDN = (bf16_t*)(ws + WS_WDN);
    F.H = (bf16_t*)(ws + WS_H); F.O = (bf16_t*)(ws + WS_O); F.AGG = (f32x2*)(ws + WS_AGG); F.HIN = (float*)(ws + WS_HIN); F.ER = (unsigned*)(ws + WS_ER); F.STOK = (int*)(ws + WS_STOK);
    F.SLW = (float*)(ws + WS_SLW); F.CNT = F.ctl + CW_CNT; F.HS = (bf16_t*)(ws + WS_HS); F.XN2 = ws + WS_XN2;
    for (int u = F.tid; u < (LDS_BYTES - MISC_OFF) / 4; u += 512) F.MISC[u] = 0u;
    __syncthreads();
    const bool split = (F.G % 64) == 0 && NC8 > 0;
    const int row8 = (int)blockIdx.x >> 3;
    const bool conv_role = split && ((row8 & 7) < NC8);
    const int Gm = split ? (F.G / 8) * (8 - NC8) : F.G, Gc = split ? (F.G / 8) * NC8 : F.G;
    const int cm = split ? ((int)blockIdx.x & 7) + 8 * ((row8 >> 3) * (8 - NC8) + ((row8 & 7) - NC8)) : (int)blockIdx.x;
    const int cc = split ? ((int)blockIdx.x & 7) + 8 * ((row8 >> 3) * NC8 + (row8 & 7)) : (int)blockIdx.x;
    XcdBarrier bar = xcd_barrier_post(F.ctl + CW_BAR, F.MISC + 8, (unsigned)F.G, true);
    XcdBarrier barM = xcd_barrier_post(F.ctl + CW_BARM, F.MISC + 10, (unsigned)Gm, !conv_role);
#ifndef PH_MASK
#define PH_MASK 0xFFF
#endif
#define IN(k) ((PH_MASK >> (k)) & 1)
#define REP(k) ((REPEAT_MASK >> (k)) & 1)
#define NREP(k) (1 + (REP(k) ? args.pad : 0))

    if (conv_role) {
        F.bid = cc; F.nb = Gc;
        if (IN(8)) { ph_expert_conv6(F); ph_expert_conv(F); }
    } else {
        F.bid = cm; F.nb = Gm;
        if (IN(0)) ph0(F);
        xcd_barrier(barM);
        if (IN(1)) ph1(F);
        xcd_barrier(barM);
        if (IN(2)) {
            DenseOrder S; S.nM = 64; S.nN = 20; S.nwg = 1280; S.G = Gm; S.c = cm; S.nX = 0; S.A = (const char*)F.XN; S.Bt = (const char*)F.WIN; S.tstep = (size_t)256 * D * 2;
            EpiInProj E{args.ws, F.P};
            pg8::gemm_phase<EpiInProj, DenseOrder, false, true, true, false>(F.lds, D, S, E);
        }
        if (IN(8)) { ph_expert_conv6(F); ph_expert_conv(F); }
    }
    F.bid = blockIdx.x; F.nb = F.G;
    xcd_barrier(bar);
    if (IN(3)) { gates_phase<false>(F, NREP(3)); } xcd_barrier(bar);
    if (IN(4)) { for (int r = 0; r < NREP(4); ++r) { if (r) xcd_barrier(bar); ph4(F); } } xcd_barrier(bar);
    if (IN(5)) { gates_phase<true>(F, NREP(5)); } xcd_barrier(bar);
    if (IN(5)) { for (int r = 0; r < NREP(7); ++r) { if (r) xcd_barrier(bar); ph5b(F); } } xcd_barrier(bar);
    if (IN(6)) {
        DenseOrder S; S.nM = 64; S.nN = 8; S.nwg = 512; S.G = F.G; S.c = blockIdx.x; S.nX = 0; S.A = (const char*)F.Y; S.Bt = (const char*)F.WOUT; S.tstep = (size_t)256 * D * 2;
        EpiOutProj E{F.XN, F.MOD};
        for (int r = 0; r < NREP(6); ++r) { if (r) xcd_barrier(bar); pg8::gemm_phase<EpiOutProj, DenseOrder, false, true, true, false>(F.lds, D, S, E); }
    } xcd_barrier(bar);
    if (IN(7)) { ph7(F); } xcd_barrier(bar);
    if (IN(9)) {
        moe_tables(F);
        MoeOrder S; S.tab = (const LAS int*)F.MISC; S.NT = 16; S.G = F.G; S.c = blockIdx.x; S.nwg = __builtin_amdgcn_readfirstlane((int)F.MISC[16 + NE]) * 16; S.A = (const char*)F.XN2; S.Bt = (const char*)F.WGU; S.STOK = F.STOK;
        S.bstep_e = (size_t)4096 * D; S.tstep = (size_t)256 * D; S.gather = true;
        EpiGU E{F.H, F.b_gate, F.b_up};
        for (int r = 0; r < NREP(9); ++r) { if (r) xcd_barrier(bar); pg8::gemm_phase<EpiGU, MoeOrder, true, true, true, true, true>(F.lds, D / 2, S, E); }
    } xcd_barrier(bar);
    if (IN(10)) {
        moe_tables(F);
        MoeOrder S; S.tab = (const LAS int*)F.MISC; S.NT = 8; S.G = F.G; S.c = blockIdx.x; S.nwg = __builtin_amdgcn_readfirstlane((int)F.MISC[16 + NE]) * 8; S.A = (const char*)F.H; S.Bt = (const char*)F.WDN; S.STOK = F.STOK;
        S.bstep_e = (size_t)D * FF; S.tstep = (size_t)256 * FF; S.gather = false;
        EpiDown E{F.O, F.b_down, F.SLW, (const LAS int*)F.MISC + 128};
        for (int r = 0; r < NREP(10); ++r) { if (r) xcd_barrier(bar); pg8::gemm_phase<EpiDown, MoeOrder, false, true, true, true>(F.lds, FF / 2, S, E); }
    } xcd_barrier(bar);
    if (IN(11)) { ph11(F); }
#undef IN
#undef REP
}

extern "C" void kernel_launch(void* const* d_in, const int* in_sizes, int n_in, void* d_out, int out_size, void* d_ws, size_t ws_size, hipStream_t stream) {
    static int grid = 0;
    if (grid == 0) {
        if (n_in != 29 || in_sizes[0] != T * D || out_size != T * D || ws_size < WS_END) { fprintf(stderr, "kernel_launch: unexpected shapes (n_in %d, in0 %d, out %d, ws %zu); nothing launched\n", n_in, n_in > 0 ? in_sizes[0] : -1, out_size, ws_size); grid = -1; return; }
        int dev = 0, cus = 0, per_cu = 0;
        if (hipGetDevice(&dev) != hipSuccess || hipDeviceGetAttribute(&cus, hipDeviceAttributeMultiprocessorCount, dev) != hipSuccess) { grid = -1; return; }
        if (hipFuncSetAttribute((const void*)fwd_kernel, hipFuncAttributeMaxDynamicSharedMemorySize, LDS_BYTES) != hipSuccess) { fprintf(stderr, "kernel_launch: hipFuncSetAttribute failed\n"); grid = -1; return; }
        if (hipOccupancyMaxActiveBlocksPerMultiprocessor(&per_cu, (const void*)fwd_kernel, 512, LDS_BYTES) != hipSuccess || per_cu < 1) fprintf(stderr, "kernel_launch: occupancy query reports %d\n", per_cu);
        (void)hipGetLastError();
        grid = cus;
    }
    if (grid < 0) return;
    (void)hipMemsetAsync((char*)d_ws + WS_CTL, 0, CTL_ZERO_BYTES, stream);
    Args a{};
    for (int i = 0; i < 29; ++i) a.in[i] = (const float*)d_in[i];
    a.out = (float*)d_out; a.ws = (unsigned char*)d_ws;
    a.ph_lo = 0; a.ph_hi = NPH; a.li = 0; a.pad = REPEAT_MASK ? 1 : 0; hipLaunchKernelGGL(fwd_kernel, dim3(grid), dim3(512), LDS_BYTES, stream, a);
}
```

```cpp
#include <hip/hip_runtime.h>
#include <cstdio>
#include <cstdint>
#include <type_traits>

#ifndef MK_N_LAUNCHES
#define MK_N_LAUNCHES 1
#endif

#define GAS __attribute__((address_space(1)))
#define LAS __attribute__((address_space(3)))
typedef unsigned short bf16_t;
typedef short bf16x8 __attribute__((ext_vector_type(8)));
typedef float f32x4 __attribute__((ext_vector_type(4)));
typedef float f32x2 __attribute__((ext_vector_type(2)));
typedef unsigned u32x4 __attribute__((ext_vector_type(4)));
typedef unsigned u32x2 __attribute__((ext_vector_type(2)));

constexpr int T = 16384, SEQ = 8192, D = 2048, DA = 1024, NIN = 5120, CTXL = 256, NCTX = 512, MROWS = T + NCTX;
constexpr int NE = 32, FF = 2048, CAP = 16384, HROWS = 73728;
constexpr int NCHUNK = 132;
constexpr float EPS = 1e-6f;
constexpr int NPH = 12;
constexpr int N_LAUNCHES = MK_N_LAUNCHES;
#ifndef REPEAT_MASK
#define REPEAT_MASK 0
#endif
#ifndef MK_NC8
#define MK_NC8 3
#endif
constexpr int NC8 = MK_NC8;

constexpr size_t MiB = 1u << 20;
constexpr size_t WS_CTL = 0, CTL_ZERO_BYTES = 1 * MiB;
constexpr size_t WS_MOD = 1 * MiB;
constexpr size_t WS_WG = 2 * MiB;
constexpr size_t WS_WIN = 4 * MiB;
constexpr size_t WS_WOUT = 24 * MiB;
constexpr size_t WS_AGG = 32 * MiB;
constexpr size_t WS_HIN = 38 * MiB;
constexpr size_t WS_ER = 40 * MiB;
constexpr size_t WS_STOK = 41 * MiB;
constexpr size_t WS_SLW = 43 * MiB;
constexpr size_t WS_XN = 48 * MiB;
constexpr size_t WS_G = 116 * MiB;
constexpr size_t WS_XA = 148 * MiB;
constexpr size_t WS_BB = 182 * MiB;
constexpr size_t WS_P = 214 * MiB;
constexpr size_t WS_Y = 246 * MiB;
constexpr size_t WS_WGU = 320 * MiB;
constexpr size_t WS_WDN = 832 * MiB;
constexpr size_t WS_H = 1088 * MiB;
constexpr size_t WS_O = 1376 * MiB;
constexpr size_t WS_HS = 1664 * MiB;
constexpr size_t WS_XN2 = 1696 * MiB;
constexpr size_t WS_END = 1728 * MiB;
constexpr int CW_CNT = 64;
constexpr int CW_BAR = 4096;
constexpr int CW_BARM = 8192;
constexpr int CW_Q0 = 96;
constexpr int CW_QCV6 = 224;
constexpr int CW_QCV = 160;

constexpr int LDS_BYTES = 155648;
constexpr int MISC_OFF = 154624;

__device__ __forceinline__ unsigned cvt_pk_bf16(float lo, float hi) { unsigned r; asm volatile("v_cvt_pk_bf16_f32 %0, %1, %2" : "=v"(r) : "v"(lo), "v"(hi)); return r; }
constexpr float X6_SCALE = 1.5f, GU_INV = 1.0f / 96.0f;
constexpr float W8_SCALE = 64.0f, W8_INV = 1.0f / 64.0f, O8_SCALE = 16.0f, O8_INV = 1.0f / 16.0f;
__device__ __forceinline__ unsigned pk4_fp8(float a, float b, float c, float d) { int w = 0; w = __builtin_amdgcn_cvt_pk_fp8_f32(a, b, w, false); w = __builtin_amdgcn_cvt_pk_fp8_f32(c, d, w, true); return (unsigned)w; }
__device__ __forceinline__ float bf_lo(unsigned w) { return __uint_as_float(w << 16); }
__device__ __forceinline__ float bf_hi(unsigned w) { return __uint_as_float(w & 0xffff0000u); }
__device__ __forceinline__ float fexp(float x) { return __builtin_amdgcn_exp2f(x * 1.44269504089f); }
__device__ __forceinline__ float fsigmoid(float x) { return __builtin_amdgcn_rcpf(1.0f + fexp(-x)); }
__device__ __forceinline__ float gelu_tanh(float x) { const float u = 0.7978845608028654f * (x + 0.044715f * x * x * x); return x * __builtin_amdgcn_rcpf(1.0f + fexp(-2.0f * u)); }
__device__ __forceinline__ float one_minus_exp(float u) { const float ser = -u * (1.0f + 0.5f * u * (1.0f + (1.0f / 3.0f) * u * (1.0f + 0.25f * u))); const float dir = 1.0f - fexp(u); return u > -0.05f ? ser : dir; }
__device__ __forceinline__ void gate_pair(float xr, float xi, float cf, float xc, float& a_out, float& b_out) {
    const float er = 1.0f + fexp(-fmaxf(xr, -30.0f)), ei = 1.0f + fexp(-fmaxf(xi, -30.0f)), inv = __builtin_amdgcn_rcpf(er * ei);
    const float r = inv * ei, ig = inv * er, la = cf * r, a = fexp(la), u = 2.0f * la;
    const float ser = -u * (1.0f + 0.5f * u * (1.0f + (1.0f / 3.0f) * u * (1.0f + 0.25f * u))), dir = 1.0f - a * a;
    a_out = a; b_out = __builtin_amdgcn_sqrtf(u > -0.05f ? ser : dir) * ig * xc;
}
__device__ __forceinline__ float wave_sum(float v) {
#pragma unroll
    for (int o = 1; o < 64; o <<= 1) v += __shfl_xor(v, o);
    return v;
}
__device__ __forceinline__ void unpack8(const u32x4 w, float (&f)[8]) { f[0] = bf_lo(w.x); f[1] = bf_hi(w.x); f[2] = bf_lo(w.y); f[3] = bf_hi(w.y); f[4] = bf_lo(w.z); f[5] = bf_hi(w.z); f[6] = bf_lo(w.w); f[7] = bf_hi(w.w); }

namespace pg8 {
#define PG8_LAS __attribute__((address_space(3)))
constexpr int BM = 256, BK = 64, HALF = 128, HTB = HALF * BK * 2, STAGE_BYTES = 8 * HTB, NXCD = 8, WGM = 8;
__host__ __device__ __forceinline__ int lds_byte(int r, int c) { const int st = (r >> 4) * 2 + (c >> 5), rr = r & 15, cc = c & 31, ob = rr * 64 + cc * 2; return st * 1024 + (ob ^ (((ob >> 9) & 1) << 5)); }
__host__ __device__ __forceinline__ void stage_rc(int b, int& R, int& C) { const int st = b / 1024, sb = b % 1024, swz = sb ^ (((sb >> 9) & 1) << 5); R = (st >> 1) * 16 + swz / 64; C = (st & 1) * 32 + (swz % 64) / 2; }
__host__ __device__ __forceinline__ int perm32(int rho) { const int n = rho >> 4, i = rho & 15; return 8 * (i >> 2) + 4 * n + (i & 3); }

struct Unit { int pm, pn, e, mt; };

__device__ __forceinline__ int xcd_remap(int L, int nwg) { const int q = nwg / NXCD, r = nwg % NXCD, xcd = L % NXCD, off = L / NXCD; return (xcd < r ? xcd * (q + 1) : r * (q + 1) + (xcd - r) * q) + off; }

typedef int i32x4 __attribute__((ext_vector_type(4)));
typedef int i32x8 __attribute__((ext_vector_type(8)));
__device__ __forceinline__ i32x8 cat8(const bf16x8 a, const bf16x8 b) { return __builtin_shufflevector(__builtin_bit_cast(i32x4, a), __builtin_bit_cast(i32x4, b), 0, 1, 2, 3, 4, 5, 6, 7); }
__device__ __forceinline__ void mfma_fp8(f32x4& acc, const i32x8 a, const i32x8 b, const int sc) {
    (void)sc; asm volatile("v_mfma_f32_16x16x128_f8f6f4 %0, %1, %2, %0" : "+v"(acc) : "v"(a), "v"(b)); }
typedef int i32x6 __attribute__((ext_vector_type(6)));
typedef int i32x2 __attribute__((ext_vector_type(2)));
__device__ __forceinline__ void mfma_fp6(f32x4& acc, const i32x6 a, const i32x6 b) { asm volatile("v_mfma_f32_16x16x128_f8f6f4 %0, %1, %2, %0 cbsz:2 blgp:2" : "+v"(acc) : "v"(a), "v"(b)); }
__device__ __forceinline__ i32x6 cat6(const bf16x8 a, const i32x2 b) { return __builtin_shufflevector(__builtin_bit_cast(i32x4, a), __builtin_shufflevector(b, b, 0, 1, -1, -1), 0, 1, 2, 3, 4, 5); }
template <int OFF> __device__ __forceinline__ i32x2 lds_rd64(const PG8_LAS unsigned char* p) { i32x2 r; asm volatile("ds_read_b64 %0, %1 offset:%2" : "=v"(r) : "v"(p), "n"(OFF)); return r; }
template <class Epi, class Sched, bool GATHER, bool ALIGN_EPI, bool SP2, bool FP8, bool FP6 = false>
__device__ __forceinline__ void gemm_phase(PG8_LAS unsigned char* lds, const int K, const Sched& S, const Epi& E) {
    int tid = threadIdx.x; asm volatile("" : "+v"(tid));
    const int wid = __builtin_amdgcn_readfirstlane(tid >> 6), lane = tid & 63, wr = wid >> 2, wc = wid & 3, fr = lane & 15, fq = lane >> 4;
    const int nt = K / BK;
    int Rr[2], Cc[2]; unsigned voffB[2]; unsigned vAc[2][2], vAn[2][2];
#pragma unroll
    for (int i = 0; i < 2; ++i) { stage_rc(tid * 16 + i * 8192, Rr[i], Cc[i]); const int Rb = Epi::PERM ? ((Rr[i] & ~31) + perm32(Rr[i] & 31)) : Rr[i];
        voffB[i] = (unsigned)(Rb * K + Cc[i]) * 2u; }
    const size_t kstep = (size_t)(BK * 2);
    const size_t hstep = (size_t)HALF * K * 2;
    const unsigned ldsw = (unsigned)wid * 1024u;
    const int aoff = lds_byte(wr * 64 + fr, fq * 8), boff = lds_byte(wc * 32 + fr, fq * 8);
    const int dup8 = 8 * ((fr >> 2) & 1);
#define PG8_SA(b, h) (((b) * 2 + (h)) * HTB)
#define PG8_SB(b, h) ((4 + (b) * 2 + (h)) * HTB)
#define PG8_STAGE(bufoff, gbase, voff) do { _Pragma("unroll") for (int _i = 0; _i < 2; ++_i) \
        __builtin_amdgcn_global_load_lds((const unsigned*)((const char*)(gbase) + (voff)[_i]), (PG8_LAS unsigned*)(lds + (bufoff) + ldsw + _i * 8192), 16, 0, 0); } while (0)
#define PG8_STAGE_A(bufoff, gbase, VO, h) do { if constexpr (GATHER) { PG8_STAGE(bufoff, gbase, (VO)[h]); } else { PG8_STAGE(bufoff, (gbase) + (h) * hstep, (VO)[0]); } } while (0)
#define PG8_LDA(dst, b, h) do { _Pragma("unroll") for (int m = 0; m < 4; ++m) dst[m] = *(const PG8_LAS bf16x8*)(lds + PG8_SA(b, h) + aoff + m * 2048); \
        if constexpr (FP6) { dst##2[0] = rd2<PG8_SA(b, h) + 1024>(lds + aoff + dup8); dst##2[1] = rd2<PG8_SA(b, h) + 3072>(lds + aoff + dup8); dst##2[2] = rd2<PG8_SA(b, h) + 5120>(lds + aoff + dup8); dst##2[3] = rd2<PG8_SA(b, h) + 7168>(lds + aoff + dup8); } \
        else { _Pragma("unroll") for (int m = 0; m < 4; ++m) dst##2[m] = rd2v(lds + PG8_SA(b, h) + aoff + m * 2048 + 1024); } } while (0)
#define PG8_LDB(dst, b, h) do { _Pragma("unroll") for (int n = 0; n < 2; ++n) dst[n] = *(const PG8_LAS bf16x8*)(lds + PG8_SB(b, h) + boff + n * 2048); \
        if constexpr (FP6) { dst##2[0] = rd2<PG8_SB(b, h) - 65536 + 1024>(lds + 65536 + boff + dup8); dst##2[1] = rd2<PG8_SB(b, h) - 65536 + 3072>(lds + 65536 + boff + dup8); } \
        else { _Pragma("unroll") for (int n = 0; n < 2; ++n) dst##2[n] = rd2v(lds + PG8_SB(b, h) + boff + n * 2048 + 1024); } } while (0)
#define PG8_MMA(ai, bj, At, Bt) do { __builtin_amdgcn_s_setprio(1); _Pragma("unroll") for (int m = 0; m < 4; ++m) _Pragma("unroll") for (int n = 0; n < 2; ++n) { \
        if constexpr (FP6) mfma_fp6(acc[ai][bj][m][n], cat6(Bt[n], Bt##2[n]), cat6(At[m], At##2[m])); \
        else if constexpr (FP8) mfma_fp8(acc[ai][bj][m][n], cat8(Bt[n], Bt##2[n]), cat8(At[m], At##2[m]), sc1); \
        else { acc[ai][bj][m][n] = __builtin_amdgcn_mfma_f32_16x16x32_bf16(Bt[n], At[m], acc[ai][bj][m][n], 0, 0, 0); acc[ai][bj][m][n] = __builtin_amdgcn_mfma_f32_16x16x32_bf16(Bt##2[n], At##2[m], acc[ai][bj][m][n], 0, 0, 0); } } __builtin_amdgcn_s_setprio(0); } while (0)
#define PG8_WAIT_V(n) asm volatile("s_waitcnt vmcnt(" #n ")" ::: "memory")
#define PG8_WAIT_L(n) asm volatile("s_waitcnt lgkmcnt(" #n ")" ::: "memory")
#define PG8_BAR __builtin_amdgcn_s_barrier()
#define PG8_SCHED __builtin_amdgcn_sched_barrier(0)
    int sc1 = 0x7F7F7F7F; asm volatile("" : "+v"(sc1));
    Unit cur, nxt; int ui = 0;
    if (!S.next(0, cur)) return;
    f32x4 acc[2][2][4][2];
#pragma unroll
    for (int a = 0; a < 2; ++a)
#pragma unroll
        for (int b = 0; b < 2; ++b)
#pragma unroll
            for (int m = 0; m < 4; ++m)
#pragma unroll
                for (int n = 0; n < 2; ++n) acc[a][b][m][n] = (f32x4){0.f, 0.f, 0.f, 0.f};
    using S2 = typename std::conditional<FP6, i32x2, bf16x8>::type;
    auto rd2v = [](const PG8_LAS unsigned char* p) -> S2 { return *(const PG8_LAS S2*)p; };
#define rd2 lds_rd64
    bf16x8 At[4], B0[2], B1[2]; S2 At2[4], B02[2], B12[2];
    const char* cA = S.a_base(cur); const char* cB = S.b_base(cur);
#pragma unroll
    for (int h = 0; h < 2; ++h)
#pragma unroll
        for (int i = 0; i < 2; ++i) { if constexpr (GATHER) vAc[h][i] = S.gather_off(cur, Rr[i] + HALF * h) + (unsigned)Cc[i] * 2u; else vAc[h][i] = (unsigned)(Rr[i] * K + Cc[i]) * 2u; vAn[h][i] = vAc[h][i]; }
    if constexpr (SP2) {
        PG8_STAGE(PG8_SB(0, 0), cB, voffB); PG8_STAGE(PG8_SB(0, 1), cB + hstep, voffB); PG8_STAGE_A(PG8_SA(0, 0), cA, vAc, 0); PG8_STAGE_A(PG8_SA(0, 1), cA, vAc, 1);
        if (wr == 1) PG8_BAR;
        PG8_WAIT_V(2); PG8_BAR;
        PG8_STAGE(PG8_SB(1, 0), cB + kstep, voffB); PG8_STAGE_A(PG8_SA(1, 0), cA + kstep, vAc, 0); PG8_STAGE(PG8_SB(1, 1), cB + hstep + kstep, voffB);
        PG8_WAIT_V(6); PG8_BAR;
    } else {
        PG8_STAGE(PG8_SB(0, 0), cB, voffB); PG8_STAGE_A(PG8_SA(0, 0), cA, vAc, 0); PG8_STAGE(PG8_SB(0, 1), cB + hstep, voffB); PG8_STAGE_A(PG8_SA(0, 1), cA, vAc, 1);
        if (wr == 1) PG8_BAR;
        PG8_WAIT_V(4); PG8_BAR;
        PG8_STAGE(PG8_SB(1, 0), cB + kstep, voffB); PG8_STAGE_A(PG8_SA(1, 0), cA + kstep, vAc, 0); PG8_STAGE(PG8_SB(1, 1), cB + hstep + kstep, voffB);
        PG8_WAIT_V(6); PG8_BAR;
    }
    for (;;) {
        const bool has_next = S.next(ui + 1, nxt);
        const char* nA = has_next ? S.a_base(nxt) : cA; const char* nB = has_next ? S.b_base(nxt) : cB;
        if constexpr (Epi::TAB_N > 0) { if (wid < Epi::TAB_N / 64) __builtin_amdgcn_global_load_lds((const unsigned*)E.tab_src(cur, tid), (PG8_LAS unsigned*)(lds + STAGE_BYTES + 1024 + (ui & 1) * 2048 + wid * 256), 4, 0, 0); }
        if constexpr (GATHER) { if (has_next && wid < 4) __builtin_amdgcn_global_load_lds((const unsigned*)S.tok_src(nxt, tid), (PG8_LAS unsigned*)(lds + STAGE_BYTES + wid * 256), 4, 0, 0); }
        for (int t = 0; t < nt; t += 2) {
            const bool last = (t == nt - 2);
            const char* a1 = cA + (size_t)(t + 1) * kstep;
            const char* a2 = last ? nA : cA + (size_t)(t + 2) * kstep; const char* b2 = last ? nB : cB + (size_t)(t + 2) * kstep;
            const char* a3 = a2 + kstep; const char* b3 = b2 + kstep;
            if constexpr (GATHER) { if (last && has_next) {
#pragma unroll
                for (int h = 0; h < 2; ++h)
#pragma unroll
                    for (int i = 0; i < 2; ++i) vAn[h][i] = *(const PG8_LAS unsigned*)(lds + STAGE_BYTES + 4 * (Rr[i] + HALF * h)) * (unsigned)(K * 2) + (unsigned)Cc[i] * 2u; } }
            unsigned v2[2][2];
#pragma unroll
            for (int h = 0; h < 2; ++h)
#pragma unroll
                for (int i = 0; i < 2; ++i) v2[h][i] = GATHER ? (last ? vAn[h][i] : vAc[h][i]) : vAc[0][i];
            if constexpr (SP2) {
            PG8_LDB(B0, 0, 0); PG8_LDB(B1, 0, 1); PG8_SCHED; PG8_LDA(At, 0, 0); PG8_STAGE_A(PG8_SA(1, 1), a1, vAc, 1);
            PG8_WAIT_V(8); PG8_WAIT_L(0); PG8_BAR; PG8_MMA(0, 0, At, B0); PG8_MMA(0, 1, At, B1); PG8_BAR; PG8_SCHED;
            PG8_LDA(At, 0, 1); PG8_STAGE(PG8_SB(0, 0), b2, voffB); PG8_STAGE(PG8_SB(0, 1), b2 + hstep, voffB); PG8_STAGE_A(PG8_SA(0, 0), a2, v2, 0);
            PG8_WAIT_V(8); PG8_WAIT_L(0); PG8_BAR; PG8_MMA(1, 0, At, B0); PG8_MMA(1, 1, At, B1); PG8_BAR; PG8_SCHED;
            PG8_LDB(B0, 1, 0); PG8_LDB(B1, 1, 1); PG8_SCHED; PG8_LDA(At, 1, 0); PG8_STAGE_A(PG8_SA(0, 1), a2, v2, 1);
            PG8_WAIT_V(8); PG8_WAIT_L(0); PG8_BAR; PG8_MMA(0, 0, At, B0); PG8_MMA(0, 1, At, B1); PG8_BAR; PG8_SCHED;
            PG8_LDA(At, 1, 1); PG8_STAGE(PG8_SB(1, 0), b3, voffB); PG8_STAGE(PG8_SB(1, 1), b3 + hstep, voffB); PG8_STAGE_A(PG8_SA(1, 0), a3, v2, 0);
            PG8_WAIT_V(8); PG8_WAIT_L(0); PG8_BAR; PG8_MMA(1, 0, At, B0); PG8_MMA(1, 1, At, B1); PG8_BAR; PG8_SCHED;
            } else {
            PG8_LDB(B0, 0, 0); PG8_SCHED; PG8_LDA(At, 0, 0); PG8_STAGE_A(PG8_SA(1, 1), a1, vAc, 1);
            PG8_WAIT_L(8); PG8_BAR; PG8_WAIT_L(0); PG8_MMA(0, 0, At, B0); PG8_BAR; PG8_SCHED;
            PG8_LDB(B1, 0, 1); PG8_STAGE(PG8_SB(0, 0), b2, voffB);
            PG8_BAR; PG8_WAIT_L(0); PG8_MMA(0, 1, At, B1); PG8_BAR;
            PG8_LDA(At, 0, 1); PG8_STAGE_A(PG8_SA(0, 0), a2, v2, 0);
            PG8_BAR; PG8_WAIT_L(0); PG8_MMA(1, 0, At, B0); PG8_BAR; PG8_SCHED;
            PG8_STAGE(PG8_SB(0, 1), b2 + hstep, voffB);
            PG8_WAIT_V(6); PG8_BAR; PG8_MMA(1, 1, At, B1); PG8_BAR;
            PG8_LDB(B0, 1, 0); PG8_SCHED; PG8_LDA(At, 1, 0); PG8_STAGE_A(PG8_SA(0, 1), a2, v2, 1);
            PG8_WAIT_L(8); PG8_BAR; PG8_WAIT_L(0); PG8_MMA(0, 0, At, B0); PG8_BAR; PG8_SCHED;
            PG8_LDB(B1, 1, 1); PG8_STAGE(PG8_SB(1, 0), b3, voffB);
            PG8_BAR; PG8_WAIT_L(0); PG8_MMA(0, 1, At, B1); PG8_BAR;
            PG8_LDA(At, 1, 1); PG8_STAGE_A(PG8_SA(1, 0), a3, v2, 0);
            PG8_BAR; PG8_WAIT_L(0); PG8_MMA(1, 0, At, B0); PG8_BAR; PG8_SCHED;
            PG8_STAGE(PG8_SB(1, 1), b3 + hstep, voffB);
            PG8_WAIT_V(6); PG8_BAR; PG8_MMA(1, 1, At, B1); PG8_BAR;
            }
        }
        if constexpr (ALIGN_EPI) { if (wr == 0) PG8_BAR; }
        if constexpr (FP8) asm volatile("s_nop 15\n\ts_nop 15" ::: "memory");
        E(acc, cur, wr, wc, fr, fq, (const PG8_LAS float*)(lds + STAGE_BYTES + 1024 + (ui & 1) * 2048));
        if (!has_next) break;
#pragma unroll
        for (int a = 0; a < 2; ++a)
#pragma unroll
            for (int b = 0; b < 2; ++b)
#pragma unroll
                for (int m = 0; m < 4; ++m)
#pragma unroll
                    for (int n = 0; n < 2; ++n) acc[a][b][m][n] = (f32x4){0.f, 0.f, 0.f, 0.f};
        cur = nxt; cA = nA; cB = nB; ++ui;
#pragma unroll
        for (int h = 0; h < 2; ++h)
#pragma unroll
            for (int i = 0; i < 2; ++i) vAc[h][i] = vAn[h][i];
        if constexpr (ALIGN_EPI) { if (wr == 1) PG8_BAR; }
    }
    PG8_WAIT_V(0);
    if constexpr (!ALIGN_EPI) { if (wr == 0) PG8_BAR; }
    PG8_BAR;
#undef rd2
#undef PG8_SA
#undef PG8_SB
#undef PG8_STAGE
#undef PG8_STAGE_A
#undef PG8_LDA
#undef PG8_LDB
#undef PG8_MMA
#undef PG8_WAIT_V
#undef PG8_WAIT_L
#undef PG8_BAR
#undef PG8_SCHED
}
}

#define XB_TMO      128
#define XB_XCNT(j)  (256  + 64 * (j))
#define XB_XSUB(j)  (1280 + 64 * (j))
#define XB_XGEN(j)  (2304 + 64 * (j))
#define XB_TOP      3328
#define XB_TOPGEN   3392
#define XCD_BAR_WORDS 3456
#define XB_SPIN_CAP (1u << 18)
__device__ __forceinline__ unsigned xb_ld(unsigned* p)              { return __hip_atomic_load(p, __ATOMIC_RELAXED, __HIP_MEMORY_SCOPE_AGENT); }
__device__ __forceinline__ unsigned xb_add(unsigned* p, unsigned v) { return __hip_atomic_fetch_add(p, v, __ATOMIC_RELAXED, __HIP_MEMORY_SCOPE_AGENT); }
__device__ __forceinline__ unsigned xb_xcc_id() { return (unsigned)__builtin_amdgcn_s_getreg((3 << 11) | 20) & 0xFu; }
#define XB_SPIN(cond, bar) do { unsigned _sp = 0; while (cond) { __builtin_amdgcn_s_sleep(1); \
    if ((++_sp & 255u) == 0u) { if (xb_ld(&(bar)[XB_TMO])) break; if (_sp > XB_SPIN_CAP) { atomicAdd(&(bar)[XB_TMO], 1u); break; } } } } while (0)
struct XcdBarrier { unsigned* bar; unsigned x; volatile LAS unsigned* st; unsigned expect; };
__device__ __forceinline__ XcdBarrier xcd_barrier_post(unsigned* bar, volatile LAS unsigned* st, unsigned expect, bool member) {
    XcdBarrier b; b.bar = bar; b.x = xb_xcc_id(); b.st = st; b.expect = expect;
    if (member && threadIdx.x == 0) (void)xb_add(&bar[XB_XCNT(b.x)], 1u);
    return b;
}
__device__ __forceinline__ void xcd_barrier_complete(unsigned* bar, unsigned x, unsigned G, unsigned& nloc, unsigned& nx) {
    unsigned sum, cnt, mine, sp = 0u;
    for (;;) {
        sum = 0u; cnt = 0u; mine = 0u;
#pragma unroll
        for (unsigned j = 0; j < 16; ++j) { const unsigned c = xb_ld(&bar[XB_XCNT(j)]); sum += c; cnt += (c > 0u) ? 1u : 0u; mine = (j == x) ? c : mine; }
        if (sum == G) break;
        __builtin_amdgcn_s_sleep(1);
        if ((++sp & 255u) == 0u) { if (xb_ld(&bar[XB_TMO])) break; if (sp > XB_SPIN_CAP) { atomicAdd(&bar[XB_TMO], 1u); break; } }
    }
    nloc = mine > 0u ? mine : 1u; nx = cnt > 0u ? cnt : 1u;
}
__device__ __forceinline__ void xcd_barrier(const XcdBarrier& b) {
    asm volatile("s_waitcnt vmcnt(0)" ::: "memory");
    __syncthreads();
    if (threadIdx.x == 0) {
        unsigned* bar = b.bar;
        __builtin_amdgcn_s_waitcnt(0);
        unsigned nloc = b.st[0], nx = b.st[1];
        if (nloc == 0u) { xcd_barrier_complete(bar, b.x, b.expect, nloc, nx); b.st[0] = nloc; b.st[1] = nx; }
        const unsigned old = xb_add(&bar[XB_XSUB(b.x)], 1u);
        const unsigned gen = old / nloc;
        if (old + 1u == (gen + 1u) * nloc) {
            __builtin_amdgcn_fence(__ATOMIC_RELEASE, "agent");
            asm volatile("s_waitcnt vmcnt(0)" ::: "memory");
            const unsigned og = xb_add(&bar[XB_TOP], 1u);
            const unsigned tg = og / nx;
            if (og + 1u == (tg + 1u) * nx) xb_add(&bar[XB_TOPGEN], 1u);
            else XB_SPIN(xb_ld(&bar[XB_TOPGEN]) == tg, bar);
            __builtin_amdgcn_fence(__ATOMIC_ACQUIRE, "agent");
            xb_add(&bar[XB_XGEN(b.x)], 1u);
            asm volatile("s_waitcnt vmcnt(0)" ::: "memory");
        } else {
            XB_SPIN(xb_ld(&bar[XB_XGEN(b.x)]) == gen, bar);
            __builtin_amdgcn_fence(__ATOMIC_ACQUIRE, "agent");
            asm volatile("s_waitcnt vmcnt(0)" ::: "memory");
        }
    }
    __syncthreads();
}

struct Frame {
    LAS unsigned char* lds;
    volatile LAS unsigned* MISC;
    unsigned* ctl;
    int tid, lane, wave, G;
    int bid, nb;
    const float *x, *c, *ctx, *c_ctx, *w_mod, *b_mod, *g_mix, *w_in, *conv_a_w, *conv_a_b, *lru_w_r, *lru_b_r, *lru_w_i, *lru_b_i, *lru_lam, *conv_b_w, *g_out_a, *g_out_b, *w_out,
        *g_ffn, *w_router, *b_router, *w_gate, *b_gate, *w_up, *b_up, *w_down, *b_down, *g_final;
    float* out;
    float* MOD; bf16_t *WG, *WIN, *WOUT, *XN, *Gb, *XA, *BB, *P, *Y, *WGU, *WDN, *H, *O, *HS;
    f32x2* AGG; float* HIN; unsigned* ER; int* STOK; float* SLW; unsigned* CNT; unsigned char* XN2;
};

struct EpiInProj {
    static constexpr bool PERM = true; static constexpr int TAB_N = 0;
    __device__ __forceinline__ const float* tab_src(const pg8::Unit&, int) const { return nullptr; }
    unsigned char* ws; bf16_t* P;
    __device__ __forceinline__ void operator()(const f32x4 (&acc)[2][2][4][2], const pg8::Unit& u, int wr, int wc, int fr, int fq, const LAS float* tab) const {
        const int row0 = u.pm * 256 + wr * 64 + fr, cl = wc * 32 + 8 * fq, pn = u.pn;
        if (pn < 12) {
            const size_t woff = pn < 4 ? WS_G : (pn < 8 ? WS_XA : WS_BB); bf16_t* dst = (bf16_t*)(ws + woff); const int colt = (pn & 3) * 256;
#pragma unroll
            for (int ai = 0; ai < 2; ++ai)
#pragma unroll
                for (int m = 0; m < 4; ++m) { bf16_t* rowp = dst + (size_t)(row0 + ai * 128 + m * 16) * DA + colt + cl;
#pragma unroll
                    for (int bj = 0; bj < 2; ++bj) { f32x4 v0 = acc[ai][bj][m][0], v1 = acc[ai][bj][m][1];
                        if (pn < 4) {
#pragma unroll
                            for (int j = 0; j < 4; ++j) { v0[j] = gelu_tanh(v0[j]); v1[j] = gelu_tanh(v1[j]); } }
                        u32x4 w; w.x = cvt_pk_bf16(v0[0], v0[1]); w.y = cvt_pk_bf16(v0[2], v0[3]); w.z = cvt_pk_bf16(v1[0], v1[1]); w.w = cvt_pk_bf16(v1[2], v1[3]);
                        *(u32x4*)(rowp + bj * 128) = w; } }
        } else {
            const int j = pn - 12;
#pragma unroll
            for (int ai = 0; ai < 2; ++ai)
#pragma unroll
                for (int m = 0; m < 4; ++m) { bf16_t* rowp = P + (size_t)(row0 + ai * 128 + m * 16) * DA + j * 128 + cl;
                    const f32x4 v0 = acc[ai][0][m][0] * acc[ai][1][m][0], v1 = acc[ai][0][m][1] * acc[ai][1][m][1];
                    u32x4 w; w.x = cvt_pk_bf16(v0[0], v0[1]); w.y = cvt_pk_bf16(v0[2], v0[3]); w.z = cvt_pk_bf16(v1[0], v1[1]); w.w = cvt_pk_bf16(v1[2], v1[3]);
                    *(u32x4*)rowp = w; }
        }
    }
};
struct EpiOutProj {
    static constexpr bool PERM = true; static constexpr int TAB_N = 0;
    __device__ __forceinline__ const float* tab_src(const pg8::Unit&, int) const { return nullptr; }
    bf16_t* MX; const float* MOD;
    __device__ __forceinline__ void operator()(const f32x4 (&acc)[2][2][4][2], const pg8::Unit& u, int wr, int wc, int fr, int fq, const LAS float* tab) const {
        const int row0 = u.pm * 256 + wr * 64 + fr, col0 = u.pn * 256 + wc * 32 + 8 * fq, b = u.pm >> 5;
        f32x4 gt[2][2];
#pragma unroll
        for (int bj = 0; bj < 2; ++bj)
#pragma unroll
            for (int n = 0; n < 2; ++n) gt[bj][n] = *(const f32x4*)(MOD + b * 12288 + 4096 + col0 + bj * 128 + 4 * n);
#pragma unroll
        for (int ai = 0; ai < 2; ++ai)
#pragma unroll
            for (int m = 0; m < 4; ++m) { bf16_t* rowp = MX + (size_t)(row0 + ai * 128 + m * 16) * D + col0;
#pragma unroll
                for (int bj = 0; bj < 2; ++bj) { const f32x4 v0 = gt[bj][0] * acc[ai][bj][m][0], v1 = gt[bj][1] * acc[ai][bj][m][1];
                    u32x4 w; w.x = cvt_pk_bf16(v0[0], v0[1]); w.y = cvt_pk_bf16(v0[2], v0[3]); w.z = cvt_pk_bf16(v1[0], v1[1]); w.w = cvt_pk_bf16(v1[2], v1[3]);
                    *(u32x4*)(rowp + bj * 128) = w; } }
    }
};
struct EpiGU {
    static constexpr bool PERM = true; static constexpr int TAB_N = 256;
    bf16_t* H; const float *b_gate, *b_up;
    __device__ __forceinline__ const float* tab_src(const pg8::Unit& u, int t) const { return (t < 128 ? b_gate : b_up) + u.e * FF + u.pn * 128 + (t & 127); }
    __device__ __forceinline__ void operator()(const f32x4 (&acc)[2][2][4][2], const pg8::Unit& u, int wr, int wc, int fr, int fq, const LAS float* tab) const {
        const int row0 = u.pm * 256 + wr * 64 + fr, colg = u.pn * 128 + wc * 32 + 8 * fq;
        f32x4 bg[2], bu[2];
#pragma unroll
        for (int n = 0; n < 2; ++n) { bg[n] = *(const LAS f32x4*)(tab + wc * 32 + 8 * fq + 4 * n); bu[n] = *(const LAS f32x4*)(tab + 128 + wc * 32 + 8 * fq + 4 * n); }
#pragma unroll
        for (int ai = 0; ai < 2; ++ai)
#pragma unroll
            for (int m = 0; m < 4; ++m) { unsigned char* rowp = (unsigned char*)H + (size_t)(row0 + ai * 128 + m * 16) * FF + colg; f32x4 a[2];
#pragma unroll
                for (int n = 0; n < 2; ++n)
#pragma unroll
                    for (int j = 0; j < 4; j += 2) {
                        f32x2 g = (f32x2){acc[ai][0][m][n][j], acc[ai][0][m][n][j + 1]} * GU_INV + (f32x2){bg[n][j], bg[n][j + 1]};
                        f32x2 up = (f32x2){acc[ai][1][m][n][j], acc[ai][1][m][n][j + 1]} * GU_INV + (f32x2){bu[n][j], bu[n][j + 1]};
                        g.x = fminf(g.x, 7.0f); g.y = fminf(g.y, 7.0f); up.x = __builtin_amdgcn_fmed3f(up.x, -7.0f, 7.0f); up.y = __builtin_amdgcn_fmed3f(up.y, -7.0f, 7.0f);
                        const f32x2 t = g * (-1.702f * 1.44269504089f);
                        f32x2 d = (f32x2){__builtin_amdgcn_exp2f(t.x), __builtin_amdgcn_exp2f(t.y)} + 1.0f;
                        const f32x2 sg = {__builtin_amdgcn_rcpf(d.x), __builtin_amdgcn_rcpf(d.y)};
                        const f32x2 h = (up + 1.0f) * g * sg;
                        a[n][j] = h.x; a[n][j + 1] = h.y; }
                u32x2 w; w.x = pk4_fp8(a[0][0], a[0][1], a[0][2], a[0][3]); w.y = pk4_fp8(a[1][0], a[1][1], a[1][2], a[1][3]);
                *(u32x2*)rowp = w; }
    }
};
struct EpiDown {
    static constexpr bool PERM = true; static constexpr int TAB_N = 512;
    bf16_t* O; const float* b_down; const float* SLW; const LAS int* cnt;
    __device__ __forceinline__ const float* tab_src(const pg8::Unit& u, int t) const {
        if (t < 256) return b_down + u.e * D + u.pn * 256 + t;
        const int r = t - 256, nvalid = __builtin_amdgcn_readfirstlane(cnt[u.e]) - u.mt * 256; return SLW + (size_t)u.e * CAP + (r < nvalid ? u.mt * 256 + r : 0); }
    __device__ __forceinline__ void operator()(const f32x4 (&acc)[2][2][4][2], const pg8::Unit& u, int wr, int wc, int fr, int fq, const LAS float* tab) const {
        const int row0 = u.pm * 256 + wr * 64 + fr, cl = wc * 32 + 8 * fq, nvalid = __builtin_amdgcn_readfirstlane(cnt[u.e]) - u.mt * 256;
        f32x4 bd[2][2]; float wsl[2][4];
#pragma unroll
        for (int bj = 0; bj < 2; ++bj)
#pragma unroll
            for (int n = 0; n < 2; ++n) bd[bj][n] = *(const LAS f32x4*)(tab + bj * 128 + cl + 4 * n);
#pragma unroll
        for (int ai = 0; ai < 2; ++ai)
#pragma unroll
            for (int m = 0; m < 4; ++m) { const int r = ai * 128 + wr * 64 + m * 16 + fr; const float w = tab[256 + r]; wsl[ai][m] = r < nvalid ? w : 0.f; }
#pragma unroll
        for (int ai = 0; ai < 2; ++ai)
#pragma unroll
            for (int m = 0; m < 4; ++m) { const int r = ai * 128 + wr * 64 + m * 16 + fr; const float w8 = wsl[ai][m];
                unsigned char* rowp = (unsigned char*)O + (size_t)(row0 + ai * 128 + m * 16) * D + u.pn * 256 + cl;
#pragma unroll
                for (int bj = 0; bj < 2; ++bj) { const f32x4 v0 = (acc[ai][bj][m][0] * W8_INV + bd[bj][0]) * w8, v1 = (acc[ai][bj][m][1] * W8_INV + bd[bj][1]) * w8;
                    u32x2 w; w.x = pk4_fp8(v0[0] * O8_SCALE, v0[1] * O8_SCALE, v0[2] * O8_SCALE, v0[3] * O8_SCALE); w.y = pk4_fp8(v1[0] * O8_SCALE, v1[1] * O8_SCALE, v1[2] * O8_SCALE, v1[3] * O8_SCALE);
                    *(u32x2*)(rowp + bj * 128) = w; } }
    }
};

struct DenseOrder {
    int nM, nN, nwg, G, c, nX; const char *A, *Bt; size_t tstep;
    __device__ __forceinline__ bool next(int i, pg8::Unit& u) const {
        long L = (long)i * G + c; if (L >= nwg + nX) return false;
        u.e = 0; u.mt = 0;
        if (L < nX) { u.pm = 64 + (int)L / 4; u.pn = 4 + (int)L % 4; return true; }
        L -= nX;
        const int wgid = pg8::xcd_remap((int)L, nwg);
        const int nig = pg8::WGM * nN, gid = wgid / nig, fm = gid * pg8::WGM, gsz = (nM - fm) < pg8::WGM ? (nM - fm) : pg8::WGM;
        u.pm = fm + ((wgid % nig) % gsz); u.pn = (wgid % nig) / gsz; return true;
    }
    __device__ __forceinline__ const char* a_base(const pg8::Unit& u) const { return A + (size_t)u.pm * tstep; }
    __device__ __forceinline__ const char* b_base(const pg8::Unit& u) const { return Bt + (size_t)u.pn * tstep; }
    __device__ __forceinline__ unsigned gather_off(const pg8::Unit&, int) const { return 0u; }
    __device__ __forceinline__ const int* tok_src(const pg8::Unit&, int) const { return nullptr; }
};
struct MoeOrder {
    const LAS int* tab; int NT, G, c, nwg; const char *A, *Bt; const int* STOK; size_t bstep_e, tstep; bool gather;
    __device__ __forceinline__ bool next(int i, pg8::Unit& u) const {
        const int x = c & 7, npx = NT / 4, ng = NT / npx, mgn = 8 / ng, ngroup = x % ng, mgroup = x / ng, nbx = (G - x + 7) >> 3, q = i * nbx + (c >> 3);
        const int til = q / npx, ti = til * mgn + mgroup; if (ti >= nwg / NT) return false;
        u.pn = ngroup * npx + (q - til * npx);
        const int sl = (int)(threadIdx.x & 63), pv = tab[17 + (sl < NE - 1 ? sl : NE - 2)];
        const int e = (int)__popcll(__ballot(sl < NE - 1 && ti >= pv));
        u.e = e; u.mt = ti - __builtin_amdgcn_readfirstlane(tab[16 + e]); u.pm = __builtin_amdgcn_readfirstlane(tab[64 + e]) + u.mt; return true;
    }
    __device__ __forceinline__ const char* a_base(const pg8::Unit& u) const { return gather ? A : A + (size_t)u.pm * tstep; }
    __device__ __forceinline__ const char* b_base(const pg8::Unit& u) const { return Bt + (size_t)u.e * bstep_e + (size_t)u.pn * tstep; }
    __device__ __forceinline__ const int* tok_src(const pg8::Unit& u, int row) const { const int idx = u.mt * 256 + row; return STOK + (size_t)u.e * CAP + (idx < __builtin_amdgcn_readfirstlane(tab[128 + u.e]) ? idx : 0); }
    __device__ __forceinline__ unsigned gather_off(const pg8::Unit& u, int row) const { return (unsigned)(*tok_src(u, row)) * (unsigned)D; }
};

__device__ __forceinline__ void transpose_item(const float* W, int K, int N, int k0, int n0, bf16_t* WT, int orow0, LAS float* scr, int lane) {
#pragma unroll 8
    for (int i = 0; i < 32; ++i) { const int kk = 2 * i + (lane >> 5); scr[kk * 33 + (lane & 31)] = W[(size_t)(k0 + kk) * N + n0 + (lane & 31)]; }
    asm volatile("s_waitcnt lgkmcnt(0)" ::: "memory");
    const int c = lane & 7;
#pragma unroll
    for (int j = 0; j < 4; ++j) { const int n = (lane >> 3) + 8 * j; const LAS float* s = scr + (8 * c) * 33 + n;
        u32x4 o; o.x = cvt_pk_bf16(s[0 * 33], s[1 * 33]); o.y = cvt_pk_bf16(s[2 * 33], s[3 * 33]); o.z = cvt_pk_bf16(s[4 * 33], s[5 * 33]); o.w = cvt_pk_bf16(s[6 * 33], s[7 * 33]);
        *(u32x4*)(WT + (size_t)(orow0 + n) * K + k0 + 8 * c) = o; }
    asm volatile("s_waitcnt lgkmcnt(0)" ::: "memory");
}

__device__ __forceinline__ void transpose_item_fp8(const float* W, int K, int N, int k0, int n0, unsigned char* WT, int orow0, LAS float* scr, int lane) {
#pragma unroll 8
    for (int i = 0; i < 64; ++i) { const int kk = 2 * i + (lane >> 5); scr[kk * 33 + (lane & 31)] = W[(size_t)(k0 + kk) * N + n0 + (lane & 31)]; }
    asm volatile("s_waitcnt lgkmcnt(0)" ::: "memory");
    const int c = lane & 7;
#pragma unroll
    for (int j = 0; j < 4; ++j) { const int n = (lane >> 3) + 8 * j; const LAS float* s = scr + (16 * c) * 33 + n;
        u32x4 o; o.x = pk4_fp8(s[0 * 33] * W8_SCALE, s[1 * 33] * W8_SCALE, s[2 * 33] * W8_SCALE, s[3 * 33] * W8_SCALE); o.y = pk4_fp8(s[4 * 33] * W8_SCALE, s[5 * 33] * W8_SCALE, s[6 * 33] * W8_SCALE, s[7 * 33] * W8_SCALE);
        o.z = pk4_fp8(s[8 * 33] * W8_SCALE, s[9 * 33] * W8_SCALE, s[10 * 33] * W8_SCALE, s[11 * 33] * W8_SCALE); o.w = pk4_fp8(s[12 * 33] * W8_SCALE, s[13 * 33] * W8_SCALE, s[14 * 33] * W8_SCALE, s[15 * 33] * W8_SCALE);
        *(u32x4*)(WT + (size_t)(orow0 + n) * K + k0 + 16 * c) = o; }
    asm volatile("s_waitcnt lgkmcnt(0)" ::: "memory");
}

__device__ __forceinline__ void ph0(Frame& F) {
    LAS float* sc = (LAS float*)(F.lds + 67584);
    LAS float* red = (LAS float*)(F.lds + 67584 + 24576);
    LAS float* scr = (LAS float*)(F.lds + F.wave * 8448);
    constexpr int I_IN = (D / 64) * (NIN / 32), I_OUT = (D / 64) * (D / 32), I_G = 32 * 8, NJOB = 128 + (I_IN + I_OUT + I_G) / 32;
    bool have_sc = false;
    for (;;) {
        __syncthreads();
        if (F.tid == 0) F.MISC[12] = atomicAdd(F.ctl + CW_Q0, 1u);
        __syncthreads();
        const int job = __builtin_amdgcn_readfirstlane((int)F.MISC[12]);
        if (job >= NJOB) break;
        if (job < 128) {
            if (!have_sc) { for (int idx = F.tid; idx < 3 * D; idx += 512) { const int r = idx >> 11, k = idx & 2047; const float v = r < 2 ? F.c[r * D + k] : F.c_ctx[k]; sc[idx] = v * fsigmoid(v); } have_sc = true; __syncthreads(); }
            const int cg = job, sub = F.lane / 24, c4 = F.lane % 24;
            f32x4 a0 = {0.f, 0.f, 0.f, 0.f}, a1 = a0, a2 = a0;
            if (F.lane < 48) {
                const float* wp = F.w_mod + (size_t)(F.wave * 2 + sub) * 12288 + cg * 96 + c4 * 4;
                for (int it = 0; it < 128; it += 8) {
                    f32x4 wv[8];
#pragma unroll
                    for (int u = 0; u < 8; ++u) wv[u] = __builtin_nontemporal_load((const f32x4*)(wp + (size_t)(it + u) * 16 * 12288));
#pragma unroll
                    for (int u = 0; u < 8; ++u) { const int k = (it + u) * 16 + F.wave * 2 + sub; a0 += sc[k] * wv[u]; a1 += sc[D + k] * wv[u]; a2 += sc[2 * D + k] * wv[u]; }
                }
                LAS float* rp = red + (F.wave * 2 + sub) * 288 + c4 * 4;
                *(LAS f32x4*)(rp) = a0; *(LAS f32x4*)(rp + 96) = a1; *(LAS f32x4*)(rp + 192) = a2;
            }
            __syncthreads();
            if (F.tid < 288) { const int r = F.tid / 96, cc = F.tid % 96; float s = F.b_mod[cg * 96 + cc];
#pragma unroll
                for (int p = 0; p < 16; ++p) s += red[p * 288 + r * 96 + cc];
                F.MOD[r * 12288 + cg * 96 + cc] = s; }
        } else {
#pragma unroll 1
            for (int q = 0; q < 4; ++q) {
                int r = (job - 128) * 32 + q * 8 + F.wave;
                if (r < I_IN) { const int nblk = NIN / 32, k0 = 64 * (r / nblk), n0 = 32 * (r % nblk); int orow0;
                    if (n0 < 3072) orow0 = n0; else if (n0 < 4096) { const int qq = n0 - 3072; orow0 = 3072 + (qq >> 7) * 256 + (qq & 127); } else { const int qq = n0 - 4096; orow0 = 3072 + (qq >> 7) * 256 + 128 + (qq & 127); }
                    transpose_item(F.w_in, D, NIN, k0, n0, F.WIN, orow0, scr, F.lane); continue; }
                r -= I_IN;
                if (r < I_OUT) { const int nblk = D / 32, k0 = 64 * (r / nblk), n0 = 32 * (r % nblk); transpose_item(F.w_out, D, D, k0, n0, F.WOUT, n0, scr, F.lane); continue; }
                r -= I_OUT;
                { const int mat = r >> 3, sub = r & 7, type = mat >> 4, dh = mat & 15; const int k0 = 64 * (sub >> 2), n0 = 32 * (sub & 3);
                  const float* W = (type ? F.lru_w_i : F.lru_w_r) + (size_t)dh * 16384; transpose_item(W, 128, 128, k0, n0, F.WG + (size_t)(type * 16 + dh) * 16384, n0, scr, F.lane); }
            }
        }
    }
}

struct CvItem { const GAS float* W; GAS unsigned char* WT; };
typedef float f32x16 __attribute__((ext_vector_type(16)));
typedef unsigned u32x6 __attribute__((ext_vector_type(6)));
constexpr int CV6_NSTRIP = 2 * 32 * 64, CV6_FQ_PITCH = 1040, CV6_TILE_BYTES = 4 * CV6_FQ_PITCH * 4;
__device__ __forceinline__ u32x6 cvt_fp6_32(const float (&v)[32], const float scale) {
    f32x16 p, q;
#pragma unroll
    for (int i = 0; i < 16; ++i) { p[i] = v[i] * scale; q[i] = v[16 + i] * scale; }
    return __builtin_amdgcn_cvt_scalef32_2xpk16_fp6_f32(p, q, 1.0f);
}
__device__ __forceinline__ CvItem cv6_decode(Frame& F, int strip, int kt) {
    const int which = strip >> 11, e = (strip >> 6) & 31, n0 = 32 * (strip & 63);
    const unsigned long long m0 = which == 0 ? ~0ull : 0ull;
    const unsigned long long wsel = ((unsigned long long)F.w_gate & m0) | ((unsigned long long)F.w_up & ~m0);
    const int orow0 = (n0 >> 7) * 256 + which * 128 + (n0 & 127);
    CvItem c; c.W = (const GAS float*)wsel + (size_t)e * D * FF + (size_t)(128 * kt) * 2048 + n0;
    c.WT = (GAS unsigned char*)F.WGU + (size_t)e * 4096 * D + (size_t)orow0 * 2048 + kt * 128;
    return c;
}
__device__ __forceinline__ void cv6_load(const CvItem& c, int lane, f32x4 (&v)[16]) {
    const GAS float* p = c.W + (size_t)(lane >> 3) * 2048 + 4 * (lane & 7);
#pragma unroll
    for (int i = 0; i < 16; ++i) v[i] = __builtin_nontemporal_load((const GAS f32x4*)(p + (size_t)(8 * i) * 2048));
}
__device__ __forceinline__ void cv6_store(const CvItem& c, int lane, const f32x4 (&v)[16], LAS float* scr) {
    const int r8 = lane >> 3, c4 = lane & 7;
    LAS float* wb = scr + (r8 >> 2) * 128 + 4 * c4 + (r8 & 3);
#pragma unroll
    for (int i = 0; i < 16; ++i)
#pragma unroll
        for (int nn = 0; nn < 4; ++nn) wb[(i >> 2) * CV6_FQ_PITCH + 2 * (i & 3) * 128 + 32 * nn] = v[i][nn];
    asm volatile("s_waitcnt lgkmcnt(0)" ::: "memory");
#pragma unroll
    for (int rd = 0; rd < 2; ++rd) {
        const int npp = 16 * rd + (lane >> 2), fq = lane & 3;
        const LAS float* rb = scr + fq * CV6_FQ_PITCH + 4 * npp;
        float f[32];
#pragma unroll
        for (int j = 0; j < 8; ++j) { const f32x4 t = *(const LAS f32x4*)(rb + j * 128); f[4 * j] = t.x; f[4 * j + 1] = t.y; f[4 * j + 2] = t.z; f[4 * j + 3] = t.w; }
        const u32x6 pk = cvt_fp6_32(f, W8_SCALE);
        const unsigned lo4 = (unsigned)__builtin_amdgcn_update_dpp(0, (int)pk[4], 0x114, 0xf, 0xf, false), lo5 = (unsigned)__builtin_amdgcn_update_dpp(0, (int)pk[5], 0x114, 0xf, 0xf, false);
        const unsigned hi4 = (unsigned)__builtin_amdgcn_update_dpp(0, (int)pk[4], 0x104, 0xf, 0xf, false), hi5 = (unsigned)__builtin_amdgcn_update_dpp(0, (int)pk[5], 0x104, 0xf, 0xf, false);
        const bool odd = (npp & 1) != 0;
        const int na = odd ? npp - 1 : npp, nb = odd ? npp : npp + 1;
        GAS unsigned char* oa = c.WT + (size_t)(4 * (na & 7) + (na >> 3)) * 2048 + 16 * fq + (odd ? 64 : 0);
        GAS unsigned char* ob = c.WT + (size_t)(4 * (nb & 7) + (nb >> 3)) * 2048 + 16 * fq + (odd ? 0 : 64);
        const u32x4 f1 = {pk[0], pk[1], pk[2], pk[3]}, slo = {lo4, lo5, lo4, lo5}, shi = {hi4, hi5, hi4, hi5};
        __builtin_nontemporal_store(odd ? slo : f1, (GAS u32x4*)oa);
        __builtin_nontemporal_store(odd ? f1 : shi, (GAS u32x4*)ob);
    }
    asm volatile("s_waitcnt lgkmcnt(0)" ::: "memory");
}
__device__ __forceinline__ int cv6_claim(Frame& F) { int s = 0; if (F.lane == 0) s = (int)atomicAdd(F.ctl + CW_QCV6, 1u); return __builtin_amdgcn_readfirstlane(s); }
__device__ __forceinline__ void ph_expert_conv6(Frame& F) {
    LAS float* scr = (LAS float*)(F.lds + F.wave * CV6_TILE_BYTES);
    int sc = cv6_claim(F), kb = 0;
    if (sc >= CV6_NSTRIP) return;
    f32x4 va[16], vb[16];
    cv6_load(cv6_decode(F, sc, kb), F.lane, va);
    for (;;) {
        int s1 = sc, k1 = kb + 1; if (k1 == 16) { s1 = cv6_claim(F); k1 = 0; }
        const bool h1 = s1 < CV6_NSTRIP;
        cv6_load(cv6_decode(F, h1 ? s1 : sc, h1 ? k1 : kb), F.lane, vb);
        cv6_store(cv6_decode(F, sc, kb), F.lane, va, scr);
        if (!h1) break;
        int s2 = s1, k2 = k1 + 1; if (k2 == 16) { s2 = cv6_claim(F); k2 = 0; }
        const bool h2 = s2 < CV6_NSTRIP;
        cv6_load(cv6_decode(F, h2 ? s2 : s1, h2 ? k2 : k1), F.lane, va);
        cv6_store(cv6_decode(F, s1, k1), F.lane, vb, scr);
        if (!h2) break;
        sc = s2; kb = k2;
    }
}

constexpr int CV_PK = 132, CV_TILE_BYTES = 8 * CV_PK * 4, CV_NSTRIP = 32 * 64, CV_KB = 16;
__device__ __forceinline__ CvItem cv_decode(Frame& F, int strip, int kb) {
    const int which = 2, e = (strip >> 6) & 31, n0 = 32 * (strip & 63), k0 = 128 * kb;
    const unsigned long long m0 = which == 0 ? ~0ull : 0ull, m1 = which == 1 ? ~0ull : 0ull, m2 = which == 2 ? ~0ull : 0ull;
    const unsigned long long wsel = ((unsigned long long)F.w_gate & m0) | ((unsigned long long)F.w_up & m1) | ((unsigned long long)F.w_down & m2);
    const unsigned long long osel = ((unsigned long long)F.WGU & (m0 | m1)) | ((unsigned long long)F.WDN & m2);
    const int orow0 = which == 2 ? n0 : (n0 >> 7) * 256 + which * 128 + (n0 & 127);
    const size_t ebytes = which == 2 ? (size_t)D * FF : (size_t)4096 * D;
    CvItem c; c.W = (const GAS float*)wsel + (size_t)e * D * FF + (size_t)k0 * 2048 + n0;
    c.WT = (GAS unsigned char*)osel + (size_t)e * ebytes + (size_t)orow0 * 2048 + k0;
    return c;
}
__device__ __forceinline__ void cv_load(const CvItem& c, int lane, f32x4 (&v)[16]) {
    const GAS float* p = c.W + (size_t)(lane >> 3) * 2048 + 4 * (lane & 7);
#pragma unroll
    for (int i = 0; i < 16; ++i) v[i] = __builtin_nontemporal_load((const GAS f32x4*)(p + (size_t)(8 * i) * 2048));
}
__device__ __forceinline__ void cv_store(const CvItem& c, int lane, const f32x4 (&v)[16], LAS float* scr) {
    LAS unsigned* sb = (LAS unsigned*)scr;
    const int r8 = lane >> 3, c4 = lane & 7;
#pragma unroll
    for (int i = 0; i < 16; ++i) { const f32x4 w = v[i] * W8_SCALE; sb[c4 * CV_PK + 8 * i + r8] = pk4_fp8(w.x, w.y, w.z, w.w); }
    asm volatile("s_waitcnt lgkmcnt(0)" ::: "memory");
    const int n4 = lane >> 3, kb = lane & 7;
    u32x4 dq[4];
#pragma unroll
    for (int g = 0; g < 4; ++g) dq[g] = *(const LAS u32x4*)(sb + n4 * CV_PK + 16 * kb + 4 * g);
    u32x4 o[4];
#pragma unroll
    for (int g = 0; g < 4; ++g) {
        const unsigned lo01 = __builtin_amdgcn_perm(dq[g].y, dq[g].x, 0x05010400u), hi01 = __builtin_amdgcn_perm(dq[g].y, dq[g].x, 0x07030602u);
        const unsigned lo23 = __builtin_amdgcn_perm(dq[g].w, dq[g].z, 0x05010400u), hi23 = __builtin_amdgcn_perm(dq[g].w, dq[g].z, 0x07030602u);
        o[0][g] = __builtin_amdgcn_perm(lo23, lo01, 0x05040100u); o[1][g] = __builtin_amdgcn_perm(lo23, lo01, 0x07060302u);
        o[2][g] = __builtin_amdgcn_perm(hi23, hi01, 0x05040100u); o[3][g] = __builtin_amdgcn_perm(hi23, hi01, 0x07060302u);
    }
#pragma unroll
    for (int j = 0; j < 4; ++j) __builtin_nontemporal_store(o[j], (GAS u32x4*)(c.WT + (size_t)(4 * n4 + j) * 2048 + 16 * kb));
    asm volatile("s_waitcnt lgkmcnt(0)" ::: "memory");
}
__device__ __forceinline__ int cv_claim(Frame& F) { int s = 0; if (F.lane == 0) s = (int)atomicAdd(F.ctl + CW_QCV, 1u); return __builtin_amdgcn_readfirstlane(s); }
__device__ __forceinline__ void ph_expert_conv(Frame& F) {
    LAS float* scr = (LAS float*)(F.lds + F.wave * CV6_TILE_BYTES);
    int sc = cv_claim(F), kb = 0;
    if (sc >= CV_NSTRIP) return;
    f32x4 va[16], vb[16];
    cv_load(cv_decode(F, sc, kb), F.lane, va);
    for (;;) {
        int s1 = sc, k1 = kb + 1; if (k1 == CV_KB) { s1 = cv_claim(F); k1 = 0; }
        const bool h1 = s1 < CV_NSTRIP;
        cv_load(cv_decode(F, h1 ? s1 : sc, h1 ? k1 : kb), F.lane, vb);
        cv_store(cv_decode(F, sc, kb), F.lane, va, scr);
        if (!h1) break;
        int s2 = s1, k2 = k1 + 1; if (k2 == CV_KB) { s2 = cv_claim(F); k2 = 0; }
        const bool h2 = s2 < CV_NSTRIP;
        cv_load(cv_decode(F, h2 ? s2 : s1, h2 ? k2 : k1), F.lane, va);
        cv_store(cv_decode(F, s1, k1), F.lane, vb, scr);
        if (!h2) break;
        sc = s2; kb = k2;
    }
}

constexpr int AT_STRIDE = 4112;
__device__ __forceinline__ void ph1(Frame& F) {
    LAS float* Ac = (LAS float*)F.lds; LAS float* Bc = Ac + D;
    const int gw = F.bid * 8 + F.wave, NGW = F.nb * 8;
    for (int seg = 0; seg < 3; ++seg) {
        __syncthreads();
        for (int cc = F.tid; cc < D; cc += 512) { const float sh = F.MOD[seg * 12288 + cc], sl = F.MOD[seg * 12288 + D + cc]; Ac[cc] = F.g_mix[cc] * (1.0f + sl); Bc[cc] = sh; }
        __syncthreads();
        if (seg < 2) {
            const float* in = F.x + (size_t)seg * SEQ * D; bf16_t* outp = F.XN + (size_t)(seg * SEQ) * D;
            for (int m = gw; m < SEQ; m += NGW) {
                const f32x4* xr = (const f32x4*)(in + (size_t)m * D) + F.lane; f32x4 v[8]; float s = 0.f;
#pragma unroll
                for (int j = 0; j < 8; ++j) { v[j] = __builtin_nontemporal_load(xr + 64 * j); s += (v[j].x * v[j].x + v[j].y * v[j].y) + (v[j].z * v[j].z + v[j].w * v[j].w); }
                const float rstd = 1.0f / sqrtf(wave_sum(s) * (1.0f / D) + EPS);
                unsigned long long* o8 = (unsigned long long*)(outp + (size_t)m * D) + F.lane;
#pragma unroll
                for (int j = 0; j < 8; ++j) { const f32x4 a = *(const LAS f32x4*)(Ac + 4 * (F.lane + 64 * j)), b = *(const LAS f32x4*)(Bc + 4 * (F.lane + 64 * j)); const f32x4 o = v[j] * rstd * a + b;
                    o8[64 * j] = (unsigned long long)cvt_pk_bf16(o.x, o.y) | ((unsigned long long)cvt_pk_bf16(o.z, o.w) << 32); }
            }
        } else {
            LAS unsigned char* AT = F.lds + 16384; LAS float* RED = (LAS float*)(F.lds + 16384 + 16 * AT_STRIDE + 256);
            for (int u = F.bid; u < 256; u += F.nb) {
                const int rg = u >> 3, cg = u & 7;
                __syncthreads();
#pragma unroll 1
                for (int rr = 0; rr < 2; ++rr) { const int r = F.wave * 2 + rr;
                    const f32x4* xr = (const f32x4*)(F.ctx + (size_t)(16 * rg + r) * D) + F.lane; f32x4 v[8]; float s = 0.f;
#pragma unroll
                    for (int j = 0; j < 8; ++j) { v[j] = xr[64 * j]; s += (v[j].x * v[j].x + v[j].y * v[j].y) + (v[j].z * v[j].z + v[j].w * v[j].w); }
                    const float rstd = 1.0f / sqrtf(wave_sum(s) * (1.0f / D) + EPS);
#pragma unroll
                    for (int j = 0; j < 8; ++j) { const f32x4 a = *(const LAS f32x4*)(Ac + 4 * (F.lane + 64 * j)), b = *(const LAS f32x4*)(Bc + 4 * (F.lane + 64 * j)); const f32x4 o = v[j] * rstd * a + b;
                        u32x2 w; w.x = cvt_pk_bf16(o.x, o.y); w.y = cvt_pk_bf16(o.z, o.w); *(LAS u32x2*)(AT + r * AT_STRIDE + 8 * (F.lane + 64 * j)) = w; } }
                __syncthreads();
                const int c16 = F.lane & 15, q = F.lane >> 4;
                f32x4 acc[8];
#pragma unroll
                for (int n = 0; n < 8; ++n) acc[n] = (f32x4){0.f, 0.f, 0.f, 0.f};
                const bf16_t* wb = F.WIN + (size_t)(DA + 128 * cg + c16) * D + 256 * F.wave + 8 * q;
                const bf16_t* wp[8];
#pragma unroll
                for (int n = 0; n < 8; ++n) wp[n] = wb + (size_t)(16 * n) * D;
                u32x4 bA[8], bB[8];
#define P1_LD(dst, ks) do { _Pragma("unroll") for (int n = 0; n < 8; ++n) asm volatile("global_load_dwordx4 %0, %1, off offset:%2" : "=v"(dst[n]) : "v"(wp[n]), "n"(64 * (ks))); } while (0)
#define P1_WAIT(dst, cnt) asm volatile("s_waitcnt vmcnt(" #cnt ")" : "+v"(dst[0]), "+v"(dst[1]), "+v"(dst[2]), "+v"(dst[3]), "+v"(dst[4]), "+v"(dst[5]), "+v"(dst[6]), "+v"(dst[7]) :: "memory")
#define P1_MMA(dst, ks) do { const bf16x8 af = *(const LAS bf16x8*)(AT + c16 * AT_STRIDE + (256 * F.wave + 32 * (ks) + 8 * q) * 2); \
                    _Pragma("unroll") for (int n = 0; n < 8; ++n) acc[n] = __builtin_amdgcn_mfma_f32_16x16x32_bf16(af, __builtin_bit_cast(bf16x8, dst[n]), acc[n], 0, 0, 0); } while (0)
                P1_LD(bA, 0);
                P1_LD(bB, 1); P1_WAIT(bA, 8); P1_MMA(bA, 0);
                P1_LD(bA, 2); P1_WAIT(bB, 8); P1_MMA(bB, 1);
                P1_LD(bB, 3); P1_WAIT(bA, 8); P1_MMA(bA, 2);
                P1_LD(bA, 4); P1_WAIT(bB, 8); P1_MMA(bB, 3);
                P1_LD(bB, 5); P1_WAIT(bA, 8); P1_MMA(bA, 4);
                P1_LD(bA, 6); P1_WAIT(bB, 8); P1_MMA(bB, 5);
                P1_LD(bB, 7); P1_WAIT(bA, 8); P1_MMA(bA, 6);
                P1_WAIT(bB, 0); P1_MMA(bB, 7);
#undef P1_LD
#undef P1_WAIT
#undef P1_MMA
#pragma unroll
                for (int n = 0; n < 8; ++n)
#pragma unroll
                    for (int rg4 = 0; rg4 < 4; ++rg4) RED[(F.wave * 16 + 4 * q + rg4) * 128 + 16 * n + c16] = acc[n][rg4];
                __syncthreads();
                { const int tok = F.tid >> 5, c4 = (F.tid & 31) * 4; f32x4 sum = {0.f, 0.f, 0.f, 0.f};
#pragma unroll
                  for (int w = 0; w < 8; ++w) sum += *(const LAS f32x4*)(RED + (w * 16 + tok) * 128 + c4);
                  u32x2 o; o.x = cvt_pk_bf16(sum.x, sum.y); o.y = cvt_pk_bf16(sum.z, sum.w);
                  *(u32x2*)(F.XA + (size_t)(T + 16 * rg + tok) * DA + 128 * cg + c4) = o; }
            }
        }
    }
}

constexpr int XCT_STRIDE = 272;
template <bool FINAL>
__device__ __forceinline__ void gates_phase(Frame& F, const int nrep) {
    LAS unsigned char* xcT = F.lds; LAS unsigned char* hsT = F.lds + 64 * XCT_STRIDE;
    const int h = F.bid & 7, kb0 = F.bid >> 3, kstride = (F.nb - h + 7) >> 3;
    const int NU = FINAL ? 256 : 2 * NCHUNK;
    const int c16 = F.lane & 15, q = F.lane >> 4, jrow = F.wave * 16 + c16, ch = h * 128 + jrow;
    bf16x8 bfr[4][4];
#pragma unroll
    for (int ks = 0; ks < 4; ++ks)
#pragma unroll
        for (int td = 0; td < 4; ++td) bfr[ks][td] = *(const bf16x8*)(F.WG + (size_t)((td * 8 + h) * 128 + jrow) * 128 + ks * 32 + q * 8);
    const float brf = F.lru_b_r[ch], brb = F.lru_b_r[DA + ch], bif = F.lru_b_i[ch], bib = F.lru_b_i[DA + ch];
    const float cff = -8.0f * log1pf(expf(-F.lru_lam[ch])), cfb = -8.0f * log1pf(expf(-F.lru_lam[DA + ch]));
    const int cg = F.tid & 15, tok0 = F.tid >> 4, chc = h * 128 + cg * 8;
    LAS float* CW = (LAS float*)(F.lds + 128 * XCT_STRIDE);
    for (int i = F.tid; i < 640; i += 512) CW[i] = i < 512 ? F.conv_a_w[(i >> 7) * DA + h * 128 + (i & 127)] : F.conv_a_b[h * 128 + (i - 512)];
    u32x4 xr[2][4];
#define GU_DECODE(k, b_, ci_, grow0_, t0_, seqlen_) const int b_ = (k) / (FINAL ? 128 : NCHUNK), ci_ = (k) % (FINAL ? 128 : NCHUNK); \
        const bool ctxu_ = !FINAL && ci_ < 4; const int t0_ = ctxu_ ? ci_ * 64 : (FINAL ? ci_ : ci_ - 4) * 64, seqlen_ = ctxu_ ? CTXL : SEQ, grow0_ = ctxu_ ? T + b_ * CTXL + t0_ : b_ * SEQ + t0_;
#define GU_LOAD(k) do { GU_DECODE(k, b_, ci_, grow0_, t0_, seqlen_) (void)ci_; \
        _Pragma("unroll") for (int it = 0; it < 2; ++it) _Pragma("unroll") for (int kk = 0; kk < 4; ++kk) { const int tt = t0_ + tok0 + 32 * it + kk - 2; \
            xr[it][kk] = (tt >= 0 && tt < seqlen_) ? *(const u32x4*)(F.XA + (size_t)(grow0_ + tok0 + 32 * it + kk - 2) * DA + chc) : (u32x4){0u, 0u, 0u, 0u}; } } while (0)
#pragma unroll 1
    for (int rep = 0; rep < nrep; ++rep) {
    int k = kb0;
    if (k < NU) GU_LOAD(k);
    for (; k < NU; k += kstride) {
        GU_DECODE(k, b, ci, grow0, t0, seqlen) (void)t0; (void)seqlen;
        __syncthreads();
#pragma unroll
        for (int it = 0; it < 2; ++it) { f32x4 a0 = *(const LAS f32x4*)(CW + 512 + cg * 8), a1 = *(const LAS f32x4*)(CW + 512 + cg * 8 + 4);
#pragma unroll
            for (int kk = 0; kk < 4; ++kk) { float xf[8]; unpack8(xr[it][kk], xf); a0 += *(const LAS f32x4*)(CW + kk * 128 + cg * 8) * (f32x4){xf[0], xf[1], xf[2], xf[3]}; a1 += *(const LAS f32x4*)(CW + kk * 128 + cg * 8 + 4) * (f32x4){xf[4], xf[5], xf[6], xf[7]}; }
            u32x4 o; o.x = cvt_pk_bf16(a0.x, a0.y); o.y = cvt_pk_bf16(a0.z, a0.w); o.z = cvt_pk_bf16(a1.x, a1.y); o.w = cvt_pk_bf16(a1.z, a1.w);
            *(LAS u32x4*)(xcT + (tok0 + 32 * it) * XCT_STRIDE + cg * 16) = o; }
        { const int kn = k + kstride; if (kn < NU) GU_LOAD(kn); }
        __syncthreads();
        f32x4 acc[4][4];
#pragma unroll
        for (int m = 0; m < 4; ++m)
#pragma unroll
            for (int td = 0; td < 4; ++td) acc[m][td] = (f32x4){0.f, 0.f, 0.f, 0.f};
#pragma unroll
        for (int ks = 0; ks < 4; ++ks) {
#pragma unroll
            for (int m = 0; m < 4; ++m) { const int arow = 16 * (c16 >> 2) + 4 * m + (c16 & 3); const bf16x8 af = *(const LAS bf16x8*)(xcT + arow * XCT_STRIDE + (ks * 32 + q * 8) * 2);
#pragma unroll
                for (int td = 0; td < 4; ++td) acc[m][td] = __builtin_amdgcn_mfma_f32_16x16x32_bf16(af, bfr[ks][td], acc[m][td], 0, 0, 0); }
        }
#pragma unroll
        for (int m = 0; m < 4; ++m)
#pragma unroll
            for (int rg = 0; rg < 4; ++rg) { const int tok = 16 * q + 4 * m + rg; const float xcv = __uint_as_float((unsigned)(*(const LAS unsigned short*)(xcT + tok * XCT_STRIDE + jrow * 2)) << 16);
                { float ao, bo; gate_pair(acc[m][0][rg] + brf, acc[m][2][rg] + bif, cff, xcv, ao, bo); acc[m][0][rg] = ao; acc[m][2][rg] = bo; }
                { float ao, bo; gate_pair(acc[m][1][rg] + brb, acc[m][3][rg] + bib, cfb, xcv, ao, bo); acc[m][1][rg] = ao; acc[m][3][rg] = bo; } }
        float Af = 1.f, Bf = 0.f, Ab = 1.f, Bb = 0.f;
#pragma unroll
        for (int m = 0; m < 4; ++m)
#pragma unroll
            for (int rg = 0; rg < 4; ++rg) { Bf = acc[m][0][rg] * Bf + acc[m][2][rg]; Af *= acc[m][0][rg]; }
#pragma unroll
        for (int m = 3; m >= 0; --m)
#pragma unroll
            for (int rg = 3; rg >= 0; --rg) { Bb = acc[m][1][rg] * Bb + acc[m][3][rg]; Ab *= acc[m][1][rg]; }
        float A_[4], B_[4], Ab_[4], Bb_[4];
#pragma unroll
        for (int qq = 0; qq < 4; ++qq) { A_[qq] = __shfl(Af, c16 + 16 * qq); B_[qq] = __shfl(Bf, c16 + 16 * qq); Ab_[qq] = __shfl(Ab, c16 + 16 * qq); Bb_[qq] = __shfl(Bb, c16 + 16 * qq); }
        if constexpr (!FINAL) {
            const float At = (A_[0] * A_[1]) * (A_[2] * A_[3]), Bt = ((B_[0] * A_[1] + B_[1]) * A_[2] + B_[2]) * A_[3] + B_[3];
            const float Abt = (Ab_[0] * Ab_[1]) * (Ab_[2] * Ab_[3]), Bbt = ((Bb_[3] * Ab_[2] + Bb_[2]) * Ab_[1] + Bb_[1]) * Ab_[0] + Bb_[0];
            if (q == 0) { F.AGG[(size_t)((0 * 2 + b) * NCHUNK + ci) * DA + ch] = (f32x2){At, Bt}; F.AGG[(size_t)((1 * 2 + b) * NCHUNK + ci) * DA + ch] = (f32x2){Abt, Bbt}; }
        } else {
            float hf = F.HIN[(size_t)((0 * 2 + b) * 128 + ci) * DA + ch], hb = F.HIN[(size_t)((1 * 2 + b) * 128 + ci) * DA + ch];
#pragma unroll
            for (int qq = 0; qq < 4; ++qq) hf = (qq < q) ? A_[qq] * hf + B_[qq] : hf;
#pragma unroll
            for (int qq = 3; qq >= 0; --qq) hb = (qq > q) ? Ab_[qq] * hb + Bb_[qq] : hb;
            float hs[4][4]; float hh = hf;
#pragma unroll
            for (int m = 0; m < 4; ++m)
#pragma unroll
                for (int rg = 0; rg < 4; ++rg) { hh = acc[m][0][rg] * hh + acc[m][2][rg]; hs[m][rg] = hh; }
            hh = hb;
#pragma unroll
            for (int m = 3; m >= 0; --m)
#pragma unroll
                for (int rg = 3; rg >= 0; --rg) { hh = acc[m][1][rg] * hh + acc[m][3][rg]; hs[m][rg] += hh; }
#pragma unroll
            for (int m = 0; m < 4; ++m)
#pragma unroll
                for (int rg = 0; rg < 4; ++rg) { const int tok = 16 * q + 4 * m + rg; *(LAS unsigned short*)(hsT + tok * XCT_STRIDE + jrow * 2) = (unsigned short)(cvt_pk_bf16(hs[m][rg], 0.f) & 0xffffu); }
            __syncthreads();
#pragma unroll
            for (int it = 0; it < 2; ++it) { const int tok = tok0 + 32 * it; *(u32x4*)(F.HS + (size_t)(grow0 + tok) * DA + chc) = *(const LAS u32x4*)(hsT + tok * XCT_STRIDE + cg * 16); }
        }
    }
    }
#undef GU_DECODE
#undef GU_LOAD
}
__device__ __forceinline__ void ph4(Frame& F) {
    LAS f32x2* G = (LAS f32x2*)F.lds;
    for (int u = F.bid; u < 128; u += F.nb) {
        const int dir = u >> 6, b = (u >> 5) & 1, ch = (u & 31) * 32 + (F.tid & 31), g = F.tid >> 5;
        const f32x2* ag = F.AGG + (size_t)((dir * 2 + b) * NCHUNK) * DA + ch; float* hin = F.HIN + (size_t)((dir * 2 + b) * 128) * DA + ch;
        f32x2 v[12]; float A = 1.f, B = 0.f;
        __syncthreads();
        if (g < 11) {
#pragma unroll
            for (int j = 0; j < 12; ++j) { const int p = g * 12 + j, cidx = dir == 0 ? p : (p < 4 ? 3 - p : 135 - p); v[j] = ag[(size_t)cidx * DA]; }
#pragma unroll
            for (int j = 0; j < 12; ++j) { B = v[j].x * B + v[j].y; A *= v[j].x; }
            G[g * 32 + (F.tid & 31)] = (f32x2){A, B};
        }
        __syncthreads();
        if (g < 11) {
            float hcur = 0.f;
            for (int gg = 0; gg < g; ++gg) { const f32x2 t = G[gg * 32 + (F.tid & 31)]; hcur = t.x * hcur + t.y; }
#pragma unroll
            for (int j = 0; j < 12; ++j) { const int p = g * 12 + j, cidx = dir == 0 ? p : (p < 4 ? 3 - p : 135 - p); if (cidx >= 4) hin[(size_t)(cidx - 4) * DA] = hcur; hcur = v[j].x * hcur + v[j].y; }
        }
    }
}
__device__ __forceinline__ void p5b_load(Frame& F, int t, int c0, int c1, u32x4 (&v)[12]) {
    const int tl = t & (SEQ - 1), col = tl & 63, grow = tl >> 6; const size_t ro = (size_t)t * DA; const u32x4 zero = {0u, 0u, 0u, 0u};
    v[0] = __builtin_nontemporal_load((const u32x4*)(F.Gb + ro + c0)); v[1] = __builtin_nontemporal_load((const u32x4*)(F.Gb + ro + c1)); v[2] = __builtin_nontemporal_load((const u32x4*)(F.HS + ro + c0)); v[3] = __builtin_nontemporal_load((const u32x4*)(F.HS + ro + c1));
    v[4] = __builtin_nontemporal_load((const u32x4*)(F.BB + ro + c0)); v[5] = __builtin_nontemporal_load((const u32x4*)(F.BB + ro + c1)); v[6] = *(const u32x4*)(F.P + ro + c0); v[7] = *(const u32x4*)(F.P + ro + c1);
    v[8] = col > 0 ? *(const u32x4*)(F.P + ro - DA + c0) : zero; v[9] = col < 63 ? *(const u32x4*)(F.P + ro + DA + c0) : zero;
    v[10] = grow > 0 ? *(const u32x4*)(F.P + ro - 64 * DA + c1) : zero; v[11] = grow < 127 ? *(const u32x4*)(F.P + ro + 64 * DA + c1) : zero;
}
__device__ __forceinline__ void p5b_item(Frame& F, int t, int c0, int c1, const u32x4 (&v)[12], const f32x4 (&wa)[2][2], const f32x4 (&wb)[2][2], const f32x4 (&w0)[2][2], const f32x4 (&w1)[2][2], const f32x4 (&w2)[2][2]) {
    float ya[2][8], yb[2][8]; float sa = 0.f, sb = 0.f;
#pragma unroll
    for (int cc = 0; cc < 2; ++cc) { float gg[8], hh[8]; unpack8(v[cc], gg); unpack8(v[2 + cc], hh);
#pragma unroll
        for (int j = 0; j < 8; ++j) { const float y = gg[j] * hh[j]; sa += y * y; ya[cc][j] = y * wa[cc][j >> 2][j & 3]; } }
#pragma unroll
    for (int cc = 0; cc < 2; ++cc) { float bq[8], a[8], m[8], p[8]; unpack8(v[4 + cc], bq); unpack8(v[6 + cc], a); unpack8(v[8 + 2 * cc], m); unpack8(v[9 + 2 * cc], p);
#pragma unroll
        for (int j = 0; j < 8; ++j) { const float y = bq[j] * (w0[cc][j >> 2][j & 3] * m[j] + w1[cc][j >> 2][j & 3] * a[j] + w2[cc][j >> 2][j & 3] * p[j]); sb += y * y; yb[cc][j] = y * wb[cc][j >> 2][j & 3]; } }
    sa = wave_sum(sa); sb = wave_sum(sb);
    const float ra = 1.0f / sqrtf(sa * (1.0f / DA) + EPS), rb = 1.0f / sqrtf(sb * (1.0f / DA) + EPS);
    bf16_t* yo = F.Y + (size_t)t * D;
#pragma unroll
    for (int cc = 0; cc < 2; ++cc) { const int c = cc ? c1 : c0; u32x4 o;
        o.x = cvt_pk_bf16(ya[cc][0] * ra, ya[cc][1] * ra); o.y = cvt_pk_bf16(ya[cc][2] * ra, ya[cc][3] * ra); o.z = cvt_pk_bf16(ya[cc][4] * ra, ya[cc][5] * ra); o.w = cvt_pk_bf16(ya[cc][6] * ra, ya[cc][7] * ra);
        *(u32x4*)(yo + c) = o;
        o.x = cvt_pk_bf16(yb[cc][0] * rb, yb[cc][1] * rb); o.y = cvt_pk_bf16(yb[cc][2] * rb, yb[cc][3] * rb); o.z = cvt_pk_bf16(yb[cc][4] * rb, yb[cc][5] * rb); o.w = cvt_pk_bf16(yb[cc][6] * rb, yb[cc][7] * rb);
        *(u32x4*)(yo + DA + c) = o; }
}
__device__ __forceinline__ void ph5b(Frame& F) {
    const int gw = F.bid * 8 + F.wave, NGW = F.nb * 8, c0 = 8 * F.lane, c1 = 512 + 8 * F.lane;
    if (gw >= T) return;
    f32x4 wa[2][2], wb[2][2], w0[2][2], w1[2][2], w2[2][2];
#pragma unroll
    for (int cc = 0; cc < 2; ++cc)
#pragma unroll
        for (int hh = 0; hh < 2; ++hh) { const int c = (cc ? c1 : c0) + 4 * hh; wa[cc][hh] = *(const f32x4*)(F.g_out_a + c); wb[cc][hh] = *(const f32x4*)(F.g_out_b + c);
            w0[cc][hh] = *(const f32x4*)(F.conv_b_w + c); w1[cc][hh] = *(const f32x4*)(F.conv_b_w + DA + c); w2[cc][hh] = *(const f32x4*)(F.conv_b_w + 2 * DA + c); }
    u32x4 va[12], vb[12]; int t = gw;
    p5b_load(F, t, c0, c1, va);
    for (;;) {
        const int t1 = t + NGW; const bool h1 = t1 < T;
        p5b_load(F, h1 ? t1 : t, c0, c1, vb);
        p5b_item(F, t, c0, c1, va, wa, wb, w0, w1, w2);
        if (!h1) break;
        const int t2 = t1 + NGW; const bool h2 = t2 < T;
        p5b_load(F, h2 ? t2 : t1, c0, c1, va);
        p5b_item(F, t1, c0, c1, vb, wa, wb, w0, w1, w2);
        if (!h2) break;
        t = t2;
    }
}

constexpr int XT_STRIDE = 2052;
__device__ __forceinline__ void ph7(Frame& F) {
    LAS float* Ac = (LAS float*)F.lds; LAS float* Bc = Ac + D; LAS float* XT = (LAS float*)(F.lds + 16384); LAS float* RED = XT; LAS float* LG = (LAS float*)(F.lds + 16384 + 16 * XT_STRIDE * 4);
    int curb = -1;
    for (int g = F.bid; g < T / 16; g += F.nb) {
        const int row0 = 16 * g, b = row0 >> 13;
        __syncthreads();
        if (b != curb) { for (int cc = F.tid; cc < D; cc += 512) { const float sh = F.MOD[b * 12288 + 6144 + cc], sl = F.MOD[b * 12288 + 8192 + cc]; Ac[cc] = F.g_ffn[cc] * (1.0f + sl); Bc[cc] = sh; } curb = b; __syncthreads(); }
#pragma unroll 1
        for (int rr = 0; rr < 2; ++rr) { const int r = F.wave * 2 + rr; const size_t row = (size_t)row0 + r;
            const f32x4* xr = (const f32x4*)(F.x + row * D) + F.lane; const u32x2* mr = (const u32x2*)(F.XN + row * D) + F.lane; f32x4 v[8]; float s = 0.f;
#pragma unroll
            for (int j = 0; j < 8; ++j) { const u32x2 mw = __builtin_nontemporal_load(mr + 64 * j); v[j] = __builtin_nontemporal_load(xr + 64 * j) + (f32x4){bf_lo(mw.x), bf_hi(mw.x), bf_lo(mw.y), bf_hi(mw.y)}; s += (v[j].x * v[j].x + v[j].y * v[j].y) + (v[j].z * v[j].z + v[j].w * v[j].w); }
            const float rstd = 1.0f / sqrtf(wave_sum(s) * (1.0f / D) + EPS);
            unsigned char* o6 = F.XN2 + row * D + (F.lane >> 2) * 128 + (F.lane & 3) * 16;
            u32x2* x1o = (u32x2*)(F.Y + row * D) + F.lane;
#pragma unroll
            for (int j = 0; j < 8; ++j) { u32x2 xw; xw.x = cvt_pk_bf16(v[j].x, v[j].y); xw.y = cvt_pk_bf16(v[j].z, v[j].w); __builtin_nontemporal_store(xw, x1o + 64 * j); }
#pragma unroll
            for (int j = 0; j < 8; ++j) { const f32x4 a = *(const LAS f32x4*)(Ac + 4 * (F.lane + 64 * j)), bq = *(const LAS f32x4*)(Bc + 4 * (F.lane + 64 * j)); const f32x4 o = v[j] * rstd * a + bq;
                v[j] = o;
                *(LAS f32x4*)(XT + r * XT_STRIDE + 4 * (F.lane + 64 * j)) = o; }
            { float fv[32];
#pragma unroll
              for (int j = 0; j < 8; ++j) { const f32x4 t = *(const LAS f32x4*)(XT + r * XT_STRIDE + 32 * F.lane + 4 * j); fv[4 * j] = t.x; fv[4 * j + 1] = t.y; fv[4 * j + 2] = t.z; fv[4 * j + 3] = t.w; }
              const u32x6 pk = cvt_fp6_32(fv, X6_SCALE);
              *(u32x4*)o6 = (u32x4){pk[0], pk[1], pk[2], pk[3]}; *(u32x4*)(o6 + 64) = (u32x4){pk[4], pk[5], pk[4], pk[5]}; }
        }
        __syncthreads();
        {
            const int r = F.lane & 15, q = F.lane >> 4; f32x4 acc0 = {0.f, 0.f, 0.f, 0.f}, acc1 = acc0;
#pragma unroll 8
            for (int i = 0; i < 16; ++i) { const int kb = 256 * F.wave + 16 * i + 4 * q; const f32x4 a4 = *(const LAS f32x4*)(XT + r * XT_STRIDE + kb);
#pragma unroll
                for (int u = 0; u < 4; ++u) { const float b0 = F.w_router[(kb + u) * NE + r], b1 = F.w_router[(kb + u) * NE + 16 + r];
                    acc0 = __builtin_amdgcn_mfma_f32_16x16x4f32(a4[u], b0, acc0, 0, 0, 0); acc1 = __builtin_amdgcn_mfma_f32_16x16x4f32(a4[u], b1, acc1, 0, 0, 0); } }
            __syncthreads();
#pragma unroll
            for (int rg = 0; rg < 4; ++rg) { RED[(F.wave * 16 + 4 * q + rg) * 32 + r] = acc0[rg]; RED[(F.wave * 16 + 4 * q + rg) * 32 + 16 + r] = acc1[rg]; }
        }
        __syncthreads();
        { const int tok = F.tid >> 5, e = F.tid & 31; float s = F.b_router[e];
#pragma unroll
          for (int w = 0; w < 8; ++w) s += RED[(w * 16 + tok) * 32 + e];
          LG[tok * 33 + e] = s; }
        __syncthreads();
        if (F.tid < 16) { const int tok = F.tid; unsigned taken = 0u; float tv[4]; int te[4];
#pragma unroll
            for (int k = 0; k < 4; ++k) { float best = -3.0e38f; int bi = 0;
                for (int e = 0; e < NE; ++e) { const float v = LG[tok * 33 + e]; if (!((taken >> e) & 1u) && v > best) { best = v; bi = e; } }
                taken |= 1u << bi; tv[k] = best; te[k] = bi; }
            float ex[4], sum = 0.f;
#pragma unroll
            for (int k = 0; k < 4; ++k) { ex[k] = expf(tv[k] - tv[0]); sum += ex[k]; }
            const float inv = 1.0f / sum; const int token = row0 + tok;
            unsigned rank[4];
#pragma unroll
            for (int k = 0; k < 4; ++k) rank[k] = atomicAdd(F.CNT + te[k], 1u);
#pragma unroll
            for (int k = 0; k < 4; ++k) { F.STOK[(size_t)te[k] * CAP + rank[k]] = token; F.SLW[(size_t)te[k] * CAP + rank[k]] = ex[k] * inv; F.ER[token * 4 + k] = (unsigned)te[k] | (rank[k] << 8); }
        }
    }
}
__device__ __forceinline__ void moe_tables(Frame& F) {
    __syncthreads();
    if (F.tid < 64) {
        const int e = F.tid, c = e < NE ? (int)F.CNT[e] : 0, tl = (c + 255) >> 8;
        int incl = tl;
#pragma unroll
        for (int d = 1; d < NE; d <<= 1) { const int o = __shfl_up(incl, d); if (e >= d) incl += o; }
        if (e < NE) { F.MISC[128 + e] = (unsigned)c; F.MISC[16 + e] = (unsigned)(incl - tl); F.MISC[64 + e] = (unsigned)(incl - tl); }
        if (e == NE - 1) { F.MISC[16 + NE] = (unsigned)incl; F.MISC[64 + NE] = (unsigned)incl; }
    }
    __syncthreads();
}
__device__ __forceinline__ void ph11(Frame& F) {
    LAS float* GT = (LAS float*)F.lds; LAS float* GF = GT + 2 * D;
    for (int cc = F.tid; cc < D; cc += 512) { GT[cc] = F.MOD[10240 + cc]; GT[D + cc] = F.MOD[12288 + 10240 + cc]; GF[cc] = F.g_final[cc]; }
    __syncthreads();
    const int gw = F.bid * 8 + F.wave, NGW = F.nb * 8;
    u32x4 ern = gw < T ? *(const u32x4*)(F.ER + (size_t)gw * 4) : (u32x4){0u, 0u, 0u, 0u};
    for (int t = gw; t < T; t += NGW) {
        const int b = t >> 13; size_t pos[4]; const u32x4 erc = ern;
        { const int tn = t + NGW; ern = *(const u32x4*)(F.ER + (size_t)(tn < T ? tn : t) * 4); }
#pragma unroll
        for (int k = 0; k < 4; ++k) { const unsigned er = erc[k]; pos[k] = ((size_t)F.MISC[64 + (er & 255u)] << 8) + (er >> 8); }
        float x2[4][8]; float ssq = 0.f;
#pragma unroll
        for (int j = 0; j < 4; ++j) { const int col = 8 * (F.lane + 64 * j);
            const u32x4 mw = __builtin_nontemporal_load((const u32x4*)(F.Y + (size_t)t * D + col));
            const f32x4 xa = {bf_lo(mw.x), bf_hi(mw.x), bf_lo(mw.y), bf_hi(mw.y)}, xb = {bf_lo(mw.z), bf_hi(mw.z), bf_lo(mw.w), bf_hi(mw.w)};
            float s8[8] = {0.f, 0.f, 0.f, 0.f, 0.f, 0.f, 0.f, 0.f};
#pragma unroll
            for (int k = 0; k < 4; ++k) { const u32x2 ov = __builtin_nontemporal_load((const u32x2*)((const unsigned char*)F.O + pos[k] * D + col));
                const f32x2 q0 = __builtin_amdgcn_cvt_pk_f32_fp8((int)ov.x, false), q1 = __builtin_amdgcn_cvt_pk_f32_fp8((int)ov.x, true), q2 = __builtin_amdgcn_cvt_pk_f32_fp8((int)ov.y, false), q3 = __builtin_amdgcn_cvt_pk_f32_fp8((int)ov.y, true);
                s8[0] += q0.x; s8[1] += q0.y; s8[2] += q1.x; s8[3] += q1.y; s8[4] += q2.x; s8[5] += q2.y; s8[6] += q3.x; s8[7] += q3.y; }
#pragma unroll
            for (int i = 0; i < 8; ++i) s8[i] *= O8_INV;
            const f32x4 ga = *(const LAS f32x4*)(GT + b * D + col), gb = *(const LAS f32x4*)(GT + b * D + col + 4);
            x2[j][0] = xa.x + ga.x * s8[0]; x2[j][1] = xa.y + ga.y * s8[1]; x2[j][2] = xa.z + ga.z * s8[2]; x2[j][3] = xa.w + ga.w * s8[3];
            x2[j][4] = xb.x + gb.x * s8[4]; x2[j][5] = xb.y + gb.y * s8[5]; x2[j][6] = xb.z + gb.z * s8[6]; x2[j][7] = xb.w + gb.w * s8[7];
#pragma unroll
            for (int i = 0; i < 8; ++i) ssq += x2[j][i] * x2[j][i]; }
        const float rstd = 1.0f / sqrtf(wave_sum(ssq) * (1.0f / D) + EPS);
#pragma unroll
        for (int j = 0; j < 4; ++j) { const int col = 8 * (F.lane + 64 * j); const f32x4 fa = *(const LAS f32x4*)(GF + col), fb = *(const LAS f32x4*)(GF + col + 4);
            __builtin_nontemporal_store((f32x4){x2[j][0] * rstd * fa.x, x2[j][1] * rstd * fa.y, x2[j][2] * rstd * fa.z, x2[j][3] * rstd * fa.w}, (f32x4*)(F.out + (size_t)t * D + col));
            __builtin_nontemporal_store((f32x4){x2[j][4] * rstd * fb.x, x2[j][5] * rstd * fb.y, x2[j][6] * rstd * fb.z, x2[j][7] * rstd * fb.w}, (f32x4*)(F.out + (size_t)t * D + col + 4)); }
    }
}

struct Args { const float* in[29]; float* out; unsigned char* ws; int ph_lo, ph_hi, li, pad; };
__global__ void __launch_bounds__(512, 2) fwd_kernel(Args args) {
    extern __shared__ __attribute__((aligned(16))) unsigned char lds[];
    Frame F;
    F.lds = (LAS unsigned char*)lds; F.MISC = (volatile LAS unsigned*)(F.lds + MISC_OFF);
    F.tid = threadIdx.x; F.lane = F.tid & 63; F.wave = __builtin_amdgcn_readfirstlane(F.tid >> 6); F.G = gridDim.x;
    unsigned char* ws = args.ws;
    F.ctl = (unsigned*)(ws + WS_CTL);
    F.x = args.in[0]; F.c = args.in[1]; F.ctx = args.in[2]; F.c_ctx = args.in[3]; F.w_mod = args.in[4]; F.b_mod = args.in[5]; F.g_mix = args.in[6]; F.w_in = args.in[7];
    F.conv_a_w = args.in[8]; F.conv_a_b = args.in[9]; F.lru_w_r = args.in[10]; F.lru_b_r = args.in[11]; F.lru_w_i = args.in[12]; F.lru_b_i = args.in[13]; F.lru_lam = args.in[14];
    F.conv_b_w = args.in[15]; F.g_out_a = args.in[16]; F.g_out_b = args.in[17]; F.w_out = args.in[18]; F.g_ffn = args.in[19]; F.w_router = args.in[20]; F.b_router = args.in[21];
    F.w_gate = args.in[22]; F.b_gate = args.in[23]; F.w_up = args.in[24]; F.b_up = args.in[25]; F.w_down = args.in[26]; F.b_down = args.in[27]; F.g_final = args.in[28];
    F.out = args.out;
    F.MOD = (float*)(ws + WS_MOD); F.WG = (bf16_t*)(ws + WS_WG); F.WIN = (bf16_t*)(ws + WS_WIN); F.WOUT = (bf16_t*)(ws + WS_WOUT); F.XN = (bf16_t*)(ws + WS_XN); F.Gb = (bf16_t*)(ws + WS_G);
    F.XA = (bf16_t*)(ws + WS_XA); F.BB = (bf16_t*)(ws + WS_BB); F.P = (bf16_t*)(ws + WS_P); F.Y = (bf16_t*)(ws + WS_Y); F.WGU = (bf16_t*)(ws + WS_WGU); F.WDN = (bf16_t*)(ws + WS_WDN);
    F.H = (bf16_t*)(ws + WS_H); F.O = (bf16_t*)(ws + WS_O); F.AGG = (f32x2*)(ws + WS_AGG); F.HIN = (float*)(ws + WS_HIN); F.ER = (unsigned*)(ws + WS_ER); F.STOK = (int*)(ws + WS_STOK);
    F.SLW = (float*)(ws + WS_SLW); F.CNT = F.ctl + CW_CNT; F.HS = (bf16_t*)(ws + WS_HS); F.XN2 = ws + WS_XN2;
    for (int u = F.tid; u < (LDS_BYTES - MISC_OFF) / 4; u += 512) F.MISC[u] = 0u;
    __syncthreads();
    const bool split = (F.G % 64) == 0 && NC8 > 0;
    const int row8 = (int)blockIdx.x >> 3;
    const bool conv_role = split && ((row8 & 7) < NC8);
    const int Gm = split ? (F.G / 8) * (8 - NC8) : F.G, Gc = split ? (F.G / 8) * NC8 : F.G;
    const int cm = split ? ((int)blockIdx.x & 7) + 8 * ((row8 >> 3) * (8 - NC8) + ((row8 & 7) - NC8)) : (int)blockIdx.x;
    const int cc = split ? ((int)blockIdx.x & 7) + 8 * ((row8 >> 3) * NC8 + (row8 & 7)) : (int)blockIdx.x;
    XcdBarrier bar = xcd_barrier_post(F.ctl + CW_BAR, F.MISC + 8, (unsigned)F.G, true);
    XcdBarrier barM = xcd_barrier_post(F.ctl + CW_BARM, F.MISC + 10, (unsigned)Gm, !conv_role);
#ifndef PH_MASK
#define PH_MASK 0xFFF
#endif
#define IN(k) ((PH_MASK >> (k)) & 1)
#define REP(k) ((REPEAT_MASK >> (k)) & 1)
#define NREP(k) (1 + (REP(k) ? args.pad : 0))

    if (conv_role) {
        F.bid = cc; F.nb = Gc;
        if (IN(8)) { ph_expert_conv6(F); ph_expert_conv(F); }
    } else {
        F.bid = cm; F.nb = Gm;
        if (IN(0)) ph0(F);
        xcd_barrier(barM);
        if (IN(1)) ph1(F);
        xcd_barrier(barM);
        if (IN(2)) {
            DenseOrder S; S.nM = 64; S.nN = 20; S.nwg = 1280; S.G = Gm; S.c = cm; S.nX = 0; S.A = (const char*)F.XN; S.Bt = (const char*)F.WIN; S.tstep = (size_t)256 * D * 2;
            EpiInProj E{args.ws, F.P};
            pg8::gemm_phase<EpiInProj, DenseOrder, false, true, true, false>(F.lds, D, S, E);
        }
        if (IN(8)) { ph_expert_conv6(F); ph_expert_conv(F); }
    }
    F.bid = blockIdx.x; F.nb = F.G;
    xcd_barrier(bar);
    if (IN(3)) { gates_phase<false>(F, NREP(3)); } xcd_barrier(bar);
    if (IN(4)) { for (int r = 0; r < NREP(4); ++r) { if (r) xcd_barrier(bar); ph4(F); } } xcd_barrier(bar);
    if (IN(5)) { gates_phase<true>(F, NREP(5)); } xcd_barrier(bar);
    if (IN(5)) { for (int r = 0; r < NREP(7); ++r) { if (r) xcd_barrier(bar); ph5b(F); } } xcd_barrier(bar);
    if (IN(6)) {
        DenseOrder S; S.nM = 64; S.nN = 8; S.nwg = 512; S.G = F.G; S.c = blockIdx.x; S.nX = 0; S.A = (const char*)F.Y; S.Bt = (const char*)F.WOUT; S.tstep = (size_t)256 * D * 2;
        EpiOutProj E{F.XN, F.MOD};
        for (int r = 0; r < NREP(6); ++r) { if (r) xcd_barrier(bar); pg8::gemm_phase<EpiOutProj, DenseOrder, false, true, true, false>(F.lds, D, S, E); }
    } xcd_barrier(bar);
    if (IN(7)) { ph7(F); } xcd_barrier(bar);
    if (IN(9)) {
        moe_tables(F);
        MoeOrder S; S.tab = (const LAS int*)F.MISC; S.NT = 16; S.G = F.G; S.c = blockIdx.x; S.nwg = __builtin_amdgcn_readfirstlane((int)F.MISC[16 + NE]) * 16; S.A = (const char*)F.XN2; S.Bt = (const char*)F.WGU; S.STOK = F.STOK;
        S.bstep_e = (size_t)4096 * D; S.tstep = (size_t)256 * D; S.gather = true;
        EpiGU E{F.H, F.b_gate, F.b_up};
        for (int r = 0; r < NREP(9); ++r) { if (r) xcd_barrier(bar); pg8::gemm_phase<EpiGU, MoeOrder, true, true, true, true, true>(F.lds, D / 2, S, E); }
    } xcd_barrier(bar);
    if (IN(10)) {
        MoeOrder S; S.tab = (const LAS int*)F.MISC; S.NT = 8; S.G = F.G; S.c = blockIdx.x; S.nwg = __builtin_amdgcn_readfirstlane((int)F.MISC[16 + NE]) * 8; S.A = (const char*)F.H; S.Bt = (const char*)F.WDN; S.STOK = F.STOK;
        S.bstep_e = (size_t)D * FF; S.tstep = (size_t)256 * FF; S.gather = false;
        EpiDown E{F.O, F.b_down, F.SLW, (const LAS int*)F.MISC + 128};
        for (int r = 0; r < NREP(10); ++r) { if (r) xcd_barrier(bar); pg8::gemm_phase<EpiDown, MoeOrder, false, true, true, true>(F.lds, FF / 2, S, E); }
    } xcd_barrier(bar);
    if (IN(11)) { ph11(F); }
#undef IN
#undef REP
}

extern "C" void kernel_launch(void* const* d_in, const int* in_sizes, int n_in, void* d_out, int out_size, void* d_ws, size_t ws_size, hipStream_t stream) {
    static int grid = 0;
    if (grid == 0) {
        if (n_in != 29 || in_sizes[0] != T * D || out_size != T * D || ws_size < WS_END) { fprintf(stderr, "kernel_launch: unexpected shapes (n_in %d, in0 %d, out %d, ws %zu); nothing launched\n", n_in, n_in > 0 ? in_sizes[0] : -1, out_size, ws_size); grid = -1; return; }
        int dev = 0, cus = 0, per_cu = 0;
        if (hipGetDevice(&dev) != hipSuccess || hipDeviceGetAttribute(&cus, hipDeviceAttributeMultiprocessorCount, dev) != hipSuccess) { grid = -1; return; }
        if (hipFuncSetAttribute((const void*)fwd_kernel, hipFuncAttributeMaxDynamicSharedMemorySize, LDS_BYTES) != hipSuccess) { fprintf(stderr, "kernel_launch: hipFuncSetAttribute failed\n"); grid = -1; return; }
        if (hipOccupancyMaxActiveBlocksPerMultiprocessor(&per_cu, (const void*)fwd_kernel, 512, LDS_BYTES) != hipSuccess || per_cu < 1) fprintf(stderr, "kernel_launch: occupancy query reports %d\n", per_cu);
        (void)hipGetLastError();
        grid = cus;
    }
    if (grid < 0) return;
    (void)hipMemsetAsync((char*)d_ws + WS_CTL, 0, CTL_ZERO_BYTES, stream);
    Args a{};
    for (int i = 0; i < 29; ++i) a.in[i] = (const float*)d_in[i];
    a.out = (float*)d_out; a.ws = (unsigned char*)d_ws;
    a.ph_lo = 0; a.ph_hi = NPH; a.li = 0; a.pad = REPEAT_MASK ? 1 : 0; hipLaunchKernelGGL(fwd_kernel, dim3(grid), dim3(512), LDS_BYTES, stream, a);
}
```

```cpp
#include <hip/hip_runtime.h>
#include <cstdio>
#include <cstdint>
#include <type_traits>

#ifndef MK_N_LAUNCHES
#define MK_N_LAUNCHES 1
#endif

#define GAS __attribute__((address_space(1)))
#define LAS __attribute__((address_space(3)))
typedef unsigned short bf16_t;
typedef short bf16x8 __attribute__((ext_vector_type(8)));
typedef float f32x4 __attribute__((ext_vector_type(4)));
typedef float f32x2 __attribute__((ext_vector_type(2)));
typedef unsigned u32x4 __attribute__((ext_vector_type(4)));
typedef unsigned u32x2 __attribute__((ext_vector_type(2)));

constexpr int T = 16384, SEQ = 8192, D = 2048, DA = 1024, NIN = 5120, CTXL = 256, NCTX = 512, MROWS = T + NCTX;
constexpr int NE = 32, FF = 2048, CAP = 16384, HROWS = 73728;
constexpr int NCHUNK = 132;
constexpr float EPS = 1e-6f;
constexpr int NPH = 12;
constexpr int N_LAUNCHES = MK_N_LAUNCHES;
#ifndef REPEAT_MASK
#define REPEAT_MASK 0
#endif
#ifndef MK_NC8
#define MK_NC8 3
#endif
constexpr int NC8 = MK_NC8;

constexpr size_t MiB = 1u << 20;
constexpr size_t WS_CTL = 0, CTL_ZERO_BYTES = 1 * MiB;
constexpr size_t WS_MOD = 1 * MiB;
constexpr size_t WS_WG = 2 * MiB;
constexpr size_t WS_WIN = 4 * MiB;
constexpr size_t WS_WOUT = 24 * MiB;
constexpr size_t WS_AGG = 32 * MiB;
constexpr size_t WS_HIN = 38 * MiB;
constexpr size_t WS_ER = 40 * MiB;
constexpr size_t WS_STOK = 41 * MiB;
constexpr size_t WS_SLW = 43 * MiB;
constexpr size_t WS_XN = 48 * MiB;
constexpr size_t WS_G = 116 * MiB;
constexpr size_t WS_XA = 148 * MiB;
constexpr size_t WS_BB = 182 * MiB;
constexpr size_t WS_P = 214 * MiB;
constexpr size_t WS_Y = 246 * MiB;
constexpr size_t WS_WGU = 320 * MiB;
constexpr size_t WS_WDN = 832 * MiB;
constexpr size_t WS_H = 1088 * MiB;
constexpr size_t WS_O = 1376 * MiB;
constexpr size_t WS_HS = 1664 * MiB;
constexpr size_t WS_XN2 = 1696 * MiB;
constexpr size_t WS_END = 1728 * MiB;
constexpr int CW_CNT = 64;
constexpr int CW_BAR = 4096;
constexpr int CW_BARM = 8192;
constexpr int CW_Q0 = 96;
constexpr int CW_QCV6 = 224;
constexpr int CW_QCV = 160;

constexpr int LDS_BYTES = 155648;
constexpr int MISC_OFF = 154624;

__device__ __forceinline__ unsigned cvt_pk_bf16(float lo, float hi) { unsigned r; asm volatile("v_cvt_pk_bf16_f32 %0, %1, %2" : "=v"(r) : "v"(lo), "v"(hi)); return r; }
constexpr float X6_SCALE = 1.5f, GU_INV = 1.0f / 96.0f;
constexpr float W8_SCALE = 64.0f, W8_INV = 1.0f / 64.0f, O8_SCALE = 16.0f, O8_INV = 1.0f / 16.0f;
__device__ __forceinline__ unsigned pk4_fp8(float a, float b, float c, float d) { int w = 0; w = __builtin_amdgcn_cvt_pk_fp8_f32(a, b, w, false); w = __builtin_amdgcn_cvt_pk_fp8_f32(c, d, w, true); return (unsigned)w; }
__device__ __forceinline__ float bf_lo(unsigned w) { return __uint_as_float(w << 16); }
__device__ __forceinline__ float bf_hi(unsigned w) { return __uint_as_float(w & 0xffff0000u); }
__device__ __forceinline__ float fexp(float x) { return __builtin_amdgcn_exp2f(x * 1.44269504089f); }
__device__ __forceinline__ float fsigmoid(float x) { return __builtin_amdgcn_rcpf(1.0f + fexp(-x)); }
__device__ __forceinline__ float gelu_tanh(float x) { const float u = 0.7978845608028654f * (x + 0.044715f * x * x * x); return x * __builtin_amdgcn_rcpf(1.0f + fexp(-2.0f * u)); }
__device__ __forceinline__ float one_minus_exp(float u) { const float ser = -u * (1.0f + 0.5f * u * (1.0f + (1.0f / 3.0f) * u * (1.0f + 0.25f * u))); const float dir = 1.0f - fexp(u); return u > -0.05f ? ser : dir; }
__device__ __forceinline__ void gate_pair(float xr, float xi, float cf, float xc, float& a_out, float& b_out) {
    const float er = 1.0f + fexp(-fmaxf(xr, -30.0f)), ei = 1.0f + fexp(-fmaxf(xi, -30.0f)), inv = __builtin_amdgcn_rcpf(er * ei);
    const float r = inv * ei, ig = inv * er, la = cf * r, a = fexp(la), u = 2.0f * la;
    const float ser = -u * (1.0f + 0.5f * u * (1.0f + (1.0f / 3.0f) * u * (1.0f + 0.25f * u))), dir = 1.0f - a * a;
    a_out = a; b_out = __builtin_amdgcn_sqrtf(u > -0.05f ? ser : dir) * ig * xc;
}
__device__ __forceinline__ float wave_sum(float v) {
#pragma unroll
    for (int o = 1; o < 64; o <<= 1) v += __shfl_xor(v, o);
    return v;
}
__device__ __forceinline__ void unpack8(const u32x4 w, float (&f)[8]) { f[0] = bf_lo(w.x); f[1] = bf_hi(w.x); f[2] = bf_lo(w.y); f[3] = bf_hi(w.y); f[4] = bf_lo(w.z); f[5] = bf_hi(w.z); f[6] = bf_lo(w.w); f[7] = bf_hi(w.w); }

namespace pg8 {
#define PG8_LAS __attribute__((address_space(3)))
constexpr int BM = 256, BK = 64, HALF = 128, HTB = HALF * BK * 2, STAGE_BYTES = 8 * HTB, NXCD = 8, WGM = 8;
__host__ __device__ __forceinline__ int lds_byte(int r, int c) { const int cb = c * 2; return r * 128 + ((((cb >> 4) ^ (r & 7)) & 7) << 4) + (cb & 15); }
__host__ __device__ __forceinline__ void stage_rc(int b, int& R, int& C) { R = b >> 7; C = (((((b >> 4) & 7) ^ (R & 7)) << 4) + (b & 15)) / 2; }
__host__ __device__ __forceinline__ int perm32(int rho) { const int n = rho >> 4, i = rho & 15; return 8 * (i >> 2) + 4 * n + (i & 3); }

struct Unit { int pm, pn, e, mt; };

__device__ __forceinline__ int xcd_remap(int L, int nwg) { const int q = nwg / NXCD, r = nwg % NXCD, xcd = L % NXCD, off = L / NXCD; return (xcd < r ? xcd * (q + 1) : r * (q + 1) + (xcd - r) * q) + off; }

typedef int i32x4 __attribute__((ext_vector_type(4)));
typedef int i32x8 __attribute__((ext_vector_type(8)));
__device__ __forceinline__ i32x8 cat8(const bf16x8 a, const bf16x8 b) { return __builtin_shufflevector(__builtin_bit_cast(i32x4, a), __builtin_bit_cast(i32x4, b), 0, 1, 2, 3, 4, 5, 6, 7); }
__device__ __forceinline__ void mfma_fp8(f32x4& acc, const i32x8 a, const i32x8 b, const int sc) {
    (void)sc; asm volatile("v_mfma_f32_16x16x128_f8f6f4 %0, %1, %2, %0" : "+v"(acc) : "v"(a), "v"(b)); }
typedef int i32x6 __attribute__((ext_vector_type(6)));
typedef int i32x2 __attribute__((ext_vector_type(2)));
__device__ __forceinline__ void mfma_fp6(f32x4& acc, const i32x6 a, const i32x6 b) { asm volatile("v_mfma_f32_16x16x128_f8f6f4 %0, %1, %2, %0 cbsz:2 blgp:2" : "+v"(acc) : "v"(a), "v"(b)); }
__device__ __forceinline__ i32x6 cat6(const bf16x8 a, const i32x2 b) { return __builtin_shufflevector(__builtin_bit_cast(i32x4, a), __builtin_shufflevector(b, b, 0, 1, -1, -1), 0, 1, 2, 3, 4, 5); }
template <int OFF> __device__ __forceinline__ i32x2 lds_rd64(const PG8_LAS unsigned char* p) { i32x2 r; asm volatile("ds_read_b64 %0, %1 offset:%2" : "=v"(r) : "v"(p), "n"(OFF)); return r; }
template <class Epi, class Sched, bool GATHER, bool ALIGN_EPI, bool SP2, bool FP8, bool FP6 = false>
__device__ __forceinline__ void gemm_phase(PG8_LAS unsigned char* lds, const int K, const Sched& S, const Epi& E) {
    int tid = threadIdx.x; asm volatile("" : "+v"(tid));
    const int wid = __builtin_amdgcn_readfirstlane(tid >> 6), lane = tid & 63, wr = wid >> 2, wc = wid & 3, fr = lane & 15, fq = lane >> 4;
    const int nt = K / BK;
    int Rr[2], Cc[2]; unsigned voffB[2]; unsigned vAc[2][2], vAn[2][2];
#pragma unroll
    for (int i = 0; i < 2; ++i) { stage_rc(tid * 16 + i * 8192, Rr[i], Cc[i]); const int Rb = Epi::PERM ? ((Rr[i] & ~31) + perm32(Rr[i] & 31)) : Rr[i];
        voffB[i] = (unsigned)(Rb * K + Cc[i]) * 2u; }
    const size_t kstep = (size_t)(BK * 2);
    const size_t hstep = (size_t)HALF * K * 2;
    const unsigned ldsw = (unsigned)wid * 1024u;
    const int aoff = lds_byte(wr * 64 + fr, fq * 8), boff = lds_byte(wc * 32 + fr, fq * 8), aoff1 = lds_byte(wr * 64 + fr, 32 + fq * 8), boff1 = lds_byte(wc * 32 + fr, 32 + fq * 8);
    const int dup8 = 8 * ((fr >> 3) & 1);
#define PG8_SA(b, h) (((b) * 2 + (h)) * HTB)
#define PG8_SB(b, h) ((4 + (b) * 2 + (h)) * HTB)
#define PG8_STAGE(bufoff, gbase, voff) do { _Pragma("unroll") for (int _i = 0; _i < 2; ++_i) \
        __builtin_amdgcn_global_load_lds((const unsigned*)((const char*)(gbase) + (voff)[_i]), (PG8_LAS unsigned*)(lds + (bufoff) + ldsw + _i * 8192), 16, 0, 0); } while (0)
#define PG8_STAGE_A(bufoff, gbase, VO, h) do { if constexpr (GATHER) { PG8_STAGE(bufoff, gbase, (VO)[h]); } else { PG8_STAGE(bufoff, (gbase) + (h) * hstep, (VO)[0]); } } while (0)
#define PG8_LDA(dst, b, h) do { _Pragma("unroll") for (int m = 0; m < 4; ++m) dst[m] = *(const PG8_LAS bf16x8*)(lds + PG8_SA(b, h) + aoff + m * 2048); \
        if constexpr (FP6) { dst##2[0] = rd2<PG8_SA(b, h)>(lds + aoff1 + dup8); dst##2[1] = rd2<PG8_SA(b, h) + 2048>(lds + aoff1 + dup8); dst##2[2] = rd2<PG8_SA(b, h) + 4096>(lds + aoff1 + dup8); dst##2[3] = rd2<PG8_SA(b, h) + 6144>(lds + aoff1 + dup8); } \
        else { _Pragma("unroll") for (int m = 0; m < 4; ++m) dst##2[m] = rd2v(lds + PG8_SA(b, h) + aoff1 + m * 2048); } } while (0)
#define PG8_LDB(dst, b, h) do { _Pragma("unroll") for (int n = 0; n < 2; ++n) dst[n] = *(const PG8_LAS bf16x8*)(lds + PG8_SB(b, h) + boff + n * 2048); \
        if constexpr (FP6) { dst##2[0] = rd2<PG8_SB(b, h) - 65536>(lds + 65536 + boff1 + dup8); dst##2[1] = rd2<PG8_SB(b, h) - 65536 + 2048>(lds + 65536 + boff1 + dup8); } \
        else { _Pragma("unroll") for (int n = 0; n < 2; ++n) dst##2[n] = rd2v(lds + PG8_SB(b, h) + boff1 + n * 2048); } } while (0)
#define PG8_MMA(ai, bj, At, Bt) do { __builtin_amdgcn_s_setprio(1); _Pragma("unroll") for (int m = 0; m < 4; ++m) _Pragma("unroll") for (int n = 0; n < 2; ++n) { \
        if constexpr (FP6) mfma_fp6(acc[ai][bj][m][n], cat6(Bt[n], Bt##2[n]), cat6(At[m], At##2[m])); \
        else if constexpr (FP8) mfma_fp8(acc[ai][bj][m][n], cat8(Bt[n], Bt##2[n]), cat8(At[m], At##2[m]), sc1); \
        else { acc[ai][bj][m][n] = __builtin_amdgcn_mfma_f32_16x16x32_bf16(Bt[n], At[m], acc[ai][bj][m][n], 0, 0, 0); acc[ai][bj][m][n] = __builtin_amdgcn_mfma_f32_16x16x32_bf16(Bt##2[n], At##2[m], acc[ai][bj][m][n], 0, 0, 0); } } __builtin_amdgcn_s_setprio(0); } while (0)
#define PG8_WAIT_V(n) asm volatile("s_waitcnt vmcnt(" #n ")" ::: "memory")
#define PG8_WAIT_L(n) asm volatile("s_waitcnt lgkmcnt(" #n ")" ::: "memory")
#define PG8_BAR __builtin_amdgcn_s_barrier()
#define PG8_SCHED __builtin_amdgcn_sched_barrier(0)
    int sc1 = 0x7F7F7F7F; asm volatile("" : "+v"(sc1));
    Unit cur, nxt; int ui = 0;
    if (!S.next(0, cur)) return;
    f32x4 acc[2][2][4][2];
#pragma unroll
    for (int a = 0; a < 2; ++a)
#pragma unroll
        for (int b = 0; b < 2; ++b)
#pragma unroll
            for (int m = 0; m < 4; ++m)
#pragma unroll
                for (int n = 0; n < 2; ++n) acc[a][b][m][n] = (f32x4){0.f, 0.f, 0.f, 0.f};
    using S2 = typename std::conditional<FP6, i32x2, bf16x8>::type;
    auto rd2v = [](const PG8_LAS unsigned char* p) -> S2 { return *(const PG8_LAS S2*)p; };
#define rd2 lds_rd64
    bf16x8 At[4], B0[2], B1[2]; S2 At2[4], B02[2], B12[2];
    const char* cA = S.a_base(cur); const char* cB = S.b_base(cur);
#pragma unroll
    for (int h = 0; h < 2; ++h)
#pragma unroll
        for (int i = 0; i < 2; ++i) { if constexpr (GATHER) vAc[h][i] = S.gather_off(cur, Rr[i] + HALF * h) + (unsigned)Cc[i] * 2u; else vAc[h][i] = (unsigned)(Rr[i] * K + Cc[i]) * 2u; vAn[h][i] = vAc[h][i]; }
    if constexpr (SP2) {
        PG8_STAGE(PG8_SB(0, 0), cB, voffB); PG8_STAGE(PG8_SB(0, 1), cB + hstep, voffB); PG8_STAGE_A(PG8_SA(0, 0), cA, vAc, 0); PG8_STAGE_A(PG8_SA(0, 1), cA, vAc, 1);
        if (wr == 1) PG8_BAR;
        PG8_WAIT_V(2); PG8_BAR;
        PG8_STAGE(PG8_SB(1, 0), cB + kstep, voffB); PG8_STAGE_A(PG8_SA(1, 0), cA + kstep, vAc, 0); PG8_STAGE(PG8_SB(1, 1), cB + hstep + kstep, voffB);
        PG8_WAIT_V(6); PG8_BAR;
    } else {
        PG8_STAGE(PG8_SB(0, 0), cB, voffB); PG8_STAGE_A(PG8_SA(0, 0), cA, vAc, 0); PG8_STAGE(PG8_SB(0, 1), cB + hstep, voffB); PG8_STAGE_A(PG8_SA(0, 1), cA, vAc, 1);
        if (wr == 1) PG8_BAR;
        PG8_WAIT_V(4); PG8_BAR;
        PG8_STAGE(PG8_SB(1, 0), cB + kstep, voffB); PG8_STAGE_A(PG8_SA(1, 0), cA + kstep, vAc, 0); PG8_STAGE(PG8_SB(1, 1), cB + hstep + kstep, voffB);
        PG8_WAIT_V(6); PG8_BAR;
    }
    for (;;) {
        const bool has_next = S.next(ui + 1, nxt);
        const char* nA = has_next ? S.a_base(nxt) : cA; const char* nB = has_next ? S.b_base(nxt) : cB;
        if constexpr (Epi::TAB_N > 0) { if (wid < Epi::TAB_N / 64) __builtin_amdgcn_global_load_lds((const unsigned*)E.tab_src(cur, tid), (PG8_LAS unsigned*)(lds + STAGE_BYTES + 1024 + (ui & 1) * 2048 + wid * 256), 4, 0, 0); }
        if constexpr (GATHER) { if (has_next && wid < 4) __builtin_amdgcn_global_load_lds((const unsigned*)S.tok_src(nxt, tid), (PG8_LAS unsigned*)(lds + STAGE_BYTES + wid * 256), 4, 0, 0); }
        for (int t = 0; t < nt; t += 2) {
            const bool last = (t == nt - 2);
            const char* a1 = cA + (size_t)(t + 1) * kstep;
            const char* a2 = last ? nA : cA + (size_t)(t + 2) * kstep; const char* b2 = last ? nB : cB + (size_t)(t + 2) * kstep;
            const char* a3 = a2 + kstep; const char* b3 = b2 + kstep;
            if constexpr (GATHER) { if (last && has_next) {
#pragma unroll
                for (int h = 0; h < 2; ++h)
#pragma unroll
                    for (int i = 0; i < 2; ++i) vAn[h][i] = *(const PG8_LAS unsigned*)(lds + STAGE_BYTES + 4 * (Rr[i] + HALF * h)) * (unsigned)(K * 2) + (unsigned)Cc[i] * 2u; } }
            unsigned v2[2][2];
#pragma unroll
            for (int h = 0; h < 2; ++h)
#pragma unroll
                for (int i = 0; i < 2; ++i) v2[h][i] = GATHER ? (last ? vAn[h][i] : vAc[h][i]) : vAc[0][i];
            if constexpr (SP2) {
            PG8_LDB(B0, 0, 0); PG8_LDB(B1, 0, 1); PG8_SCHED; PG8_LDA(At, 0, 0); PG8_STAGE_A(PG8_SA(1, 1), a1, vAc, 1);
            PG8_WAIT_V(8); PG8_WAIT_L(0); PG8_BAR; PG8_MMA(0, 0, At, B0); PG8_MMA(0, 1, At, B1); PG8_BAR; PG8_SCHED;
            PG8_LDA(At, 0, 1); PG8_STAGE(PG8_SB(0, 0), b2, voffB); PG8_STAGE(PG8_SB(0, 1), b2 + hstep, voffB); PG8_STAGE_A(PG8_SA(0, 0), a2, v2, 0);
            PG8_WAIT_V(8); PG8_WAIT_L(0); PG8_BAR; PG8_MMA(1, 0, At, B0); PG8_MMA(1, 1, At, B1); PG8_BAR; PG8_SCHED;
            PG8_LDB(B0, 1, 0); PG8_LDB(B1, 1, 1); PG8_SCHED; PG8_LDA(At, 1, 0); PG8_STAGE_A(PG8_SA(0, 1), a2, v2, 1);
            PG8_WAIT_V(8); PG8_WAIT_L(0); PG8_BAR; PG8_MMA(0, 0, At, B0); PG8_MMA(0, 1, At, B1); PG8_BAR; PG8_SCHED;
            PG8_LDA(At, 1, 1); PG8_STAGE(PG8_SB(1, 0), b3, voffB); PG8_STAGE(PG8_SB(1, 1), b3 + hstep, voffB); PG8_STAGE_A(PG8_SA(1, 0), a3, v2, 0);
            PG8_WAIT_V(8); PG8_WAIT_L(0); PG8_BAR; PG8_MMA(1, 0, At, B0); PG8_MMA(1, 1, At, B1); PG8_BAR; PG8_SCHED;
            } else {
            PG8_LDB(B0, 0, 0); PG8_SCHED; PG8_LDA(At, 0, 0); PG8_STAGE_A(PG8_SA(1, 1), a1, vAc, 1);
            PG8_WAIT_L(8); PG8_BAR; PG8_WAIT_L(0); PG8_MMA(0, 0, At, B0); PG8_BAR; PG8_SCHED;
            PG8_LDB(B1, 0, 1); PG8_STAGE(PG8_SB(0, 0), b2, voffB);
            PG8_BAR; PG8_WAIT_L(0); PG8_MMA(0, 1, At, B1); PG8_BAR;
            PG8_LDA(At, 0, 1); PG8_STAGE_A(PG8_SA(0, 0), a2, v2, 0);
            PG8_BAR; PG8_WAIT_L(0); PG8_MMA(1, 0, At, B0); PG8_BAR; PG8_SCHED;
            PG8_STAGE(PG8_SB(0, 1), b2 + hstep, voffB);
            PG8_WAIT_V(6); PG8_BAR; PG8_MMA(1, 1, At, B1); PG8_BAR;
            PG8_LDB(B0, 1, 0); PG8_SCHED; PG8_LDA(At, 1, 0); PG8_STAGE_A(PG8_SA(0, 1), a2, v2, 1);
            PG8_WAIT_L(8); PG8_BAR; PG8_WAIT_L(0); PG8_MMA(0, 0, At, B0); PG8_BAR; PG8_SCHED;
            PG8_LDB(B1, 1, 1); PG8_STAGE(PG8_SB(1, 0), b3, voffB);
            PG8_BAR; PG8_WAIT_L(0); PG8_MMA(0, 1, At, B1); PG8_BAR;
            PG8_LDA(At, 1, 1); PG8_STAGE_A(PG8_SA(1, 0), a3, v2, 0);
            PG8_BAR; PG8_WAIT_L(0); PG8_MMA(1, 0, At, B0); PG8_BAR; PG8_SCHED;
            PG8_STAGE(PG8_SB(1, 1), b3 + hstep, voffB);
            PG8_WAIT_V(6); PG8_BAR; PG8_MMA(1, 1, At, B1); PG8_BAR;
            }
        }
        if constexpr (ALIGN_EPI) { if (wr == 0) PG8_BAR; }
        if constexpr (FP8) asm volatile("s_nop 15\n\ts_nop 15" ::: "memory");
        E(acc, cur, wr, wc, fr, fq, (const PG8_LAS float*)(lds + STAGE_BYTES + 1024 + (ui & 1) * 2048));
        if (!has_next) break;
#pragma unroll
        for (int a = 0; a < 2; ++a)
#pragma unroll
            for (int b = 0; b < 2; ++b)
#pragma unroll
                for (int m = 0; m < 4; ++m)
#pragma unroll
                    for (int n = 0; n < 2; ++n) acc[a][b][m][n] = (f32x4){0.f, 0.f, 0.f, 0.f};
        cur = nxt; cA = nA; cB = nB; ++ui;
#pragma unroll
        for (int h = 0; h < 2; ++h)
#pragma unroll
            for (int i = 0; i < 2; ++i) vAc[h][i] = vAn[h][i];
        if constexpr (ALIGN_EPI) { if (wr == 1) PG8_BAR; }
    }
    PG8_WAIT_V(0);
    if constexpr (!ALIGN_EPI) { if (wr == 0) PG8_BAR; }
    PG8_BAR;
#undef rd2
#undef PG8_SA
#undef PG8_SB
#undef PG8_STAGE
#undef PG8_STAGE_A
#undef PG8_LDA
#undef PG8_LDB
#undef PG8_MMA
#undef PG8_WAIT_V
#undef PG8_WAIT_L
#undef PG8_BAR
#undef PG8_SCHED
}
}

#define XB_TMO      128
#define XB_XCNT(j)  (256  + 64 * (j))
#define XB_XSUB(j)  (1280 + 64 * (j))
#define XB_XGEN(j)  (2304 + 64 * (j))
#define XB_TOP      3328
#define XB_TOPGEN   3392
#define XCD_BAR_WORDS 3456
#define XB_SPIN_CAP (1u << 18)
__device__ __forceinline__ unsigned xb_ld(unsigned* p)              { return __hip_atomic_load(p, __ATOMIC_RELAXED, __HIP_MEMORY_SCOPE_AGENT); }
__device__ __forceinline__ unsigned xb_add(unsigned* p, unsigned v) { return __hip_atomic_fetch_add(p, v, __ATOMIC_RELAXED, __HIP_MEMORY_SCOPE_AGENT); }
__device__ __forceinline__ unsigned xb_xcc_id() { return (unsigned)__builtin_amdgcn_s_getreg((3 << 11) | 20) & 0xFu; }
#define XB_SPIN(cond, bar) do { unsigned _sp = 0; while (cond) { __builtin_amdgcn_s_sleep(1); \
    if ((++_sp & 255u) == 0u) { if (xb_ld(&(bar)[XB_TMO])) break; if (_sp > XB_SPIN_CAP) { atomicAdd(&(bar)[XB_TMO], 1u); break; } } } } while (0)
struct XcdBarrier { unsigned* bar; unsigned x; volatile LAS unsigned* st; unsigned expect; };
__device__ __forceinline__ XcdBarrier xcd_barrier_post(unsigned* bar, volatile LAS unsigned* st, unsigned expect, bool member) {
    XcdBarrier b; b.bar = bar; b.x = xb_xcc_id(); b.st = st; b.expect = expect;
    if (member && threadIdx.x == 0) (void)xb_add(&bar[XB_XCNT(b.x)], 1u);
    return b;
}
__device__ __forceinline__ void xcd_barrier_complete(unsigned* bar, unsigned x, unsigned G, unsigned& nloc, unsigned& nx) {
    unsigned sum, cnt, mine, sp = 0u;
    for (;;) {
        sum = 0u; cnt = 0u; mine = 0u;
#pragma unroll
        for (unsigned j = 0; j < 16; ++j) { const unsigned c = xb_ld(&bar[XB_XCNT(j)]); sum += c; cnt += (c > 0u) ? 1u : 0u; mine = (j == x) ? c : mine; }
        if (sum == G) break;
        __builtin_amdgcn_s_sleep(1);
        if ((++sp & 255u) == 0u) { if (xb_ld(&bar[XB_TMO])) break; if (sp > XB_SPIN_CAP) { atomicAdd(&bar[XB_TMO], 1u); break; } }
    }
    nloc = mine > 0u ? mine : 1u; nx = cnt > 0u ? cnt : 1u;
}
__device__ __forceinline__ void xcd_barrier(const XcdBarrier& b) {
    asm volatile("s_waitcnt vmcnt(0)" ::: "memory");
    __syncthreads();
    if (threadIdx.x == 0) {
        unsigned* bar = b.bar;
        __builtin_amdgcn_s_waitcnt(0);
        unsigned nloc = b.st[0], nx = b.st[1];
        if (nloc == 0u) { xcd_barrier_complete(bar, b.x, b.expect, nloc, nx); b.st[0] = nloc; b.st[1] = nx; }
        const unsigned old = xb_add(&bar[XB_XSUB(b.x)], 1u);
        const unsigned gen = old / nloc;
        if (old + 1u == (gen + 1u) * nloc) {
            __builtin_amdgcn_fence(__ATOMIC_RELEASE, "agent");
            asm volatile("s_waitcnt vmcnt(0)" ::: "memory");
            const unsigned og = xb_add(&bar[XB_TOP], 1u);
            const unsigned tg = og / nx;
            if (og + 1u == (tg + 1u) * nx) xb_add(&bar[XB_TOPGEN], 1u);
            else XB_SPIN(xb_ld(&bar[XB_TOPGEN]) == tg, bar);
            __builtin_amdgcn_fence(__ATOMIC_ACQUIRE, "agent");
            xb_add(&bar[XB_XGEN(b.x)], 1u);
            asm volatile("s_waitcnt vmcnt(0)" ::: "memory");
        } else {
            XB_SPIN(xb_ld(&bar[XB_XGEN(b.x)]) == gen, bar);
            __builtin_amdgcn_fence(__ATOMIC_ACQUIRE, "agent");
            asm volatile("s_waitcnt vmcnt(0)" ::: "memory");
        }
    }
    __syncthreads();
}

struct Frame {
    LAS unsigned char* lds;
    volatile LAS unsigned* MISC;
    unsigned* ctl;
    int tid, lane, wave, G;
    int bid, nb;
    const float *x, *c, *ctx, *c_ctx, *w_mod, *b_mod, *g_mix, *w_in, *conv_a_w, *conv_a_b, *lru_w_r, *lru_b_r, *lru_w_i, *lru_b_i, *lru_lam, *conv_b_w, *g_out_a, *g_out_b, *w_out,
        *g_ffn, *w_router, *b_router, *w_gate, *b_gate, *w_up, *b_up, *w_down, *b_down, *g_final;
    float* out;
    float* MOD; bf16_t *WG, *WIN, *WOUT, *XN, *Gb, *XA, *BB, *P, *Y, *WGU, *WDN, *H, *O, *HS;
    f32x2* AGG; float* HIN; unsigned* ER; int* STOK; float* SLW; unsigned* CNT; unsigned char* XN2;
};

struct EpiInProj {
    static constexpr bool PERM = true; static constexpr int TAB_N = 0;
    __device__ __forceinline__ const float* tab_src(const pg8::Unit&, int) const { return nullptr; }
    unsigned char* ws; bf16_t* P;
    __device__ __forceinline__ void operator()(const f32x4 (&acc)[2][2][4][2], const pg8::Unit& u, int wr, int wc, int fr, int fq, const LAS float* tab) const {
        const int row0 = u.pm * 256 + wr * 64 + fr, cl = wc * 32 + 8 * fq, pn = u.pn;
        if (pn < 12) {
            const size_t woff = pn < 4 ? WS_G : (pn < 8 ? WS_XA : WS_BB); bf16_t* dst = (bf16_t*)(ws + woff); const int colt = (pn & 3) * 256;
#pragma unroll
            for (int ai = 0; ai < 2; ++ai)
#pragma unroll
                for (int m = 0; m < 4; ++m) { bf16_t* rowp = dst + (size_t)(row0 + ai * 128 + m * 16) * DA + colt + cl;
#pragma unroll
                    for (int bj = 0; bj < 2; ++bj) { f32x4 v0 = acc[ai][bj][m][0], v1 = acc[ai][bj][m][1];
                        if (pn < 4) {
#pragma unroll
                            for (int j = 0; j < 4; ++j) { v0[j] = gelu_tanh(v0[j]); v1[j] = gelu_tanh(v1[j]); } }
                        u32x4 w; w.x = cvt_pk_bf16(v0[0], v0[1]); w.y = cvt_pk_bf16(v0[2], v0[3]); w.z = cvt_pk_bf16(v1[0], v1[1]); w.w = cvt_pk_bf16(v1[2], v1[3]);
                        *(u32x4*)(rowp + bj * 128) = w; } }
        } else {
            const int j = pn - 12;
#pragma unroll
            for (int ai = 0; ai < 2; ++ai)
#pragma unroll
                for (int m = 0; m < 4; ++m) { bf16_t* rowp = P + (size_t)(row0 + ai * 128 + m * 16) * DA + j * 128 + cl;
                    const f32x4 v0 = acc[ai][0][m][0] * acc[ai][1][m][0], v1 = acc[ai][0][m][1] * acc[ai][1][m][1];
                    u32x4 w; w.x = cvt_pk_bf16(v0[0], v0[1]); w.y = cvt_pk_bf16(v0[2], v0[3]); w.z = cvt_pk_bf16(v1[0], v1[1]); w.w = cvt_pk_bf16(v1[2], v1[3]);
                    *(u32x4*)rowp = w; }
        }
    }
};
struct EpiOutProj {
    static constexpr bool PERM = true; static constexpr int TAB_N = 0;
    __device__ __forceinline__ const float* tab_src(const pg8::Unit&, int) const { return nullptr; }
    bf16_t* MX; const float* MOD;
    __device__ __forceinline__ void operator()(const f32x4 (&acc)[2][2][4][2], const pg8::Unit& u, int wr, int wc, int fr, int fq, const LAS float* tab) const {
        const int row0 = u.pm * 256 + wr * 64 + fr, col0 = u.pn * 256 + wc * 32 + 8 * fq, b = u.pm >> 5;
        f32x4 gt[2][2];
#pragma unroll
        for (int bj = 0; bj < 2; ++bj)
#pragma unroll
            for (int n = 0; n < 2; ++n) gt[bj][n] = *(const f32x4*)(MOD + b * 12288 + 4096 + col0 + bj * 128 + 4 * n);
#pragma unroll
        for (int ai = 0; ai < 2; ++ai)
#pragma unroll
            for (int m = 0; m < 4; ++m) { bf16_t* rowp = MX + (size_t)(row0 + ai * 128 + m * 16) * D + col0;
#pragma unroll
                for (int bj = 0; bj < 2; ++bj) { const f32x4 v0 = gt[bj][0] * acc[ai][bj][m][0], v1 = gt[bj][1] * acc[ai][bj][m][1];
                    u32x4 w; w.x = cvt_pk_bf16(v0[0], v0[1]); w.y = cvt_pk_bf16(v0[2], v0[3]); w.z = cvt_pk_bf16(v1[0], v1[1]); w.w = cvt_pk_bf16(v1[2], v1[3]);
                    *(u32x4*)(rowp + bj * 128) = w; } }
    }
};
struct EpiGU {
    static constexpr bool PERM = true; static constexpr int TAB_N = 256;
    bf16_t* H; const float *b_gate, *b_up;
    __device__ __forceinline__ const float* tab_src(const pg8::Unit& u, int t) const { return (t < 128 ? b_gate : b_up) + u.e * FF + u.pn * 128 + (t & 127); }
    __device__ __forceinline__ void operator()(const f32x4 (&acc)[2][2][4][2], const pg8::Unit& u, int wr, int wc, int fr, int fq, const LAS float* tab) const {
        const int row0 = u.pm * 256 + wr * 64 + fr, colg = u.pn * 128 + wc * 32 + 8 * fq;
        f32x4 bg[2], bu[2];
#pragma unroll
        for (int n = 0; n < 2; ++n) { bg[n] = *(const LAS f32x4*)(tab + wc * 32 + 8 * fq + 4 * n); bu[n] = *(const LAS f32x4*)(tab + 128 + wc * 32 + 8 * fq + 4 * n); }
#pragma unroll
        for (int ai = 0; ai < 2; ++ai)
#pragma unroll
            for (int m = 0; m < 4; ++m) { unsigned char* rowp = (unsigned char*)H + (size_t)(row0 + ai * 128 + m * 16) * FF + colg; f32x4 a[2];
#pragma unroll
                for (int n = 0; n < 2; ++n)
#pragma unroll
                    for (int j = 0; j < 4; j += 2) {
                        f32x2 g = (f32x2){acc[ai][0][m][n][j], acc[ai][0][m][n][j + 1]} * GU_INV + (f32x2){bg[n][j], bg[n][j + 1]};
                        f32x2 up = (f32x2){acc[ai][1][m][n][j], acc[ai][1][m][n][j + 1]} * GU_INV + (f32x2){bu[n][j], bu[n][j + 1]};
                        g.x = fminf(g.x, 7.0f); g.y = fminf(g.y, 7.0f); up.x = __builtin_amdgcn_fmed3f(up.x, -7.0f, 7.0f); up.y = __builtin_amdgcn_fmed3f(up.y, -7.0f, 7.0f);
                        const f32x2 t = g * (-1.702f * 1.44269504089f);
                        f32x2 d = (f32x2){__builtin_amdgcn_exp2f(t.x), __builtin_amdgcn_exp2f(t.y)} + 1.0f;
                        const f32x2 sg = {__builtin_amdgcn_rcpf(d.x), __builtin_amdgcn_rcpf(d.y)};
                        const f32x2 h = (up + 1.0f) * g * sg;
                        a[n][j] = h.x; a[n][j + 1] = h.y; }
                u32x2 w; w.x = pk4_fp8(a[0][0], a[0][1], a[0][2], a[0][3]); w.y = pk4_fp8(a[1][0], a[1][1], a[1][2], a[1][3]);
                *(u32x2*)rowp = w; }
    }
};
struct EpiDown {
    static constexpr bool PERM = true; static constexpr int TAB_N = 512;
    bf16_t* O; const float* b_down; const float* SLW; const LAS int* cnt;
    __device__ __forceinline__ const float* tab_src(const pg8::Unit& u, int t) const {
        if (t < 256) return b_down + u.e * D + u.pn * 256 + t;
        const int r = t - 256, nvalid = __builtin_amdgcn_readfirstlane(cnt[u.e]) - u.mt * 256; return SLW + (size_t)u.e * CAP + (r < nvalid ? u.mt * 256 + r : 0); }
    __device__ __forceinline__ void operator()(const f32x4 (&acc)[2][2][4][2], const pg8::Unit& u, int wr, int wc, int fr, int fq, const LAS float* tab) const {
        const int row0 = u.pm * 256 + wr * 64 + fr, cl = wc * 32 + 8 * fq, nvalid = __builtin_amdgcn_readfirstlane(cnt[u.e]) - u.mt * 256;
        f32x4 bd[2][2]; float wsl[2][4];
#pragma unroll
        for (int bj = 0; bj < 2; ++bj)
#pragma unroll
            for (int n = 0; n < 2; ++n) bd[bj][n] = *(const LAS f32x4*)(tab + bj * 128 + cl + 4 * n);
#pragma unroll
        for (int ai = 0; ai < 2; ++ai)
#pragma unroll
            for (int m = 0; m < 4; ++m) { const int r = ai * 128 + wr * 64 + m * 16 + fr; const float w = tab[256 + r]; wsl[ai][m] = r < nvalid ? w : 0.f; }
#pragma unroll
        for (int ai = 0; ai < 2; ++ai)
#pragma unroll
            for (int m = 0; m < 4; ++m) { const int r = ai * 128 + wr * 64 + m * 16 + fr; const float w8 = wsl[ai][m];
                unsigned char* rowp = (unsigned char*)O + (size_t)(row0 + ai * 128 + m * 16) * D + u.pn * 256 + cl;
#pragma unroll
                for (int bj = 0; bj < 2; ++bj) { const f32x4 v0 = (acc[ai][bj][m][0] * W8_INV + bd[bj][0]) * w8, v1 = (acc[ai][bj][m][1] * W8_INV + bd[bj][1]) * w8;
                    u32x2 w; w.x = pk4_fp8(v0[0] * O8_SCALE, v0[1] * O8_SCALE, v0[2] * O8_SCALE, v0[3] * O8_SCALE); w.y = pk4_fp8(v1[0] * O8_SCALE, v1[1] * O8_SCALE, v1[2] * O8_SCALE, v1[3] * O8_SCALE);
                    *(u32x2*)(rowp + bj * 128) = w; } }
    }
};

struct DenseOrder {
    int nM, nN, nwg, G, c, nX; const char *A, *Bt; size_t tstep;
    __device__ __forceinline__ bool next(int i, pg8::Unit& u) const {
        long L = (long)i * G + c; if (L >= nwg + nX) return false;
        u.e = 0; u.mt = 0;
        if (L < nX) { u.pm = 64 + (int)L / 4; u.pn = 4 + (int)L % 4; return true; }
        L -= nX;
        const int wgid = pg8::xcd_remap((int)L, nwg);
        const int nig = pg8::WGM * nN, gid = wgid / nig, fm = gid * pg8::WGM, gsz = (nM - fm) < pg8::WGM ? (nM - fm) : pg8::WGM;
        u.pm = fm + ((wgid % nig) % gsz); u.pn = (wgid % nig) / gsz; return true;
    }
    __device__ __forceinline__ const char* a_base(const pg8::Unit& u) const { return A + (size_t)u.pm * tstep; }
    __device__ __forceinline__ const char* b_base(const pg8::Unit& u) const { return Bt + (size_t)u.pn * tstep; }
    __device__ __forceinline__ unsigned gather_off(const pg8::Unit&, int) const { return 0u; }
    __device__ __forceinline__ const int* tok_src(const pg8::Unit&, int) const { return nullptr; }
};
struct MoeOrder {
    const LAS int* tab; int NT, G, c, nwg; const char *A, *Bt; const int* STOK; size_t bstep_e, tstep; bool gather;
    __device__ __forceinline__ bool next(int i, pg8::Unit& u) const {
        const int x = c & 7, npx = NT / 4, ng = NT / npx, mgn = 8 / ng, ngroup = x % ng, mgroup = x / ng, nbx = (G - x + 7) >> 3, q = i * nbx + (c >> 3);
        const int til = q / npx, ti = til * mgn + mgroup; if (ti >= nwg / NT) return false;
        u.pn = ngroup * npx + (q - til * npx);
        const int sl = (int)(threadIdx.x & 63), pv = tab[17 + (sl < NE - 1 ? sl : NE - 2)];
        const int e = (int)__popcll(__ballot(sl < NE - 1 && ti >= pv));
        u.e = e; u.mt = ti - __builtin_amdgcn_readfirstlane(tab[16 + e]); u.pm = __builtin_amdgcn_readfirstlane(tab[64 + e]) + u.mt; return true;
    }
    __device__ __forceinline__ const char* a_base(const pg8::Unit& u) const { return gather ? A : A + (size_t)u.pm * tstep; }
    __device__ __forceinline__ const char* b_base(const pg8::Unit& u) const { return Bt + (size_t)u.e * bstep_e + (size_t)u.pn * tstep; }
    __device__ __forceinline__ const int* tok_src(const pg8::Unit& u, int row) const { const int idx = u.mt * 256 + row; return STOK + (size_t)u.e * CAP + (idx < __builtin_amdgcn_readfirstlane(tab[128 + u.e]) ? idx : 0); }
    __device__ __forceinline__ unsigned gather_off(const pg8::Unit& u, int row) const { return (unsigned)(*tok_src(u, row)) * (unsigned)D; }
};

__device__ __forceinline__ void transpose_item(const float* W, int K, int N, int k0, int n0, bf16_t* WT, int orow0, LAS float* scr, int lane) {
#pragma unroll 8
    for (int i = 0; i < 32; ++i) { const int kk = 2 * i + (lane >> 5); scr[kk * 33 + (lane & 31)] = W[(size_t)(k0 + kk) * N + n0 + (lane & 31)]; }
    asm volatile("s_waitcnt lgkmcnt(0)" ::: "memory");
    const int c = lane & 7;
#pragma unroll
    for (int j = 0; j < 4; ++j) { const int n = (lane >> 3) + 8 * j; const LAS float* s = scr + (8 * c) * 33 + n;
        u32x4 o; o.x = cvt_pk_bf16(s[0 * 33], s[1 * 33]); o.y = cvt_pk_bf16(s[2 * 33], s[3 * 33]); o.z = cvt_pk_bf16(s[4 * 33], s[5 * 33]); o.w = cvt_pk_bf16(s[6 * 33], s[7 * 33]);
        *(u32x4*)(WT + (size_t)(orow0 + n) * K + k0 + 8 * c) = o; }
    asm volatile("s_waitcnt lgkmcnt(0)" ::: "memory");
}

__device__ __forceinline__ void transpose_item_fp8(const float* W, int K, int N, int k0, int n0, unsigned char* WT, int orow0, LAS float* scr, int lane) {
#pragma unroll 8
    for (int i = 0; i < 64; ++i) { const int kk = 2 * i + (lane >> 5); scr[kk * 33 + (lane & 31)] = W[(size_t)(k0 + kk) * N + n0 + (lane & 31)]; }
    asm volatile("s_waitcnt lgkmcnt(0)" ::: "memory");
    const int c = lane & 7;
#pragma unroll
    for (int j = 0; j < 4; ++j) { const int n = (lane >> 3) + 8 * j; const LAS float* s = scr + (16 * c) * 33 + n;
        u32x4 o; o.x = pk4_fp8(s[0 * 33] * W8_SCALE, s[1 * 33] * W8_SCALE, s[2 * 33] * W8_SCALE, s[3 * 33] * W8_SCALE); o.y = pk4_fp8(s[4 * 33] * W8_SCALE, s[5 * 33] * W8_SCALE, s[6 * 33] * W8_SCALE, s[7 * 33] * W8_SCALE);
        o.z = pk4_fp8(s[8 * 33] * W8_SCALE, s[9 * 33] * W8_SCALE, s[10 * 33] * W8_SCALE, s[11 * 33] * W8_SCALE); o.w = pk4_fp8(s[12 * 33] * W8_SCALE, s[13 * 33] * W8_SCALE, s[14 * 33] * W8_SCALE, s[15 * 33] * W8_SCALE);
        *(u32x4*)(WT + (size_t)(orow0 + n) * K + k0 + 16 * c) = o; }
    asm volatile("s_waitcnt lgkmcnt(0)" ::: "memory");
}

__device__ __forceinline__ void ph0(Frame& F) {
    LAS float* sc = (LAS float*)(F.lds + 67584);
    LAS float* red = (LAS float*)(F.lds + 67584 + 24576);
    LAS float* scr = (LAS float*)(F.lds + F.wave * 8448);
    constexpr int I_IN = (D / 64) * (NIN / 32), I_OUT = (D / 64) * (D / 32), I_G = 32 * 8, NJOB = 128 + (I_IN + I_OUT + I_G) / 32;
    bool have_sc = false;
    for (;;) {
        __syncthreads();
        if (F.tid == 0) F.MISC[12] = atomicAdd(F.ctl + CW_Q0, 1u);
        __syncthreads();
        const int job = __builtin_amdgcn_readfirstlane((int)F.MISC[12]);
        if (job >= NJOB) break;
        if (job < 128) {
            if (!have_sc) { for (int idx = F.tid; idx < 3 * D; idx += 512) { const int r = idx >> 11, k = idx & 2047; const float v = r < 2 ? F.c[r * D + k] : F.c_ctx[k]; sc[idx] = v * fsigmoid(v); } have_sc = true; __syncthreads(); }
            const int cg = job, sub = F.lane / 24, c4 = F.lane % 24;
            f32x4 a0 = {0.f, 0.f, 0.f, 0.f}, a1 = a0, a2 = a0;
            if (F.lane < 48) {
                const float* wp = F.w_mod + (size_t)(F.wave * 2 + sub) * 12288 + cg * 96 + c4 * 4;
                for (int it = 0; it < 128; it += 8) {
                    f32x4 wv[8];
#pragma unroll
                    for (int u = 0; u < 8; ++u) wv[u] = __builtin_nontemporal_load((const f32x4*)(wp + (size_t)(it + u) * 16 * 12288));
#pragma unroll
                    for (int u = 0; u < 8; ++u) { const int k = (it + u) * 16 + F.wave * 2 + sub; a0 += sc[k] * wv[u]; a1 += sc[D + k] * wv[u]; a2 += sc[2 * D + k] * wv[u]; }
                }
                LAS float* rp = red + (F.wave * 2 + sub) * 288 + c4 * 4;
                *(LAS f32x4*)(rp) = a0; *(LAS f32x4*)(rp + 96) = a1; *(LAS f32x4*)(rp + 192) = a2;
            }
            __syncthreads();
            if (F.tid < 288) { const int r = F.tid / 96, cc = F.tid % 96; float s = F.b_mod[cg * 96 + cc];
#pragma unroll
                for (int p = 0; p < 16; ++p) s += red[p * 288 + r * 96 + cc];
                F.MOD[r * 12288 + cg * 96 + cc] = s; }
        } else {
#pragma unroll 1
            for (int q = 0; q < 4; ++q) {
                int r = (job - 128) * 32 + q * 8 + F.wave;
                if (r < I_IN) { const int nblk = NIN / 32, k0 = 64 * (r / nblk), n0 = 32 * (r % nblk); int orow0;
                    if (n0 < 3072) orow0 = n0; else if (n0 < 4096) { const int qq = n0 - 3072; orow0 = 3072 + (qq >> 7) * 256 + (qq & 127); } else { const int qq = n0 - 4096; orow0 = 3072 + (qq >> 7) * 256 + 128 + (qq & 127); }
                    transpose_item(F.w_in, D, NIN, k0, n0, F.WIN, orow0, scr, F.lane); continue; }
                r -= I_IN;
                if (r < I_OUT) { const int nblk = D / 32, k0 = 64 * (r / nblk), n0 = 32 * (r % nblk); transpose_item(F.w_out, D, D, k0, n0, F.WOUT, n0, scr, F.lane); continue; }
                r -= I_OUT;
                { const int mat = r >> 3, sub = r & 7, type = mat >> 4, dh = mat & 15; const int k0 = 64 * (sub >> 2), n0 = 32 * (sub & 3);
                  const float* W = (type ? F.lru_w_i : F.lru_w_r) + (size_t)dh * 16384; transpose_item(W, 128, 128, k0, n0, F.WG + (size_t)(type * 16 + dh) * 16384, n0, scr, F.lane); }
            }
        }
    }
}

struct CvItem { const GAS float* W; GAS unsigned char* WT; };
typedef float f32x16 __attribute__((ext_vector_type(16)));
typedef unsigned u32x6 __attribute__((ext_vector_type(6)));
constexpr int CV6_NSTRIP = 2 * 32 * 64, CV6_FQ_PITCH = 1040, CV6_TILE_BYTES = 4 * CV6_FQ_PITCH * 4;
__device__ __forceinline__ u32x6 cvt_fp6_32(const float (&v)[32], const float scale) {
    f32x16 p, q;
#pragma unroll
    for (int i = 0; i < 16; ++i) { p[i] = v[i] * scale; q[i] = v[16 + i] * scale; }
    return __builtin_amdgcn_cvt_scalef32_2xpk16_fp6_f32(p, q, 1.0f);
}
__device__ __forceinline__ CvItem cv6_decode(Frame& F, int strip, int kt) {
    const int which = strip >> 11, e = (strip >> 6) & 31, n0 = 32 * (strip & 63);
    const unsigned long long m0 = which == 0 ? ~0ull : 0ull;
    const unsigned long long wsel = ((unsigned long long)F.w_gate & m0) | ((unsigned long long)F.w_up & ~m0);
    const int orow0 = (n0 >> 7) * 256 + which * 128 + (n0 & 127);
    CvItem c; c.W = (const GAS float*)wsel + (size_t)e * D * FF + (size_t)(128 * kt) * 2048 + n0;
    c.WT = (GAS unsigned char*)F.WGU + (size_t)e * 4096 * D + (size_t)orow0 * 2048 + kt * 128;
    return c;
}
__device__ __forceinline__ void cv6_load(const CvItem& c, int lane, f32x4 (&v)[16]) {
    const GAS float* p = c.W + (size_t)(lane >> 3) * 2048 + 4 * (lane & 7);
#pragma unroll
    for (int i = 0; i < 16; ++i) v[i] = __builtin_nontemporal_load((const GAS f32x4*)(p + (size_t)(8 * i) * 2048));
}
__device__ __forceinline__ void cv6_store(const CvItem& c, int lane, const f32x4 (&v)[16], LAS float* scr) {
    const int r8 = lane >> 3, c4 = lane & 7;
    LAS float* wb = scr + (r8 >> 2) * 128 + 4 * c4 + (r8 & 3);
#pragma unroll
    for (int i = 0; i < 16; ++i)
#pragma unroll
        for (int nn = 0; nn < 4; ++nn) wb[(i >> 2) * CV6_FQ_PITCH + 2 * (i & 3) * 128 + 32 * nn] = v[i][nn];
    asm volatile("s_waitcnt lgkmcnt(0)" ::: "memory");
#pragma unroll
    for (int rd = 0; rd < 2; ++rd) {
        const int npp = 16 * rd + (lane >> 2), fq = lane & 3;
        const LAS float* rb = scr + fq * CV6_FQ_PITCH + 4 * npp;
        float f[32];
#pragma unroll
        for (int j = 0; j < 8; ++j) { const f32x4 t = *(const LAS f32x4*)(rb + j * 128); f[4 * j] = t.x; f[4 * j + 1] = t.y; f[4 * j + 2] = t.z; f[4 * j + 3] = t.w; }
        const u32x6 pk = cvt_fp6_32(f, W8_SCALE);
        const unsigned lo4 = (unsigned)__builtin_amdgcn_update_dpp(0, (int)pk[4], 0x114, 0xf, 0xf, false), lo5 = (unsigned)__builtin_amdgcn_update_dpp(0, (int)pk[5], 0x114, 0xf, 0xf, false);
        const unsigned hi4 = (unsigned)__builtin_amdgcn_update_dpp(0, (int)pk[4], 0x104, 0xf, 0xf, false), hi5 = (unsigned)__builtin_amdgcn_update_dpp(0, (int)pk[5], 0x104, 0xf, 0xf, false);
        const bool odd = (npp & 1) != 0;
        const int na = odd ? npp - 1 : npp, nb = odd ? npp : npp + 1;
        GAS unsigned char* oa = c.WT + (size_t)(4 * (na & 7) + (na >> 3)) * 2048 + 16 * fq + (odd ? 64 : 0);
        GAS unsigned char* ob = c.WT + (size_t)(4 * (nb & 7) + (nb >> 3)) * 2048 + 16 * fq + (odd ? 0 : 64);
        const u32x4 f1 = {pk[0], pk[1], pk[2], pk[3]}, slo = {lo4, lo5, lo4, lo5}, shi = {hi4, hi5, hi4, hi5};
        __builtin_nontemporal_store(odd ? slo : f1, (GAS u32x4*)oa);
        __builtin_nontemporal_store(odd ? f1 : shi, (GAS u32x4*)ob);
    }
    asm volatile("s_waitcnt lgkmcnt(0)" ::: "memory");
}
__device__ __forceinline__ int cv6_claim(Frame& F) { int s = 0; if (F.lane == 0) s = (int)atomicAdd(F.ctl + CW_QCV6, 1u); return __builtin_amdgcn_readfirstlane(s); }
__device__ __forceinline__ void ph_expert_conv6(Frame& F) {
    LAS float* scr = (LAS float*)(F.lds + F.wave * CV6_TILE_BYTES);
    int sc = cv6_claim(F), kb = 0;
    if (sc >= CV6_NSTRIP) return;
    f32x4 va[16], vb[16];
    cv6_load(cv6_decode(F, sc, kb), F.lane, va);
    for (;;) {
        int s1 = sc, k1 = kb + 1; if (k1 == 16) { s1 = cv6_claim(F); k1 = 0; }
        const bool h1 = s1 < CV6_NSTRIP;
        cv6_load(cv6_decode(F, h1 ? s1 : sc, h1 ? k1 : kb), F.lane, vb);
        cv6_store(cv6_decode(F, sc, kb), F.lane, va, scr);
        if (!h1) break;
        int s2 = s1, k2 = k1 + 1; if (k2 == 16) { s2 = cv6_claim(F); k2 = 0; }
        const bool h2 = s2 < CV6_NSTRIP;
        cv6_load(cv6_decode(F, h2 ? s2 : s1, h2 ? k2 : k1), F.lane, va);
        cv6_store(cv6_decode(F, s1, k1), F.lane, vb, scr);
        if (!h2) break;
        sc = s2; kb = k2;
    }
}

constexpr int CV_PK = 132, CV_TILE_BYTES = 8 * CV_PK * 4, CV_NSTRIP = 32 * 64, CV_KB = 16;
__device__ __forceinline__ CvItem cv_decode(Frame& F, int strip, int kb) {
    const int which = 2, e = (strip >> 6) & 31, n0 = 32 * (strip & 63), k0 = 128 * kb;
    const unsigned long long m0 = which == 0 ? ~0ull : 0ull, m1 = which == 1 ? ~0ull : 0ull, m2 = which == 2 ? ~0ull : 0ull;
    const unsigned long long wsel = ((unsigned long long)F.w_gate & m0) | ((unsigned long long)F.w_up & m1) | ((unsigned long long)F.w_down & m2);
    const unsigned long long osel = ((unsigned long long)F.WGU & (m0 | m1)) | ((unsigned long long)F.WDN & m2);
    const int orow0 = which == 2 ? n0 : (n0 >> 7) * 256 + which * 128 + (n0 & 127);
    const size_t ebytes = which == 2 ? (size_t)D * FF : (size_t)4096 * D;
    CvItem c; c.W = (const GAS float*)wsel + (size_t)e * D * FF + (size_t)k0 * 2048 + n0;
    c.WT = (GAS unsigned char*)osel + (size_t)e * ebytes + (size_t)orow0 * 2048 + k0;
    return c;
}
__device__ __forceinline__ void cv_load(const CvItem& c, int lane, f32x4 (&v)[16]) {
    const GAS float* p = c.W + (size_t)(lane >> 3) * 2048 + 4 * (lane & 7);
#pragma unroll
    for (int i = 0; i < 16; ++i) v[i] = __builtin_nontemporal_load((const GAS f32x4*)(p + (size_t)(8 * i) * 2048));
}
__device__ __forceinline__ void cv_store(const CvItem& c, int lane, const f32x4 (&v)[16], LAS float* scr) {
    LAS unsigned* sb = (LAS unsigned*)scr;
    const int r8 = lane >> 3, c4 = lane & 7;
#pragma unroll
    for (int i = 0; i < 16; ++i) { const f32x4 w = v[i] * W8_SCALE; sb[c4 * CV_PK + 8 * i + r8] = pk4_fp8(w.x, w.y, w.z, w.w); }
    asm volatile("s_waitcnt lgkmcnt(0)" ::: "memory");
    const int n4 = lane >> 3, kb = lane & 7;
    u32x4 dq[4];
#pragma unroll
    for (int g = 0; g < 4; ++g) dq[g] = *(const LAS u32x4*)(sb + n4 * CV_PK + 16 * kb + 4 * g);
    u32x4 o[4];
#pragma unroll
    for (int g = 0; g < 4; ++g) {
        const unsigned lo01 = __builtin_amdgcn_perm(dq[g].y, dq[g].x, 0x05010400u), hi01 = __builtin_amdgcn_perm(dq[g].y, dq[g].x, 0x07030602u);
        const unsigned lo23 = __builtin_amdgcn_perm(dq[g].w, dq[g].z, 0x05010400u), hi23 = __builtin_amdgcn_perm(dq[g].w, dq[g].z, 0x07030602u);
        o[0][g] = __builtin_amdgcn_perm(lo23, lo01, 0x05040100u); o[1][g] = __builtin_amdgcn_perm(lo23, lo01, 0x07060302u);
        o[2][g] = __builtin_amdgcn_perm(hi23, hi01, 0x05040100u); o[3][g] = __builtin_amdgcn_perm(hi23, hi01, 0x07060302u);
    }
#pragma unroll
    for (int j = 0; j < 4; ++j) __builtin_nontemporal_store(o[j], (GAS u32x4*)(c.WT + (size_t)(4 * n4 + j) * 2048 + 16 * kb));
    asm volatile("s_waitcnt lgkmcnt(0)" ::: "memory");
}
__device__ __forceinline__ int cv_claim(Frame& F) { int s = 0; if (F.lane == 0) s = (int)atomicAdd(F.ctl + CW_QCV, 1u); return __builtin_amdgcn_readfirstlane(s); }
__device__ __forceinline__ void ph_expert_conv(Frame& F) {
    LAS float* scr = (LAS float*)(F.lds + F.wave * CV6_TILE_BYTES);
    int sc = cv_claim(F), kb = 0;
    if (sc >= CV_NSTRIP) return;
    f32x4 va[16], vb[16];
    cv_load(cv_decode(F, sc, kb), F.lane, va);
    for (;;) {
        int s1 = sc, k1 = kb + 1; if (k1 == CV_KB) { s1 = cv_claim(F); k1 = 0; }
        const bool h1 = s1 < CV_NSTRIP;
        cv_load(cv_decode(F, h1 ? s1 : sc, h1 ? k1 : kb), F.lane, vb);
        cv_store(cv_decode(F, sc, kb), F.lane, va, scr);
        if (!h1) break;
        int s2 = s1, k2 = k1 + 1; if (k2 == CV_KB) { s2 = cv_claim(F); k2 = 0; }
        const bool h2 = s2 < CV_NSTRIP;
        cv_load(cv_decode(F, h2 ? s2 : s1, h2 ? k2 : k1), F.lane, va);
        cv_store(cv_decode(F, s1, k1), F.lane, vb, scr);
        if (!h2) break;
        sc = s2; kb = k2;
    }
}

constexpr int AT_STRIDE = 4112;
__device__ __forceinline__ void ph1(Frame& F) {
    LAS float* Ac = (LAS float*)F.lds; LAS float* Bc = Ac + D;
    const int gw = F.bid * 8 + F.wave, NGW = F.nb * 8;
    for (int seg = 0; seg < 3; ++seg) {
        __syncthreads();
        for (int cc = F.tid; cc < D; cc += 512) { const float sh = F.MOD[seg * 12288 + cc], sl = F.MOD[seg * 12288 + D + cc]; Ac[cc] = F.g_mix[cc] * (1.0f + sl); Bc[cc] = sh; }
        __syncthreads();
        if (seg < 2) {
            const float* in = F.x + (size_t)seg * SEQ * D; bf16_t* outp = F.XN + (size_t)(seg * SEQ) * D;
            for (int m = gw; m < SEQ; m += NGW) {
                const f32x4* xr = (const f32x4*)(in + (size_t)m * D) + F.lane; f32x4 v[8]; float s = 0.f;
#pragma unroll
                for (int j = 0; j < 8; ++j) { v[j] = __builtin_nontemporal_load(xr + 64 * j); s += (v[j].x * v[j].x + v[j].y * v[j].y) + (v[j].z * v[j].z + v[j].w * v[j].w); }
                const float rstd = 1.0f / sqrtf(wave_sum(s) * (1.0f / D) + EPS);
                unsigned long long* o8 = (unsigned long long*)(outp + (size_t)m * D) + F.lane;
#pragma unroll
                for (int j = 0; j < 8; ++j) { const f32x4 a = *(const LAS f32x4*)(Ac + 4 * (F.lane + 64 * j)), b = *(const LAS f32x4*)(Bc + 4 * (F.lane + 64 * j)); const f32x4 o = v[j] * rstd * a + b;
                    o8[64 * j] = (unsigned long long)cvt_pk_bf16(o.x, o.y) | ((unsigned long long)cvt_pk_bf16(o.z, o.w) << 32); }
            }
        } else {
            LAS unsigned char* AT = F.lds + 16384; LAS float* RED = (LAS float*)(F.lds + 16384 + 16 * AT_STRIDE + 256);
            for (int u = F.bid; u < 256; u += F.nb) {
                const int rg = u >> 3, cg = u & 7;
                __syncthreads();
#pragma unroll 1
                for (int rr = 0; rr < 2; ++rr) { const int r = F.wave * 2 + rr;
                    const f32x4* xr = (const f32x4*)(F.ctx + (size_t)(16 * rg + r) * D) + F.lane; f32x4 v[8]; float s = 0.f;
#pragma unroll
                    for (int j = 0; j < 8; ++j) { v[j] = xr[64 * j]; s += (v[j].x * v[j].x + v[j].y * v[j].y) + (v[j].z * v[j].z + v[j].w * v[j].w); }
                    const float rstd = 1.0f / sqrtf(wave_sum(s) * (1.0f / D) + EPS);
#pragma unroll
                    for (int j = 0; j < 8; ++j) { const f32x4 a = *(const LAS f32x4*)(Ac + 4 * (F.lane + 64 * j)), b = *(const LAS f32x4*)(Bc + 4 * (F.lane + 64 * j)); const f32x4 o = v[j] * rstd * a + b;
                        u32x2 w; w.x = cvt_pk_bf16(o.x, o.y); w.y = cvt_pk_bf16(o.z, o.w); *(LAS u32x2*)(AT + r * AT_STRIDE + 8 * (F.lane + 64 * j)) = w; } }
                __syncthreads();
                const int c16 = F.lane & 15, q = F.lane >> 4;
                f32x4 acc[8];
#pragma unroll
                for (int n = 0; n < 8; ++n) acc[n] = (f32x4){0.f, 0.f, 0.f, 0.f};
                const bf16_t* wb = F.WIN + (size_t)(DA + 128 * cg + c16) * D + 256 * F.wave + 8 * q;
                const bf16_t* wp[8];
#pragma unroll
                for (int n = 0; n < 8; ++n) wp[n] = wb + (size_t)(16 * n) * D;
                u32x4 bA[8], bB[8];
#define P1_LD(dst, ks) do { _Pragma("unroll") for (int n = 0; n < 8; ++n) asm volatile("global_load_dwordx4 %0, %1, off offset:%2" : "=v"(dst[n]) : "v"(wp[n]), "n"(64 * (ks))); } while (0)
#define P1_WAIT(dst, cnt) asm volatile("s_waitcnt vmcnt(" #cnt ")" : "+v"(dst[0]), "+v"(dst[1]), "+v"(dst[2]), "+v"(dst[3]), "+v"(dst[4]), "+v"(dst[5]), "+v"(dst[6]), "+v"(dst[7]) :: "memory")
#define P1_MMA(dst, ks) do { const bf16x8 af = *(const LAS bf16x8*)(AT + c16 * AT_STRIDE + (256 * F.wave + 32 * (ks) + 8 * q) * 2); \
                    _Pragma("unroll") for (int n = 0; n < 8; ++n) acc[n] = __builtin_amdgcn_mfma_f32_16x16x32_bf16(af, __builtin_bit_cast(bf16x8, dst[n]), acc[n], 0, 0, 0); } while (0)
                P1_LD(bA, 0);
                P1_LD(bB, 1); P1_WAIT(bA, 8); P1_MMA(bA, 0);
                P1_LD(bA, 2); P1_WAIT(bB, 8); P1_MMA(bB, 1);
                P1_LD(bB, 3); P1_WAIT(bA, 8); P1_MMA(bA, 2);
                P1_LD(bA, 4); P1_WAIT(bB, 8); P1_MMA(bB, 3);
                P1_LD(bB, 5); P1_WAIT(bA, 8); P1_MMA(bA, 4);
                P1_LD(bA, 6); P1_WAIT(bB, 8); P1_MMA(bB, 5);
                P1_LD(bB, 7); P1_WAIT(bA, 8); P1_MMA(bA, 6);
                P1_WAIT(bB, 0); P1_MMA(bB, 7);
#undef P1_LD
#undef P1_WAIT
#undef P1_MMA
#pragma unroll
                for (int n = 0; n < 8; ++n)
#pragma unroll
                    for (int rg4 = 0; rg4 < 4; ++rg4) RED[(F.wave * 16 + 4 * q + rg4) * 128 + 16 * n + c16] = acc[n][rg4];
                __syncthreads();
                { const int tok = F.tid >> 5, c4 = (F.tid & 31) * 4; f32x4 sum = {0.f, 0.f, 0.f, 0.f};
#pragma unroll
                  for (int w = 0; w < 8; ++w) sum += *(const LAS f32x4*)(RED + (w * 16 + tok) * 128 + c4);
                  u32x2 o; o.x = cvt_pk_bf16(sum.x, sum.y); o.y = cvt_pk_bf16(sum.z, sum.w);
                  *(u32x2*)(F.XA + (size_t)(T + 16 * rg + tok) * DA + 128 * cg + c4) = o; }
            }
        }
    }
}

constexpr int XCT_STRIDE = 272;
template <bool FINAL>
__device__ __forceinline__ void gates_phase(Frame& F, const int nrep) {
    LAS unsigned char* xcT = F.lds; LAS unsigned char* hsT = F.lds + 64 * XCT_STRIDE;
    const int h = F.bid & 7, kb0 = F.bid >> 3, kstride = (F.nb - h + 7) >> 3;
    const int NU = FINAL ? 256 : 2 * NCHUNK;
    const int c16 = F.lane & 15, q = F.lane >> 4, jrow = F.wave * 16 + c16, ch = h * 128 + jrow;
    bf16x8 bfr[4][4];
#pragma unroll
    for (int ks = 0; ks < 4; ++ks)
#pragma unroll
        for (int td = 0; td < 4; ++td) bfr[ks][td] = *(const bf16x8*)(F.WG + (size_t)((td * 8 + h) * 128 + jrow) * 128 + ks * 32 + q * 8);
    const float brf = F.lru_b_r[ch], brb = F.lru_b_r[DA + ch], bif = F.lru_b_i[ch], bib = F.lru_b_i[DA + ch];
    const float cff = -8.0f * log1pf(expf(-F.lru_lam[ch])), cfb = -8.0f * log1pf(expf(-F.lru_lam[DA + ch]));
    const int cg = F.tid & 15, tok0 = F.tid >> 4, chc = h * 128 + cg * 8;
    LAS float* CW = (LAS float*)(F.lds + 128 * XCT_STRIDE);
    for (int i = F.tid; i < 640; i += 512) CW[i] = i < 512 ? F.conv_a_w[(i >> 7) * DA + h * 128 + (i & 127)] : F.conv_a_b[h * 128 + (i - 512)];
    u32x4 xr[2][4];
#define GU_DECODE(k, b_, ci_, grow0_, t0_, seqlen_) const int b_ = (k) / (FINAL ? 128 : NCHUNK), ci_ = (k) % (FINAL ? 128 : NCHUNK); \
        const bool ctxu_ = !FINAL && ci_ < 4; const int t0_ = ctxu_ ? ci_ * 64 : (FINAL ? ci_ : ci_ - 4) * 64, seqlen_ = ctxu_ ? CTXL : SEQ, grow0_ = ctxu_ ? T + b_ * CTXL + t0_ : b_ * SEQ + t0_;
#define GU_LOAD(k) do { GU_DECODE(k, b_, ci_, grow0_, t0_, seqlen_) (void)ci_; \
        _Pragma("unroll") for (int it = 0; it < 2; ++it) _Pragma("unroll") for (int kk = 0; kk < 4; ++kk) { const int tt = t0_ + tok0 + 32 * it + kk - 2; \
            xr[it][kk] = (tt >= 0 && tt < seqlen_) ? *(const u32x4*)(F.XA + (size_t)(grow0_ + tok0 + 32 * it + kk - 2) * DA + chc) : (u32x4){0u, 0u, 0u, 0u}; } } while (0)
#pragma unroll 1
    for (int rep = 0; rep < nrep; ++rep) {
    int k = kb0;
    if (k < NU) GU_LOAD(k);
    for (; k < NU; k += kstride) {
        GU_DECODE(k, b, ci, grow0, t0, seqlen) (void)t0; (void)seqlen;
        __syncthreads();
#pragma unroll
        for (int it = 0; it < 2; ++it) { f32x4 a0 = *(const LAS f32x4*)(CW + 512 + cg * 8), a1 = *(const LAS f32x4*)(CW + 512 + cg * 8 + 4);
#pragma unroll
            for (int kk = 0; kk < 4; ++kk) { float xf[8]; unpack8(xr[it][kk], xf); a0 += *(const LAS f32x4*)(CW + kk * 128 + cg * 8) * (f32x4){xf[0], xf[1], xf[2], xf[3]}; a1 += *(const LAS f32x4*)(CW + kk * 128 + cg * 8 + 4) * (f32x4){xf[4], xf[5], xf[6], xf[7]}; }
            u32x4 o; o.x = cvt_pk_bf16(a0.x, a0.y); o.y = cvt_pk_bf16(a0.z, a0.w); o.z = cvt_pk_bf16(a1.x, a1.y); o.w = cvt_pk_bf16(a1.z, a1.w);
            *(LAS u32x4*)(xcT + (tok0 + 32 * it) * XCT_STRIDE + cg * 16) = o; }
        { const int kn = k + kstride; if (kn < NU) GU_LOAD(kn); }
        __syncthreads();
        f32x4 acc[4][4];
#pragma unroll
        for (int m = 0; m < 4; ++m)
#pragma unroll
            for (int td = 0; td < 4; ++td) acc[m][td] = (f32x4){0.f, 0.f, 0.f, 0.f};
#pragma unroll
        for (int ks = 0; ks < 4; ++ks) {
#pragma unroll
            for (int m = 0; m < 4; ++m) { const int arow = 16 * (c16 >> 2) + 4 * m + (c16 & 3); const bf16x8 af = *(const LAS bf16x8*)(xcT + arow * XCT_STRIDE + (ks * 32 + q * 8) * 2);
#pragma unroll
                for (int td = 0; td < 4; ++td) acc[m][td] = __builtin_amdgcn_mfma_f32_16x16x32_bf16(af, bfr[ks][td], acc[m][td], 0, 0, 0); }
        }
#pragma unroll
        for (int m = 0; m < 4; ++m)
#pragma unroll
            for (int rg = 0; rg < 4; ++rg) { const int tok = 16 * q + 4 * m + rg; const float xcv = __uint_as_float((unsigned)(*(const LAS unsigned short*)(xcT + tok * XCT_STRIDE + jrow * 2)) << 16);
                { float ao, bo; gate_pair(acc[m][0][rg] + brf, acc[m][2][rg] + bif, cff, xcv, ao, bo); acc[m][0][rg] = ao; acc[m][2][rg] = bo; }
                { float ao, bo; gate_pair(acc[m][1][rg] + brb, acc[m][3][rg] + bib, cfb, xcv, ao, bo); acc[m][1][rg] = ao; acc[m][3][rg] = bo; } }
        float Af = 1.f, Bf = 0.f, Ab = 1.f, Bb = 0.f;
#pragma unroll
        for (int m = 0; m < 4; ++m)
#pragma unroll
            for (int rg = 0; rg < 4; ++rg) { Bf = acc[m][0][rg] * Bf + acc[m][2][rg]; Af *= acc[m][0][rg]; }
#pragma unroll
        for (int m = 3; m >= 0; --m)
#pragma unroll
            for (int rg = 3; rg >= 0; --rg) { Bb = acc[m][1][rg] * Bb + acc[m][3][rg]; Ab *= acc[m][1][rg]; }
        float A_[4], B_[4], Ab_[4], Bb_[4];
#pragma unroll
        for (int qq = 0; qq < 4; ++qq) { A_[qq] = __shfl(Af, c16 + 16 * qq); B_[qq] = __shfl(Bf, c16 + 16 * qq); Ab_[qq] = __shfl(Ab, c16 + 16 * qq); Bb_[qq] = __shfl(Bb, c16 + 16 * qq); }
        if constexpr (!FINAL) {
            const float At = (A_[0] * A_[1]) * (A_[2] * A_[3]), Bt = ((B_[0] * A_[1] + B_[1]) * A_[2] + B_[2]) * A_[3] + B_[3];
            const float Abt = (Ab_[0] * Ab_[1]) * (Ab_[2] * Ab_[3]), Bbt = ((Bb_[3] * Ab_[2] + Bb_[2]) * Ab_[1] + Bb_[1]) * Ab_[0] + Bb_[0];
            if (q == 0) { F.AGG[(size_t)((0 * 2 + b) * NCHUNK + ci) * DA + ch] = (f32x2){At, Bt}; F.AGG[(size_t)((1 * 2 + b) * NCHUNK + ci) * DA + ch] = (f32x2){Abt, Bbt}; }
        } else {
            float hf = F.HIN[(size_t)((0 * 2 + b) * 128 + ci) * DA + ch], hb = F.HIN[(size_t)((1 * 2 + b) * 128 + ci) * DA + ch];
#pragma unroll
            for (int qq = 0; qq < 4; ++qq) hf = (qq < q) ? A_[qq] * hf + B_[qq] : hf;
#pragma unroll
            for (int qq = 3; qq >= 0; --qq) hb = (qq > q) ? Ab_[qq] * hb + Bb_[qq] : hb;
            float hs[4][4]; float hh = hf;
#pragma unroll
            for (int m = 0; m < 4; ++m)
#pragma unroll
                for (int rg = 0; rg < 4; ++rg) { hh = acc[m][0][rg] * hh + acc[m][2][rg]; hs[m][rg] = hh; }
            hh = hb;
#pragma unroll
            for (int m = 3; m >= 0; --m)
#pragma unroll
                for (int rg = 3; rg >= 0; --rg) { hh = acc[m][1][rg] * hh + acc[m][3][rg]; hs[m][rg] += hh; }
#pragma unroll
            for (int m = 0; m < 4; ++m)
#pragma unroll
                for (int rg = 0; rg < 4; ++rg) { const int tok = 16 * q + 4 * m + rg; *(LAS unsigned short*)(hsT + tok * XCT_STRIDE + jrow * 2) = (unsigned short)(cvt_pk_bf16(hs[m][rg], 0.f) & 0xffffu); }
            __syncthreads();
#pragma unroll
            for (int it = 0; it < 2; ++it) { const int tok = tok0 + 32 * it; *(u32x4*)(F.HS + (size_t)(grow0 + tok) * DA + chc) = *(const LAS u32x4*)(hsT + tok * XCT_STRIDE + cg * 16); }
        }
    }
    }
#undef GU_DECODE
#undef GU_LOAD
}
__device__ __forceinline__ void ph4(Frame& F) {
    LAS f32x2* G = (LAS f32x2*)F.lds;
    for (int u = F.bid; u < 128; u += F.nb) {
        const int dir = u >> 6, b = (u >> 5) & 1, ch = (u & 31) * 32 + (F.tid & 31), g = F.tid >> 5;
        const f32x2* ag = F.AGG + (size_t)((dir * 2 + b) * NCHUNK) * DA + ch; float* hin = F.HIN + (size_t)((dir * 2 + b) * 128) * DA + ch;
        f32x2 v[12]; float A = 1.f, B = 0.f;
        __syncthreads();
        if (g < 11) {
#pragma unroll
            for (int j = 0; j < 12; ++j) { const int p = g * 12 + j, cidx = dir == 0 ? p : (p < 4 ? 3 - p : 135 - p); v[j] = ag[(size_t)cidx * DA]; }
#pragma unroll
            for (int j = 0; j < 12; ++j) { B = v[j].x * B + v[j].y; A *= v[j].x; }
            G[g * 32 + (F.tid & 31)] = (f32x2){A, B};
        }
        __syncthreads();
        if (g < 11) {
            float hcur = 0.f;
            for (int gg = 0; gg < g; ++gg) { const f32x2 t = G[gg * 32 + (F.tid & 31)]; hcur = t.x * hcur + t.y; }
#pragma unroll
            for (int j = 0; j < 12; ++j) { const int p = g * 12 + j, cidx = dir == 0 ? p : (p < 4 ? 3 - p : 135 - p); if (cidx >= 4) hin[(size_t)(cidx - 4) * DA] = hcur; hcur = v[j].x * hcur + v[j].y; }
        }
    }
}
__device__ __forceinline__ void p5b_load(Frame& F, int t, int c0, int c1, u32x4 (&v)[12]) {
    const int tl = t & (SEQ - 1), col = tl & 63, grow = tl >> 6; const size_t ro = (size_t)t * DA; const u32x4 zero = {0u, 0u, 0u, 0u};
    v[0] = __builtin_nontemporal_load((const u32x4*)(F.Gb + ro + c0)); v[1] = __builtin_nontemporal_load((const u32x4*)(F.Gb + ro + c1)); v[2] = __builtin_nontemporal_load((const u32x4*)(F.HS + ro + c0)); v[3] = __builtin_nontemporal_load((const u32x4*)(F.HS + ro + c1));
    v[4] = __builtin_nontemporal_load((const u32x4*)(F.BB + ro + c0)); v[5] = __builtin_nontemporal_load((const u32x4*)(F.BB + ro + c1)); v[6] = *(const u32x4*)(F.P + ro + c0); v[7] = *(const u32x4*)(F.P + ro + c1);
    v[8] = col > 0 ? *(const u32x4*)(F.P + ro - DA + c0) : zero; v[9] = col < 63 ? *(const u32x4*)(F.P + ro + DA + c0) : zero;
    v[10] = grow > 0 ? *(const u32x4*)(F.P + ro - 64 * DA + c1) : zero; v[11] = grow < 127 ? *(const u32x4*)(F.P + ro + 64 * DA + c1) : zero;
}
__device__ __forceinline__ void p5b_item(Frame& F, int t, int c0, int c1, const u32x4 (&v)[12], const f32x4 (&wa)[2][2], const f32x4 (&wb)[2][2], const f32x4 (&w0)[2][2], const f32x4 (&w1)[2][2], const f32x4 (&w2)[2][2]) {
    float ya[2][8], yb[2][8]; float sa = 0.f, sb = 0.f;
#pragma unroll
    for (int cc = 0; cc < 2; ++cc) { float gg[8], hh[8]; unpack8(v[cc], gg); unpack8(v[2 + cc], hh);
#pragma unroll
        for (int j = 0; j < 8; ++j) { const float y = gg[j] * hh[j]; sa += y * y; ya[cc][j] = y * wa[cc][j >> 2][j & 3]; } }
#pragma unroll
    for (int cc = 0; cc < 2; ++cc) { float bq[8], a[8], m[8], p[8]; unpack8(v[4 + cc], bq); unpack8(v[6 + cc], a); unpack8(v[8 + 2 * cc], m); unpack8(v[9 + 2 * cc], p);
#pragma unroll
        for (int j = 0; j < 8; ++j) { const float y = bq[j] * (w0[cc][j >> 2][j & 3] * m[j] + w1[cc][j >> 2][j & 3] * a[j] + w2[cc][j >> 2][j & 3] * p[j]); sb += y * y; yb[cc][j] = y * wb[cc][j >> 2][j & 3]; } }
    sa = wave_sum(sa); sb = wave_sum(sb);
    const float ra = 1.0f / sqrtf(sa * (1.0f / DA) + EPS), rb = 1.0f / sqrtf(sb * (1.0f / DA) + EPS);
    bf16_t* yo = F.Y + (size_t)t * D;
#pragma unroll
    for (int cc = 0; cc < 2; ++cc) { const int c = cc ? c1 : c0; u32x4 o;
        o.x = cvt_pk_bf16(ya[cc][0] * ra, ya[cc][1] * ra); o.y = cvt_pk_bf16(ya[cc][2] * ra, ya[cc][3] * ra); o.z = cvt_pk_bf16(ya[cc][4] * ra, ya[cc][5] * ra); o.w = cvt_pk_bf16(ya[cc][6] * ra, ya[cc][7] * ra);
        *(u32x4*)(yo + c) = o;
        o.x = cvt_pk_bf16(yb[cc][0] * rb, yb[cc][1] * rb); o.y = cvt_pk_bf16(yb[cc][2] * rb, yb[cc][3] * rb); o.z = cvt_pk_bf16(yb[cc][4] * rb, yb[cc][5] * rb); o.w = cvt_pk_bf16(yb[cc][6] * rb, yb[cc][7] * rb);
        *(u32x4*)(yo + DA + c) = o; }
}
__device__ __forceinline__ void ph5b(Frame& F) {
    const int gw = F.bid * 8 + F.wave, NGW = F.nb * 8, c0 = 8 * F.lane, c1 = 512 + 8 * F.lane;
    if (gw >= T) return;
    f32x4 wa[2][2], wb[2][2], w0[2][2], w1[2][2], w2[2][2];
#pragma unroll
    for (int cc = 0; cc < 2; ++cc)
#pragma unroll
        for (int hh = 0; hh < 2; ++hh) { const int c = (cc ? c1 : c0) + 4 * hh; wa[cc][hh] = *(const f32x4*)(F.g_out_a + c); wb[cc][hh] = *(const f32x4*)(F.g_out_b + c);
            w0[cc][hh] = *(const f32x4*)(F.conv_b_w + c); w1[cc][hh] = *(const f32x4*)(F.conv_b_w + DA + c); w2[cc][hh] = *(const f32x4*)(F.conv_b_w + 2 * DA + c); }
    u32x4 va[12], vb[12]; int t = gw;
    p5b_load(F, t, c0, c1, va);
    for (;;) {
        const int t1 = t + NGW; const bool h1 = t1 < T;
        p5b_load(F, h1 ? t1 : t, c0, c1, vb);
        p5b_item(F, t, c0, c1, va, wa, wb, w0, w1, w2);
        if (!h1) break;
        const int t2 = t1 + NGW; const bool h2 = t2 < T;
        p5b_load(F, h2 ? t2 : t1, c0, c1, va);
        p5b_item(F, t1, c0, c1, vb, wa, wb, w0, w1, w2);
        if (!h2) break;
        t = t2;
    }
}

constexpr int XT_STRIDE = 2052;
__device__ __forceinline__ void ph7(Frame& F) {
    LAS float* Ac = (LAS float*)F.lds; LAS float* Bc = Ac + D; LAS float* XT = (LAS float*)(F.lds + 16384); LAS float* RED = XT; LAS float* LG = (LAS float*)(F.lds + 16384 + 16 * XT_STRIDE * 4);
    int curb = -1;
    for (int g = F.bid; g < T / 16; g += F.nb) {
        const int row0 = 16 * g, b = row0 >> 13;
        __syncthreads();
        if (b != curb) { for (int cc = F.tid; cc < D; cc += 512) { const float sh = F.MOD[b * 12288 + 6144 + cc], sl = F.MOD[b * 12288 + 8192 + cc]; Ac[cc] = F.g_ffn[cc] * (1.0f + sl); Bc[cc] = sh; } curb = b; __syncthreads(); }
#pragma unroll 1
        for (int rr = 0; rr < 2; ++rr) { const int r = F.wave * 2 + rr; const size_t row = (size_t)row0 + r;
            const f32x4* xr = (const f32x4*)(F.x + row * D) + F.lane; const u32x2* mr = (const u32x2*)(F.XN + row * D) + F.lane; f32x4 v[8]; float s = 0.f;
#pragma unroll
            for (int j = 0; j < 8; ++j) { const u32x2 mw = __builtin_nontemporal_load(mr + 64 * j); v[j] = __builtin_nontemporal_load(xr + 64 * j) + (f32x4){bf_lo(mw.x), bf_hi(mw.x), bf_lo(mw.y), bf_hi(mw.y)}; s += (v[j].x * v[j].x + v[j].y * v[j].y) + (v[j].z * v[j].z + v[j].w * v[j].w); }
            const float rstd = 1.0f / sqrtf(wave_sum(s) * (1.0f / D) + EPS);
            unsigned char* o6 = F.XN2 + row * D + (F.lane >> 2) * 128 + (F.lane & 3) * 16;
            u32x2* x1o = (u32x2*)(F.Y + row * D) + F.lane;
#pragma unroll
            for (int j = 0; j < 8; ++j) { u32x2 xw; xw.x = cvt_pk_bf16(v[j].x, v[j].y); xw.y = cvt_pk_bf16(v[j].z, v[j].w); __builtin_nontemporal_store(xw, x1o + 64 * j); }
#pragma unroll
            for (int j = 0; j < 8; ++j) { const f32x4 a = *(const LAS f32x4*)(Ac + 4 * (F.lane + 64 * j)), bq = *(const LAS f32x4*)(Bc + 4 * (F.lane + 64 * j)); const f32x4 o = v[j] * rstd * a + bq;
                v[j] = o;
                *(LAS f32x4*)(XT + r * XT_STRIDE + 4 * (F.lane + 64 * j)) = o; }
            { float fv[32];
#pragma unroll
              for (int j = 0; j < 8; ++j) { const f32x4 t = *(const LAS f32x4*)(XT + r * XT_STRIDE + 32 * F.lane + 4 * j); fv[4 * j] = t.x; fv[4 * j + 1] = t.y; fv[4 * j + 2] = t.z; fv[4 * j + 3] = t.w; }
              const u32x6 pk = cvt_fp6_32(fv, X6_SCALE);
              *(u32x4*)o6 = (u32x4){pk[0], pk[1], pk[2], pk[3]}; *(u32x4*)(o6 + 64) = (u32x4){pk[4], pk[5], pk[4], pk[5]}; }
        }
        __syncthreads();
        {
            const int r = F.lane & 15, q = F.lane >> 4; f32x4 acc0 = {0.f, 0.f, 0.f, 0.f}, acc1 = acc0;
#pragma unroll 8
            for (int i = 0; i < 16; ++i) { const int kb = 256 * F.wave + 16 * i + 4 * q; const f32x4 a4 = *(const LAS f32x4*)(XT + r * XT_STRIDE + kb);
#pragma unroll
                for (int u = 0; u < 4; ++u) { const float b0 = F.w_router[(kb + u) * NE + r], b1 = F.w_router[(kb + u) * NE + 16 + r];
                    acc0 = __builtin_amdgcn_mfma_f32_16x16x4f32(a4[u], b0, acc0, 0, 0, 0); acc1 = __builtin_amdgcn_mfma_f32_16x16x4f32(a4[u], b1, acc1, 0, 0, 0); } }
            __syncthreads();
#pragma unroll
            for (int rg = 0; rg < 4; ++rg) { RED[(F.wave * 16 + 4 * q + rg) * 32 + r] = acc0[rg]; RED[(F.wave * 16 + 4 * q + rg) * 32 + 16 + r] = acc1[rg]; }
        }
        __syncthreads();
        { const int tok = F.tid >> 5, e = F.tid & 31; float s = F.b_router[e];
#pragma unroll
          for (int w = 0; w < 8; ++w) s += RED[(w * 16 + tok) * 32 + e];
          LG[tok * 33 + e] = s; }
        __syncthreads();
        if (F.tid < 16) { const int tok = F.tid; unsigned taken = 0u; float tv[4]; int te[4];
#pragma unroll
            for (int k = 0; k < 4; ++k) { float best = -3.0e38f; int bi = 0;
                for (int e = 0; e < NE; ++e) { const float v = LG[tok * 33 + e]; if (!((taken >> e) & 1u) && v > best) { best = v; bi = e; } }
                taken |= 1u << bi; tv[k] = best; te[k] = bi; }
            float ex[4], sum = 0.f;
#pragma unroll
            for (int k = 0; k < 4; ++k) { ex[k] = expf(tv[k] - tv[0]); sum += ex[k]; }
            const float inv = 1.0f / sum; const int token = row0 + tok;
            unsigned rank[4];
#pragma unroll
            for (int k = 0; k < 4; ++k) rank[k] = atomicAdd(F.CNT + te[k], 1u);
#pragma unroll
            for (int k = 0; k < 4; ++k) { F.STOK[(size_t)te[k] * CAP + rank[k]] = token; F.SLW[(size_t)te[k] * CAP + rank[k]] = ex[k] * inv; F.ER[token * 4 + k] = (unsigned)te[k] | (rank[k] << 8); }
        }
    }
}
__device__ __forceinline__ void moe_tables(Frame& F) {
    __syncthreads();
    if (F.tid < 64) {
        const int e = F.tid, c = e < NE ? (int)F.CNT[e] : 0, tl = (c + 255) >> 8;
        int incl = tl;
#pragma unroll
        for (int d = 1; d < NE; d <<= 1) { const int o = __shfl_up(incl, d); if (e >= d) incl += o; }
        if (e < NE) { F.MISC[128 + e] = (unsigned)c; F.MISC[16 + e] = (unsigned)(incl - tl); F.MISC[64 + e] = (unsigned)(incl - tl); }
        if (e == NE - 1) { F.MISC[16 + NE] = (unsigned)incl; F.MISC[64 + NE] = (unsigned)incl; }
    }
    __syncthreads();
}
__device__ __forceinline__ void ph11(Frame& F) {
    LAS float* GT = (LAS float*)F.lds; LAS float* GF = GT + 2 * D;
    for (int cc = F.tid; cc < D; cc += 512) { GT[cc] = F.MOD[10240 + cc]; GT[D + cc] = F.MOD[12288 + 10240 + cc]; GF[cc] = F.g_final[cc]; }
    __syncthreads();
    const int gw = F.bid * 8 + F.wave, NGW = F.nb * 8;
    u32x4 ern = gw < T ? *(const u32x4*)(F.ER + (size_t)gw * 4) : (u32x4){0u, 0u, 0u, 0u};
    for (int t = gw; t < T; t += NGW) {
        const int b = t >> 13; size_t pos[4]; const u32x4 erc = ern;
        { const int tn = t + NGW; ern = *(const u32x4*)(F.ER + (size_t)(tn < T ? tn : t) * 4); }
#pragma unroll
        for (int k = 0; k < 4; ++k) { const unsigned er = erc[k]; pos[k] = ((size_t)F.MISC[64 + (er & 255u)] << 8) + (er >> 8); }
        float x2[4][8]; float ssq = 0.f;
#pragma unroll
        for (int j = 0; j < 4; ++j) { const int col = 8 * (F.lane + 64 * j);
            const u32x4 mw = __builtin_nontemporal_load((const u32x4*)(F.Y + (size_t)t * D + col));
            const f32x4 xa = {bf_lo(mw.x), bf_hi(mw.x), bf_lo(mw.y), bf_hi(mw.y)}, xb = {bf_lo(mw.z), bf_hi(mw.z), bf_lo(mw.w), bf_hi(mw.w)};
            float s8[8] = {0.f, 0.f, 0.f, 0.f, 0.f, 0.f, 0.f, 0.f};
#pragma unroll
            for (int k = 0; k < 4; ++k) { const u32x2 ov = __builtin_nontemporal_load((const u32x2*)((const unsigned char*)F.O + pos[k] * D + col));
                const f32x2 q0 = __builtin_amdgcn_cvt_pk_f32_fp8((int)ov.x, false), q1 = __builtin_amdgcn_cvt_pk_f32_fp8((int)ov.x, true), q2 = __builtin_amdgcn_cvt_pk_f32_fp8((int)ov.y, false), q3 = __builtin_amdgcn_cvt_pk_f32_fp8((int)ov.y, true);
                s8[0] += q0.x; s8[1] += q0.y; s8[2] += q1.x; s8[3] += q1.y; s8[4] += q2.x; s8[5] += q2.y; s8[6] += q3.x; s8[7] += q3.y; }
#pragma unroll
            for (int i = 0; i < 8; ++i) s8[i] *= O8_INV;
            const f32x4 ga = *(const LAS f32x4*)(GT + b * D + col), gb = *(const LAS f32x4*)(GT + b * D + col + 4);
            x2[j][0] = xa.x + ga.x * s8[0]; x2[j][1] = xa.y + ga.y * s8[1]; x2[j][2] = xa.z + ga.z * s8[2]; x2[j][3] = xa.w + ga.w * s8[3];
            x2[j][4] = xb.x + gb.x * s8[4]; x2[j][5] = xb.y + gb.y * s8[5]; x2[j][6] = xb.z + gb.z * s8[6]; x2[j][7] = xb.w + gb.w * s8[7];
#pragma unroll
            for (int i = 0; i < 8; ++i) ssq += x2[j][i] * x2[j][i]; }
        const float rstd = 1.0f / sqrtf(wave_sum(ssq) * (1.0f / D) + EPS);
#pragma unroll
        for (int j = 0; j < 4; ++j) { const int col = 8 * (F.lane + 64 * j); const f32x4 fa = *(const LAS f32x4*)(GF + col), fb = *(const LAS f32x4*)(GF + col + 4);
            __builtin_nontemporal_store((f32x4){x2[j][0] * rstd * fa.x, x2[j][1] * rstd * fa.y, x2[j][2] * rstd * fa.z, x2[j][3] * rstd * fa.w}, (f32x4*)(F.out + (size_t)t * D + col));
            __builtin_nontemporal_store((f32x4){x2[j][4] * rstd * fb.x, x2[j][5] * rstd * fb.y, x2[j][6] * rstd * fb.z, x2[j][7] * rstd * fb.w}, (f32x4*)(F.out + (size_t)t * D + col + 4)); }
    }
}

struct Args { const float* in[29]; float* out; unsigned char* ws; int ph_lo, ph_hi, li, pad; };
__global__ void __launch_bounds__(512, 2) fwd_kernel(Args args) {
    extern __shared__ __attribute__((aligned(16))) unsigned char lds[];
    Frame F;
    F.lds = (LAS unsigned char*)lds; F.MISC = (volatile LAS unsigned*)(F.lds + MISC_OFF);
    F.tid = threadIdx.x; F.lane = F.tid & 63; F.wave = __builtin_amdgcn_readfirstlane(F.tid >> 6); F.G = gridDim.x;
    unsigned char* ws = args.ws;
    F.ctl = (unsigned*)(ws + WS_CTL);
    F.x = args.in[0]; F.c = args.in[1]; F.ctx = args.in[2]; F.c_ctx = args.in[3]; F.w_mod = args.in[4]; F.b_mod = args.in[5]; F.g_mix = args.in[6]; F.w_in = args.in[7];
    F.conv_a_w = args.in[8]; F.conv_a_b = args.in[9]; F.lru_w_r = args.in[10]; F.lru_b_r = args.in[11]; F.lru_w_i = args.in[12]; F.lru_b_i = args.in[13]; F.lru_lam = args.in[14];
    F.conv_b_w = args.in[15]; F.g_out_a = args.in[16]; F.g_out_b = args.in[17]; F.w_out = args.in[18]; F.g_ffn = args.in[19]; F.w_router = args.in[20]; F.b_router = args.in[21];
    F.w_gate = args.in[22]; F.b_gate = args.in[23]; F.w_up = args.in[24]; F.b_up = args.in[25]; F.w_down = args.in[26]; F.b_down = args.in[27]; F.g_final = args.in[28];
    F.out = args.out;
    F.MOD = (float*)(ws + WS_MOD); F.WG = (bf16_t*)(ws + WS_WG); F.WIN = (bf16_t*)(ws + WS_WIN); F.WOUT = (bf16_t*)(ws + WS_WOUT); F.XN = (bf16_t*)(ws + WS_XN); F.Gb = (bf16_t*)(ws + WS_G);
    F.XA = (bf16_t*)(ws + WS_XA); F.BB = (bf16_t*)(ws + WS_BB); F.P = (bf16_t*)(ws + WS_P); F.Y = (bf16_t*)(ws + WS_Y); F.WGU = (bf16_t*)(ws + WS_WGU); F.WDN = (bf16_t*)(ws + WS_WDN);
    F.H = (bf16_t*)(ws + WS_H); F.O = (bf16_t*)(ws + WS_O); F.AGG = (f32x2*)(ws + WS_AGG); F.HIN = (float*)(ws + WS_HIN); F.ER = (unsigned*)(ws + WS_ER); F.STOK = (int*)(ws + WS_STOK);
    F.SLW = (float*)(ws + WS_SLW); F.CNT = F.ctl + CW_CNT; F.HS = (bf16_t*)(ws + WS_HS); F.XN2 = ws + WS_XN2;
    for (int u = F.tid; u < (LDS_BYTES - MISC_OFF) / 4; u += 512) F.MISC[u] = 0u;
    __syncthreads();
    const bool split = (F.G % 64) == 0 && NC8 > 0;
    const int row8 = (int)blockIdx.x >> 3;
    const bool conv_role = split && ((row8 & 7) < NC8);
    const int Gm = split ? (F.G / 8) * (8 - NC8) : F.G, Gc = split ? (F.G / 8) * NC8 : F.G;
    const int cm = split ? ((int)blockIdx.x & 7) + 8 * ((row8 >> 3) * (8 - NC8) + ((row8 & 7) - NC8)) : (int)blockIdx.x;
    const int cc = split ? ((int)blockIdx.x & 7) + 8 * ((row8 >> 3) * NC8 + (row8 & 7)) : (int)blockIdx.x;
    XcdBarrier bar = xcd_barrier_post(F.ctl + CW_BAR, F.MISC + 8, (unsigned)F.G, true);
    XcdBarrier barM = xcd_barrier_post(F.ctl + CW_BARM, F.MISC + 10, (unsigned)Gm, !conv_role);
#ifndef PH_MASK
#define PH_MASK 0xFFF
#endif
#define IN(k) ((PH_MASK >> (k)) & 1)
#define REP(k) ((REPEAT_MASK >> (k)) & 1)
#define NREP(k) (1 + (REP(k) ? args.pad : 0))

    if (conv_role) {
        F.bid = cc; F.nb = Gc;
        if (IN(8)) { ph_expert_conv6(F); ph_expert_conv(F); }
    } else {
        F.bid = cm; F.nb = Gm;
        if (IN(0)) ph0(F);
        xcd_barrier(barM);
        if (IN(1)) ph1(F);
        xcd_barrier(barM);
        if (IN(2)) {
            DenseOrder S; S.nM = 64; S.nN = 20; S.nwg = 1280; S.G = Gm; S.c = cm; S.nX = 0; S.A = (const char*)F.XN; S.Bt = (const char*)F.WIN; S.tstep = (size_t)256 * D * 2;
            EpiInProj E{args.ws, F.P};
            pg8::gemm_phase<EpiInProj, DenseOrder, false, true, true, false>(F.lds, D, S, E);
        }
        if (IN(8)) { ph_expert_conv6(F); ph_expert_conv(F); }
    }
    F.bid = blockIdx.x; F.nb = F.G;
    xcd_barrier(bar);
    if (IN(3)) { gates_phase<false>(F, NREP(3)); } xcd_barrier(bar);
    if (IN(4)) { for (int r = 0; r < NREP(4); ++r) { if (r) xcd_barrier(bar); ph4(F); } } xcd_barrier(bar);
    if (IN(5)) { gates_phase<true>(F, NREP(5)); } xcd_barrier(bar);
    if (IN(5)) { for (int r = 0; r < NREP(7); ++r) { if (r) xcd_barrier(bar); ph5b(F); } } xcd_barrier(bar);
    if (IN(6)) {
        DenseOrder S; S.nM = 64; S.nN = 8; S.nwg = 512; S.G = F.G; S.c = blockIdx.x; S.nX = 0; S.A = (const char*)F.Y; S.Bt = (const char*)F.WOUT; S.tstep = (size_t)256 * D * 2;
        EpiOutProj E{F.XN, F.MOD};
        for (int r = 0; r < NREP(6); ++r) { if (r) xcd_barrier(bar); pg8::gemm_phase<EpiOutProj, DenseOrder, false, true, true, false>(F.lds, D, S, E); }
    } xcd_barrier(bar);
    if (IN(7)) { ph7(F); } xcd_barrier(bar);
    if (IN(9)) {
        moe_tables(F);
        MoeOrder S; S.tab = (const LAS int*)F.MISC; S.NT = 16; S.G = F.G; S.c = blockIdx.x; S.nwg = __builtin_amdgcn_readfirstlane((int)F.MISC[16 + NE]) * 16; S.A = (const char*)F.XN2; S.Bt = (const char*)F.WGU; S.STOK = F.STOK;
        S.bstep_e = (size_t)4096 * D; S.tstep = (size_t)256 * D; S.gather = true;
        EpiGU E{F.H, F.b_gate, F.b_up};
        for (int r = 0; r < NREP(9); ++r) { if (r) xcd_barrier(bar); pg8::gemm_phase<EpiGU, MoeOrder, true, true, true, true, true>(F.lds, D / 2, S, E); }
    } xcd_barrier(bar);
    if (IN(10)) {
        MoeOrder S; S.tab = (const LAS int*)F.MISC; S.NT = 8; S.G = F.G; S.c = blockIdx.x; S.nwg = __builtin_amdgcn_readfirstlane((int)F.MISC[16 + NE]) * 8; S.A = (const char*)F.H; S.Bt = (const char*)F.WDN; S.STOK = F.STOK;
        S.bstep_e = (size_t)D * FF; S.tstep = (size_t)256 * FF; S.gather = false;
        EpiDown E{F.O, F.b_down, F.SLW, (const LAS int*)F.MISC + 128};
        for (int r = 0; r < NREP(10); ++r) { if (r) xcd_barrier(bar); pg8::gemm_phase<EpiDown, MoeOrder, false, true, true, true>(F.lds, FF / 2, S, E); }
    } xcd_barrier(bar);
    if (IN(11)) { ph11(F); }
#undef IN
#undef REP
}

extern "C" void kernel_launch(void* const* d_in, const int* in_sizes, int n_in, void* d_out, int out_size, void* d_ws, size_t ws_size, hipStream_t stream) {
    static int grid = 0;
    if (grid == 0) {
        if (n_in != 29 || in_sizes[0] != T * D || out_size != T * D || ws_size < WS_END) { fprintf(stderr, "kernel_launch: unexpected shapes (n_in %d, in0 %d, out %d, ws %zu); nothing launched\n", n_in, n_in > 0 ? in_sizes[0] : -1, out_size, ws_size); grid = -1; return; }
        int dev = 0, cus = 0, per_cu = 0;
        if (hipGetDevice(&dev) != hipSuccess || hipDeviceGetAttribute(&cus, hipDeviceAttributeMultiprocessorCount, dev) != hipSuccess) { grid = -1; return; }
        if (hipFuncSetAttribute((const void*)fwd_kernel, hipFuncAttributeMaxDynamicSharedMemorySize, LDS_BYTES) != hipSuccess) { fprintf(stderr, "kernel_launch: hipFuncSetAttribute failed\n"); grid = -1; return; }
        if (hipOccupancyMaxActiveBlocksPerMultiprocessor(&per_cu, (const void*)fwd_kernel, 512, LDS_BYTES) != hipSuccess || per_cu < 1) fprintf(stderr, "kernel_launch: occupancy query reports %d\n", per_cu);
        (void)hipGetLastError();
        grid = cus;
    }
    if (grid < 0) return;
    (void)hipMemsetAsync((char*)d_ws + WS_CTL, 0, CTL_ZERO_BYTES, stream);
    Args a{};
    for (int i = 0; i < 29; ++i) a.in[i] = (const float*)d_in[i];
    a.out = (float*)d_out; a.ws = (unsigned char*)d_ws;
    a.ph_lo = 0; a.ph_hi = NPH; a.li = 0; a.pad = REPEAT_MASK ? 1 : 0; hipLaunchKernelGGL(fwd_kernel, dim3(grid), dim3(512), LDS_BYTES, stream, a);
}
```

```cpp
#include <hip/hip_runtime.h>
#include <cstdio>
#include <cstdint>
#include <type_traits>

#ifndef MK_N_LAUNCHES
#define MK_N_LAUNCHES 1
#endif

#define GAS __attribute__((address_space(1)))
#define LAS __attribute__((address_space(3)))
typedef unsigned short bf16_t;
typedef short bf16x8 __attribute__((ext_vector_type(8)));
typedef float f32x4 __attribute__((ext_vector_type(4)));
typedef float f32x2 __attribute__((ext_vector_type(2)));
typedef unsigned u32x4 __attribute__((ext_vector_type(4)));
typedef unsigned u32x2 __attribute__((ext_vector_type(2)));

constexpr int T = 16384, SEQ = 8192, D = 2048, DA = 1024, NIN = 5120, CTXL = 256, NCTX = 512, MROWS = T + NCTX;
constexpr int NE = 32, FF = 2048, CAP = 16384, HROWS = 73728;
constexpr int NCHUNK = 132;
constexpr float EPS = 1e-6f;
constexpr int NPH = 12;
constexpr int N_LAUNCHES = MK_N_LAUNCHES;
#ifndef REPEAT_MASK
#define REPEAT_MASK 0
#endif
#ifndef MK_NC8
#define MK_NC8 3
#endif
constexpr int NC8 = MK_NC8;

constexpr size_t MiB = 1u << 20;
constexpr size_t WS_CTL = 0, CTL_ZERO_BYTES = 1 * MiB;
constexpr size_t WS_MOD = 1 * MiB;
constexpr size_t WS_WG = 2 * MiB;
constexpr size_t WS_WIN = 4 * MiB;
constexpr size_t WS_WOUT = 24 * MiB;
constexpr size_t WS_AGG = 32 * MiB;
constexpr size_t WS_HIN = 38 * MiB;
constexpr size_t WS_ER = 40 * MiB;
constexpr size_t WS_STOK = 41 * MiB;
constexpr size_t WS_SLW = 43 * MiB;
constexpr size_t WS_XN = 48 * MiB;
constexpr size_t WS_G = 116 * MiB;
constexpr size_t WS_XA = 148 * MiB;
constexpr size_t WS_BB = 182 * MiB;
constexpr size_t WS_P = 214 * MiB;
constexpr size_t WS_Y = 246 * MiB;
constexpr size_t WS_WGU = 320 * MiB;
constexpr size_t WS_WDN = 832 * MiB;
constexpr size_t WS_H = 1088 * MiB;
constexpr size_t WS_O = 1376 * MiB;
constexpr size_t WS_HS = 1664 * MiB;
constexpr size_t WS_XN2 = 1696 * MiB;
constexpr size_t WS_END = 1728 * MiB;
constexpr int CW_CNT = 64;
constexpr int CW_BAR = 4096;
constexpr int CW_BARM = 8192;
constexpr int CW_Q0 = 96;
constexpr int CW_QCV6 = 224;
constexpr int CW_QCV = 160;

constexpr int LDS_BYTES = 155648;
constexpr int MISC_OFF = 154624;

__device__ __forceinline__ unsigned cvt_pk_bf16(float lo, float hi) { unsigned r; asm volatile("v_cvt_pk_bf16_f32 %0, %1, %2" : "=v"(r) : "v"(lo), "v"(hi)); return r; }
constexpr float X6_SCALE = 1.5f, GU_INV = 1.0f / 96.0f;
constexpr float W8_SCALE = 64.0f, W8_INV = 1.0f / 64.0f, O8_SCALE = 16.0f, O8_INV = 1.0f / 16.0f;
__device__ __forceinline__ unsigned pk4_fp8(float a, float b, float c, float d) { int w = 0; w = __builtin_amdgcn_cvt_pk_fp8_f32(a, b, w, false); w = __builtin_amdgcn_cvt_pk_fp8_f32(c, d, w, true); return (unsigned)w; }
__device__ __forceinline__ float bf_lo(unsigned w) { return __uint_as_float(w << 16); }
__device__ __forceinline__ float bf_hi(unsigned w) { return __uint_as_float(w & 0xffff0000u); }
__device__ __forceinline__ float fexp(float x) { return __builtin_amdgcn_exp2f(x * 1.44269504089f); }
__device__ __forceinline__ float fsigmoid(float x) { return __builtin_amdgcn_rcpf(1.0f + fexp(-x)); }
__device__ __forceinline__ float gelu_tanh(float x) { const float u = 0.7978845608028654f * (x + 0.044715f * x * x * x); return x * __builtin_amdgcn_rcpf(1.0f + fexp(-2.0f * u)); }
__device__ __forceinline__ float one_minus_exp(float u) { const float ser = -u * (1.0f + 0.5f * u * (1.0f + (1.0f / 3.0f) * u * (1.0f + 0.25f * u))); const float dir = 1.0f - fexp(u); return u > -0.05f ? ser : dir; }
__device__ __forceinline__ void gate_pair(float xr, float xi, float cf, float xc, float& a_out, float& b_out) {
    const float er = 1.0f + fexp(-fmaxf(xr, -30.0f)), ei = 1.0f + fexp(-fmaxf(xi, -30.0f)), inv = __builtin_amdgcn_rcpf(er * ei);
    const float r = inv * ei, ig = inv * er, la = cf * r, a = fexp(la), u = 2.0f * la;
    const float ser = -u * (1.0f + 0.5f * u * (1.0f + (1.0f / 3.0f) * u * (1.0f + 0.25f * u))), dir = 1.0f - a * a;
    a_out = a; b_out = __builtin_amdgcn_sqrtf(u > -0.05f ? ser : dir) * ig * xc;
}
__device__ __forceinline__ float wave_sum(float v) {
#pragma unroll
    for (int o = 1; o < 64; o <<= 1) v += __shfl_xor(v, o);
    return v;
}
__device__ __forceinline__ void unpack8(const u32x4 w, float (&f)[8]) { f[0] = bf_lo(w.x); f[1] = bf_hi(w.x); f[2] = bf_lo(w.y); f[3] = bf_hi(w.y); f[4] = bf_lo(w.z); f[5] = bf_hi(w.z); f[6] = bf_lo(w.w); f[7] = bf_hi(w.w); }

namespace pg8 {
#define PG8_LAS __attribute__((address_space(3)))
constexpr int BM = 256, BK = 64, HALF = 128, HTB = HALF * BK * 2, STAGE_BYTES = 8 * HTB, NXCD = 8, WGM = 8;
__host__ __device__ __forceinline__ int lds_byte(int r, int c) { const int cb = c * 2; return r * 128 + ((((cb >> 4) ^ (r & 7)) & 7) << 4) + (cb & 15); }
__host__ __device__ __forceinline__ void stage_rc(int b, int& R, int& C) { R = b >> 7; C = (((((b >> 4) & 7) ^ (R & 7)) << 4) + (b & 15)) / 2; }
__host__ __device__ __forceinline__ int perm32(int rho) { const int n = rho >> 4, i = rho & 15; return 8 * (i >> 2) + 4 * n + (i & 3); }

struct Unit { int pm, pn, e, mt; };

__device__ __forceinline__ int xcd_remap(int L, int nwg) { const int q = nwg / NXCD, r = nwg % NXCD, xcd = L % NXCD, off = L / NXCD; return (xcd < r ? xcd * (q + 1) : r * (q + 1) + (xcd - r) * q) + off; }

typedef int i32x4 __attribute__((ext_vector_type(4)));
typedef int i32x8 __attribute__((ext_vector_type(8)));
__device__ __forceinline__ i32x8 cat8(const bf16x8 a, const bf16x8 b) { return __builtin_shufflevector(__builtin_bit_cast(i32x4, a), __builtin_bit_cast(i32x4, b), 0, 1, 2, 3, 4, 5, 6, 7); }
__device__ __forceinline__ void mfma_fp8(f32x4& acc, const i32x8 a, const i32x8 b, const int sc) {
    (void)sc; asm volatile("v_mfma_f32_16x16x128_f8f6f4 %0, %1, %2, %0" : "+v"(acc) : "v"(a), "v"(b)); }
typedef int i32x6 __attribute__((ext_vector_type(6)));
typedef int i32x2 __attribute__((ext_vector_type(2)));
__device__ __forceinline__ void mfma_fp6(f32x4& acc, const i32x6 a, const i32x6 b) { asm volatile("v_mfma_f32_16x16x128_f8f6f4 %0, %1, %2, %0 cbsz:2 blgp:2" : "+v"(acc) : "v"(a), "v"(b)); }
__device__ __forceinline__ i32x6 cat6(const bf16x8 a, const i32x2 b) { return __builtin_shufflevector(__builtin_bit_cast(i32x4, a), __builtin_shufflevector(b, b, 0, 1, -1, -1), 0, 1, 2, 3, 4, 5); }
template <int OFF> __device__ __forceinline__ i32x2 lds_rd64(const PG8_LAS unsigned char* p) { i32x2 r; asm volatile("ds_read_b64 %0, %1 offset:%2" : "=v"(r) : "v"(p), "n"(OFF)); return r; }
template <class Epi, class Sched, bool GATHER, bool ALIGN_EPI, bool SP2, bool FP8, bool FP6 = false>
__device__ __forceinline__ void gemm_phase(PG8_LAS unsigned char* lds, const int K, const Sched& S, const Epi& E) {
    int tid = threadIdx.x; asm volatile("" : "+v"(tid));
    const int wid = __builtin_amdgcn_readfirstlane(tid >> 6), lane = tid & 63, wr = wid >> 2, wc = wid & 3, fr = lane & 15, fq = lane >> 4;
    const int nt = K / BK;
    int Rr[2], Cc[2]; unsigned voffB[2]; unsigned vAc[2][2], vAn[2][2];
#pragma unroll
    for (int i = 0; i < 2; ++i) { stage_rc(tid * 16 + i * 8192, Rr[i], Cc[i]); const int Rb = Epi::PERM ? ((Rr[i] & ~31) + perm32(Rr[i] & 31)) : Rr[i];
        voffB[i] = (unsigned)(Rb * K + Cc[i]) * 2u; }
    const size_t kstep = (size_t)(BK * 2);
    const size_t hstep = (size_t)HALF * K * 2;
    const unsigned ldsw = (unsigned)wid * 1024u;
    const int aoff = lds_byte(wr * 64 + fr, fq * 8), boff = lds_byte(wc * 32 + fr, fq * 8), aoff1 = lds_byte(wr * 64 + fr, 32 + fq * 8), boff1 = lds_byte(wc * 32 + fr, 32 + fq * 8);
    const int dup8 = 8 * ((fr >> 3) & 1);
#define PG8_SA(b, h) (((b) * 2 + (h)) * HTB)
#define PG8_SB(b, h) ((4 + (b) * 2 + (h)) * HTB)
#define PG8_STAGE(bufoff, gbase, voff) do { _Pragma("unroll") for (int _i = 0; _i < 2; ++_i) \
        __builtin_amdgcn_global_load_lds((const unsigned*)((const char*)(gbase) + (voff)[_i]), (PG8_LAS unsigned*)(lds + (bufoff) + ldsw + _i * 8192), 16, 0, 0); } while (0)
#define PG8_STAGE_A(bufoff, gbase, VO, h) do { if constexpr (GATHER) { PG8_STAGE(bufoff, gbase, (VO)[h]); } else { PG8_STAGE(bufoff, (gbase) + (h) * hstep, (VO)[0]); } } while (0)
#define PG8_LDA(dst, b, h) do { _Pragma("unroll") for (int m = 0; m < 4; ++m) dst[m] = *(const PG8_LAS bf16x8*)(lds + PG8_SA(b, h) + aoff + m * 2048); \
        if constexpr (FP6) { dst##2[0] = rd2<PG8_SA(b, h)>(lds + aoff1 + dup8); dst##2[1] = rd2<PG8_SA(b, h) + 2048>(lds + aoff1 + dup8); dst##2[2] = rd2<PG8_SA(b, h) + 4096>(lds + aoff1 + dup8); dst##2[3] = rd2<PG8_SA(b, h) + 6144>(lds + aoff1 + dup8); } \
        else { _Pragma("unroll") for (int m = 0; m < 4; ++m) dst##2[m] = rd2v(lds + PG8_SA(b, h) + aoff1 + m * 2048); } } while (0)
#define PG8_LDB(dst, b, h) do { _Pragma("unroll") for (int n = 0; n < 2; ++n) dst[n] = *(const PG8_LAS bf16x8*)(lds + PG8_SB(b, h) + boff + n * 2048); \
        if constexpr (FP6) { dst##2[0] = rd2<PG8_SB(b, h) - 65536>(lds + 65536 + boff1 + dup8); dst##2[1] = rd2<PG8_SB(b, h) - 65536 + 2048>(lds + 65536 + boff1 + dup8); } \
        else { _Pragma("unroll") for (int n = 0; n < 2; ++n) dst##2[n] = rd2v(lds + PG8_SB(b, h) + boff1 + n * 2048); } } while (0)
#define PG8_MMA(ai, bj, At, Bt) do { __builtin_amdgcn_s_setprio(1); _Pragma("unroll") for (int m = 0; m < 4; ++m) _Pragma("unroll") for (int n = 0; n < 2; ++n) { \
        if constexpr (FP6) mfma_fp6(acc[ai][bj][m][n], cat6(Bt[n], Bt##2[n]), cat6(At[m], At##2[m])); \
        else if constexpr (FP8) mfma_fp8(acc[ai][bj][m][n], cat8(Bt[n], Bt##2[n]), cat8(At[m], At##2[m]), sc1); \
        else { acc[ai][bj][m][n] = __builtin_amdgcn_mfma_f32_16x16x32_bf16(Bt[n], At[m], acc[ai][bj][m][n], 0, 0, 0); acc[ai][bj][m][n] = __builtin_amdgcn_mfma_f32_16x16x32_bf16(Bt##2[n], At##2[m], acc[ai][bj][m][n], 0, 0, 0); } } __builtin_amdgcn_s_setprio(0); } while (0)
#define PG8_WAIT_V(n) asm volatile("s_waitcnt vmcnt(" #n ")" ::: "memory")
#define PG8_WAIT_L(n) asm volatile("s_waitcnt lgkmcnt(" #n ")" ::: "memory")
#define PG8_BAR __builtin_amdgcn_s_barrier()
#define PG8_SCHED __builtin_amdgcn_sched_barrier(0)
    int sc1 = 0x7F7F7F7F; asm volatile("" : "+v"(sc1));
    Unit cur, nxt; int ui = 0;
    if (!S.next(0, cur)) return;
    f32x4 acc[2][2][4][2];
#pragma unroll
    for (int a = 0; a < 2; ++a)
#pragma unroll
        for (int b = 0; b < 2; ++b)
#pragma unroll
            for (int m = 0; m < 4; ++m)
#pragma unroll
                for (int n = 0; n < 2; ++n) acc[a][b][m][n] = (f32x4){0.f, 0.f, 0.f, 0.f};
    using S2 = typename std::conditional<FP6, i32x2, bf16x8>::type;
    auto rd2v = [](const PG8_LAS unsigned char* p) -> S2 { return *(const PG8_LAS S2*)p; };
#define rd2 lds_rd64
    bf16x8 At[4], B0[2], B1[2]; S2 At2[4], B02[2], B12[2];
    const char* cA = S.a_base(cur); const char* cB = S.b_base(cur);
#pragma unroll
    for (int h = 0; h < 2; ++h)
#pragma unroll
        for (int i = 0; i < 2; ++i) { if constexpr (GATHER) vAc[h][i] = S.gather_off(cur, Rr[i] + HALF * h) + (unsigned)Cc[i] * 2u; else vAc[h][i] = (unsigned)(Rr[i] * K + Cc[i]) * 2u; vAn[h][i] = vAc[h][i]; }
    if constexpr (SP2) {
        PG8_STAGE(PG8_SB(0, 0), cB, voffB); PG8_STAGE(PG8_SB(0, 1), cB + hstep, voffB); PG8_STAGE_A(PG8_SA(0, 0), cA, vAc, 0); PG8_STAGE_A(PG8_SA(0, 1), cA, vAc, 1);
        if (wr == 1) PG8_BAR;
        PG8_WAIT_V(2); PG8_BAR;
        PG8_STAGE(PG8_SB(1, 0), cB + kstep, voffB); PG8_STAGE_A(PG8_SA(1, 0), cA + kstep, vAc, 0); PG8_STAGE(PG8_SB(1, 1), cB + hstep + kstep, voffB);
        PG8_WAIT_V(6); PG8_BAR;
    } else {
        PG8_STAGE(PG8_SB(0, 0), cB, voffB); PG8_STAGE_A(PG8_SA(0, 0), cA, vAc, 0); PG8_STAGE(PG8_SB(0, 1), cB + hstep, voffB); PG8_STAGE_A(PG8_SA(0, 1), cA, vAc, 1);
        if (wr == 1) PG8_BAR;
        PG8_WAIT_V(4); PG8_BAR;
        PG8_STAGE(PG8_SB(1, 0), cB + kstep, voffB); PG8_STAGE_A(PG8_SA(1, 0), cA + kstep, vAc, 0); PG8_STAGE(PG8_SB(1, 1), cB + hstep + kstep, voffB);
        PG8_WAIT_V(6); PG8_BAR;
    }
    for (;;) {
        const bool has_next = S.next(ui + 1, nxt);
        const char* nA = has_next ? S.a_base(nxt) : cA; const char* nB = has_next ? S.b_base(nxt) : cB;
        if constexpr (Epi::TAB_N > 0) { if (wid < Epi::TAB_N / 64) __builtin_amdgcn_global_load_lds((const unsigned*)E.tab_src(cur, tid), (PG8_LAS unsigned*)(lds + STAGE_BYTES + 1024 + (ui & 1) * 2048 + wid * 256), 4, 0, 0); }
        if constexpr (GATHER) { if (has_next && wid < 4) __builtin_amdgcn_global_load_lds((const unsigned*)S.tok_src(nxt, tid), (PG8_LAS unsigned*)(lds + STAGE_BYTES + wid * 256), 4, 0, 0); }
        for (int t = 0; t < nt; t += 2) {
            const bool last = (t == nt - 2);
            const char* a1 = cA + (size_t)(t + 1) * kstep;
            const char* a2 = last ? nA : cA + (size_t)(t + 2) * kstep; const char* b2 = last ? nB : cB + (size_t)(t + 2) * kstep;
            const char* a3 = a2 + kstep; const char* b3 = b2 + kstep;
            if constexpr (GATHER) { if (last && has_next) {
#pragma unroll
                for (int h = 0; h < 2; ++h)
#pragma unroll
                    for (int i = 0; i < 2; ++i) vAn[h][i] = *(const PG8_LAS unsigned*)(lds + STAGE_BYTES + 4 * (Rr[i] + HALF * h)) * (unsigned)(K * 2) + (unsigned)Cc[i] * 2u; } }
            unsigned v2[2][2];
#pragma unroll
            for (int h = 0; h < 2; ++h)
#pragma unroll
                for (int i = 0; i < 2; ++i) v2[h][i] = GATHER ? (last ? vAn[h][i] : vAc[h][i]) : vAc[0][i];
            if constexpr (SP2) {
            PG8_LDB(B0, 0, 0); PG8_LDB(B1, 0, 1); PG8_SCHED; PG8_LDA(At, 0, 0); PG8_STAGE_A(PG8_SA(1, 1), a1, vAc, 1);
            PG8_WAIT_V(8); PG8_WAIT_L(0); PG8_BAR; PG8_MMA(0, 0, At, B0); PG8_MMA(0, 1, At, B1); PG8_BAR; PG8_SCHED;
            PG8_LDA(At, 0, 1); PG8_STAGE(PG8_SB(0, 0), b2, voffB); PG8_STAGE(PG8_SB(0, 1), b2 + hstep, voffB); PG8_STAGE_A(PG8_SA(0, 0), a2, v2, 0);
            PG8_WAIT_V(8); PG8_WAIT_L(0); PG8_BAR; PG8_MMA(1, 0, At, B0); PG8_MMA(1, 1, At, B1); PG8_BAR; PG8_SCHED;
            PG8_LDB(B0, 1, 0); PG8_LDB(B1, 1, 1); PG8_SCHED; PG8_LDA(At, 1, 0); PG8_STAGE_A(PG8_SA(0, 1), a2, v2, 1);
            PG8_WAIT_V(8); PG8_WAIT_L(0); PG8_BAR; PG8_MMA(0, 0, At, B0); PG8_MMA(0, 1, At, B1); PG8_BAR; PG8_SCHED;
            PG8_LDA(At, 1, 1); PG8_STAGE(PG8_SB(1, 0), b3, voffB); PG8_STAGE(PG8_SB(1, 1), b3 + hstep, voffB); PG8_STAGE_A(PG8_SA(1, 0), a3, v2, 0);
            PG8_WAIT_V(8); PG8_WAIT_L(0); PG8_BAR; PG8_MMA(1, 0, At, B0); PG8_MMA(1, 1, At, B1); PG8_BAR; PG8_SCHED;
            } else {
            PG8_LDB(B0, 0, 0); PG8_SCHED; PG8_LDA(At, 0, 0); PG8_STAGE_A(PG8_SA(1, 1), a1, vAc, 1);
            PG8_WAIT_L(8); PG8_BAR; PG8_WAIT_L(0); PG8_MMA(0, 0, At, B0); PG8_BAR; PG8_SCHED;
            PG8_LDB(B1, 0, 1); PG8_STAGE(PG8_SB(0, 0), b2, voffB);
            PG8_BAR; PG8_WAIT_L(0); PG8_MMA(0, 1, At, B1); PG8_BAR;
            PG8_LDA(At, 0, 1); PG8_STAGE_A(PG8_SA(0, 0), a2, v2, 0);
            PG8_BAR; PG8_WAIT_L(0); PG8_MMA(1, 0, At, B0); PG8_BAR; PG8_SCHED;
            PG8_STAGE(PG8_SB(0, 1), b2 + hstep, voffB);
            PG8_WAIT_V(6); PG8_BAR; PG8_MMA(1, 1, At, B1); PG8_BAR;
            PG8_LDB(B0, 1, 0); PG8_SCHED; PG8_LDA(At, 1, 0); PG8_STAGE_A(PG8_SA(0, 1), a2, v2, 1);
            PG8_WAIT_L(8); PG8_BAR; PG8_WAIT_L(0); PG8_MMA(0, 0, At, B0); PG8_BAR; PG8_SCHED;
            PG8_LDB(B1, 1, 1); PG8_STAGE(PG8_SB(1, 0), b3, voffB);
            PG8_BAR; PG8_WAIT_L(0); PG8_MMA(0, 1, At, B1); PG8_BAR;
            PG8_LDA(At, 1, 1); PG8_STAGE_A(PG8_SA(1, 0), a3, v2, 0);
            PG8_BAR; PG8_WAIT_L(0); PG8_MMA(1, 0, At, B0); PG8_BAR; PG8_SCHED;
            PG8_STAGE(PG8_SB(1, 1), b3 + hstep, voffB);
            PG8_WAIT_V(6); PG8_BAR; PG8_MMA(1, 1, At, B1); PG8_BAR;
            }
        }
        if constexpr (ALIGN_EPI) { if (wr == 0) PG8_BAR; }
        if constexpr (FP8) asm volatile("s_nop 15\n\ts_nop 15" ::: "memory");
        E(acc, cur, wr, wc, fr, fq, (const PG8_LAS float*)(lds + STAGE_BYTES + 1024 + (ui & 1) * 2048));
        if (!has_next) break;
#pragma unroll
        for (int a = 0; a < 2; ++a)
#pragma unroll
            for (int b = 0; b < 2; ++b)
#pragma unroll
                for (int m = 0; m < 4; ++m)
#pragma unroll
                    for (int n = 0; n < 2; ++n) acc[a][b][m][n] = (f32x4){0.f, 0.f, 0.f, 0.f};
        cur = nxt; cA = nA; cB = nB; ++ui;
#pragma unroll
        for (int h = 0; h < 2; ++h)
#pragma unroll
            for (int i = 0; i < 2; ++i) vAc[h][i] = vAn[h][i];
        if constexpr (ALIGN_EPI) { if (wr == 1) PG8_BAR; }
    }
    PG8_WAIT_V(0);
    if constexpr (!ALIGN_EPI) { if (wr == 0) PG8_BAR; }
    PG8_BAR;
#undef rd2
#undef PG8_SA
#undef PG8_SB
#undef PG8_STAGE
#undef PG8_STAGE_A
#undef PG8_LDA
#undef PG8_LDB
#undef PG8_MMA
#undef PG8_WAIT_V
#undef PG8_WAIT_L
#undef PG8_BAR
#undef PG8_SCHED
}
}

#define XB_TMO      128
#define XB_XCNT(j)  (256  + 64 * (j))
#define XB_XSUB(j)  (1280 + 64 * (j))
#define XB_XGEN(j)  (2304 + 64 * (j))
#define XB_TOP      3328
#define XB_TOPGEN   3392
#define XCD_BAR_WORDS 3456
#define XB_SPIN_CAP (1u << 18)
__device__ __forceinline__ unsigned xb_ld(unsigned* p)              { return __hip_atomic_load(p, __ATOMIC_RELAXED, __HIP_MEMORY_SCOPE_AGENT); }
__device__ __forceinline__ unsigned xb_add(unsigned* p, unsigned v) { return __hip_atomic_fetch_add(p, v, __ATOMIC_RELAXED, __HIP_MEMORY_SCOPE_AGENT); }
__device__ __forceinline__ unsigned xb_xcc_id() { return (unsigned)__builtin_amdgcn_s_getreg((3 << 11) | 20) & 0xFu; }
#define XB_SPIN(cond, bar) do { unsigned _sp = 0; while (cond) { __builtin_amdgcn_s_sleep(1); \
    if ((++_sp & 255u) == 0u) { if (xb_ld(&(bar)[XB_TMO])) break; if (_sp > XB_SPIN_CAP) { atomicAdd(&(bar)[XB_TMO], 1u); break; } } } } while (0)
struct XcdBarrier { unsigned* bar; unsigned x; volatile LAS unsigned* st; unsigned expect; };
__device__ __forceinline__ XcdBarrier xcd_barrier_post(unsigned* bar, volatile LAS unsigned* st, unsigned expect, bool member) {
    XcdBarrier b; b.bar = bar; b.x = xb_xcc_id(); b.st = st; b.expect = expect;
    if (member && threadIdx.x == 0) (void)xb_add(&bar[XB_XCNT(b.x)], 1u);
    return b;
}
__device__ __forceinline__ void xcd_barrier_complete(unsigned* bar, unsigned x, unsigned G, unsigned& nloc, unsigned& nx) {
    unsigned sum, cnt, mine, sp = 0u;
    for (;;) {
        sum = 0u; cnt = 0u; mine = 0u;
#pragma unroll
        for (unsigned j = 0; j < 16; ++j) { const unsigned c = xb_ld(&bar[XB_XCNT(j)]); sum += c; cnt += (c > 0u) ? 1u : 0u; mine = (j == x) ? c : mine; }
        if (sum == G) break;
        __builtin_amdgcn_s_sleep(1);
        if ((++sp & 255u) == 0u) { if (xb_ld(&bar[XB_TMO])) break; if (sp > XB_SPIN_CAP) { atomicAdd(&bar[XB_TMO], 1u); break; } }
    }
    nloc = mine > 0u ? mine : 1u; nx = cnt > 0u ? cnt : 1u;
}
__device__ __forceinline__ void xcd_barrier(const XcdBarrier& b) {
    asm volatile("s_waitcnt vmcnt(0)" ::: "memory");
    __syncthreads();
    if (threadIdx.x == 0) {
        unsigned* bar = b.bar;
        __builtin_amdgcn_s_waitcnt(0);
        unsigned nloc = b.st[0], nx = b.st[1];
        if (nloc == 0u) { xcd_barrier_complete(bar, b.x, b.expect, nloc, nx); b.st[0] = nloc; b.st[1] = nx; }
        const unsigned old = xb_add(&bar[XB_XSUB(b.x)], 1u);
        const unsigned gen = old / nloc;
        if (old + 1u == (gen + 1u) * nloc) {
            __builtin_amdgcn_fence(__ATOMIC_RELEASE, "agent");
            asm volatile("s_waitcnt vmcnt(0)" ::: "memory");
            const unsigned og = xb_add(&bar[XB_TOP], 1u);
            const unsigned tg = og / nx;
            if (og + 1u == (tg + 1u) * nx) xb_add(&bar[XB_TOPGEN], 1u);
            else XB_SPIN(xb_ld(&bar[XB_TOPGEN]) == tg, bar);
            __builtin_amdgcn_fence(__ATOMIC_ACQUIRE, "agent");
            xb_add(&bar[XB_XGEN(b.x)], 1u);
            asm volatile("s_waitcnt vmcnt(0)" ::: "memory");
        } else {
            XB_SPIN(xb_ld(&bar[XB_XGEN(b.x)]) == gen, bar);
            __builtin_amdgcn_fence(__ATOMIC_ACQUIRE, "agent");
            asm volatile("s_waitcnt vmcnt(0)" ::: "memory");
        }
    }
    __syncthreads();
}

struct Frame {
    LAS unsigned char* lds;
    volatile LAS unsigned* MISC;
    unsigned* ctl;
    int tid, lane, wave, G;
    int bid, nb;
    const float *x, *c, *ctx, *c_ctx, *w_mod, *b_mod, *g_mix, *w_in, *conv_a_w, *conv_a_b, *lru_w_r, *lru_b_r, *lru_w_i, *lru_b_i, *lru_lam, *conv_b_w, *g_out_a, *g_out_b, *w_out,
        *g_ffn, *w_router, *b_router, *w_gate, *b_gate, *w_up, *b_up, *w_down, *b_down, *g_final;
    float* out;
    float* MOD; bf16_t *WG, *WIN, *WOUT, *XN, *Gb, *XA, *BB, *P, *Y, *WGU, *WDN, *H, *O, *HS;
    f32x2* AGG; float* HIN; unsigned* ER; int* STOK; float* SLW; unsigned* CNT; unsigned char* XN2;
};

struct EpiInProj {
    static constexpr bool PERM = true; static constexpr int TAB_N = 0;
    __device__ __forceinline__ const float* tab_src(const pg8::Unit&, int) const { return nullptr; }
    unsigned char* ws; bf16_t* P;
    __device__ __forceinline__ void operator()(const f32x4 (&acc)[2][2][4][2], const pg8::Unit& u, int wr, int wc, int fr, int fq, const LAS float* tab) const {
        const int row0 = u.pm * 256 + wr * 64 + fr, cl = wc * 32 + 8 * fq, pn = u.pn;
        if (pn < 12) {
            const size_t woff = pn < 4 ? WS_G : (pn < 8 ? WS_XA : WS_BB); bf16_t* dst = (bf16_t*)(ws + woff); const int colt = (pn & 3) * 256;
#pragma unroll
            for (int ai = 0; ai < 2; ++ai)
#pragma unroll
                for (int m = 0; m < 4; ++m) { bf16_t* rowp = dst + (size_t)(row0 + ai * 128 + m * 16) * DA + colt + cl;
#pragma unroll
                    for (int bj = 0; bj < 2; ++bj) { f32x4 v0 = acc[ai][bj][m][0], v1 = acc[ai][bj][m][1];
                        if (pn < 4) {
#pragma unroll
                            for (int j = 0; j < 4; ++j) { v0[j] = gelu_tanh(v0[j]); v1[j] = gelu_tanh(v1[j]); } }
                        u32x4 w; w.x = cvt_pk_bf16(v0[0], v0[1]); w.y = cvt_pk_bf16(v0[2], v0[3]); w.z = cvt_pk_bf16(v1[0], v1[1]); w.w = cvt_pk_bf16(v1[2], v1[3]);
                        *(u32x4*)(rowp + bj * 128) = w; } }
        } else {
            const int j = pn - 12;
#pragma unroll
            for (int ai = 0; ai < 2; ++ai)
#pragma unroll
                for (int m = 0; m < 4; ++m) { bf16_t* rowp = P + (size_t)(row0 + ai * 128 + m * 16) * DA + j * 128 + cl;
                    const f32x4 v0 = acc[ai][0][m][0] * acc[ai][1][m][0], v1 = acc[ai][0][m][1] * acc[ai][1][m][1];
                    u32x4 w; w.x = cvt_pk_bf16(v0[0], v0[1]); w.y = cvt_pk_bf16(v0[2], v0[3]); w.z = cvt_pk_bf16(v1[0], v1[1]); w.w = cvt_pk_bf16(v1[2], v1[3]);
                    *(u32x4*)rowp = w; }
        }
    }
};
struct EpiOutProj {
    static constexpr bool PERM = true; static constexpr int TAB_N = 0;
    __device__ __forceinline__ const float* tab_src(const pg8::Unit&, int) const { return nullptr; }
    bf16_t* MX; const float* MOD;
    __device__ __forceinline__ void operator()(const f32x4 (&acc)[2][2][4][2], const pg8::Unit& u, int wr, int wc, int fr, int fq, const LAS float* tab) const {
        const int row0 = u.pm * 256 + wr * 64 + fr, col0 = u.pn * 256 + wc * 32 + 8 * fq, b = u.pm >> 5;
        f32x4 gt[2][2];
#pragma unroll
        for (int bj = 0; bj < 2; ++bj)
#pragma unroll
            for (int n = 0; n < 2; ++n) gt[bj][n] = *(const f32x4*)(MOD + b * 12288 + 4096 + col0 + bj * 128 + 4 * n);
#pragma unroll
        for (int ai = 0; ai < 2; ++ai)
#pragma unroll
            for (int m = 0; m < 4; ++m) { bf16_t* rowp = MX + (size_t)(row0 + ai * 128 + m * 16) * D + col0;
#pragma unroll
                for (int bj = 0; bj < 2; ++bj) { const f32x4 v0 = gt[bj][0] * acc[ai][bj][m][0], v1 = gt[bj][1] * acc[ai][bj][m][1];
                    u32x4 w; w.x = cvt_pk_bf16(v0[0], v0[1]); w.y = cvt_pk_bf16(v0[2], v0[3]); w.z = cvt_pk_bf16(v1[0], v1[1]); w.w = cvt_pk_bf16(v1[2], v1[3]);
                    *(u32x4*)(rowp + bj * 128) = w; } }
    }
};
struct EpiGU {
    static constexpr bool PERM = true; static constexpr int TAB_N = 256;
    bf16_t* H; const float *b_gate, *b_up;
    __device__ __forceinline__ const float* tab_src(const pg8::Unit& u, int t) const { return (t < 128 ? b_gate : b_up) + u.e * FF + u.pn * 128 + (t & 127); }
    __device__ __forceinline__ void operator()(const f32x4 (&acc)[2][2][4][2], const pg8::Unit& u, int wr, int wc, int fr, int fq, const LAS float* tab) const {
        const int row0 = u.pm * 256 + wr * 64 + fr, colg = u.pn * 128 + wc * 32 + 8 * fq;
        f32x4 bg[2], bu[2];
#pragma unroll
        for (int n = 0; n < 2; ++n) { bg[n] = *(const LAS f32x4*)(tab + wc * 32 + 8 * fq + 4 * n); bu[n] = *(const LAS f32x4*)(tab + 128 + wc * 32 + 8 * fq + 4 * n); }
#pragma unroll
        for (int ai = 0; ai < 2; ++ai)
#pragma unroll
            for (int m = 0; m < 4; ++m) { unsigned char* rowp = (unsigned char*)H + (size_t)(row0 + ai * 128 + m * 16) * FF + colg; f32x4 a[2];
#pragma unroll
                for (int n = 0; n < 2; ++n)
#pragma unroll
                    for (int j = 0; j < 4; j += 2) {
                        f32x2 g = (f32x2){acc[ai][0][m][n][j], acc[ai][0][m][n][j + 1]} * GU_INV + (f32x2){bg[n][j], bg[n][j + 1]};
                        f32x2 up = (f32x2){acc[ai][1][m][n][j], acc[ai][1][m][n][j + 1]} * GU_INV + (f32x2){bu[n][j], bu[n][j + 1]};
                        g.x = fminf(g.x, 7.0f); g.y = fminf(g.y, 7.0f); up.x = __builtin_amdgcn_fmed3f(up.x, -7.0f, 7.0f); up.y = __builtin_amdgcn_fmed3f(up.y, -7.0f, 7.0f);
                        const f32x2 t = g * (-1.702f * 1.44269504089f);
                        f32x2 d = (f32x2){__builtin_amdgcn_exp2f(t.x), __builtin_amdgcn_exp2f(t.y)} + 1.0f;
                        const f32x2 sg = {__builtin_amdgcn_rcpf(d.x), __builtin_amdgcn_rcpf(d.y)};
                        const f32x2 h = (up + 1.0f) * g * sg;
                        a[n][j] = h.x; a[n][j + 1] = h.y; }
                u32x2 w; w.x = pk4_fp8(a[0][0], a[0][1], a[0][2], a[0][3]); w.y = pk4_fp8(a[1][0], a[1][1], a[1][2], a[1][3]);
                *(u32x2*)rowp = w; }
    }
};
struct EpiDown {
    static constexpr bool PERM = true; static constexpr int TAB_N = 512;
    bf16_t* O; const float* b_down; const float* SLW; const LAS int* cnt;
    __device__ __forceinline__ const float* tab_src(const pg8::Unit& u, int t) const {
        if (t < 256) return b_down + u.e * D + u.pn * 256 + t;
        const int r = t - 256, nvalid = __builtin_amdgcn_readfirstlane(cnt[u.e]) - u.mt * 256; return SLW + (size_t)u.e * CAP + (r < nvalid ? u.mt * 256 + r : 0); }
    __device__ __forceinline__ void operator()(const f32x4 (&acc)[2][2][4][2], const pg8::Unit& u, int wr, int wc, int fr, int fq, const LAS float* tab) const {
        const int row0 = u.pm * 256 + wr * 64 + fr, cl = wc * 32 + 8 * fq, nvalid = __builtin_amdgcn_readfirstlane(cnt[u.e]) - u.mt * 256;
        f32x4 bd[2][2]; float wsl[2][4];
#pragma unroll
        for (int bj = 0; bj < 2; ++bj)
#pragma unroll
            for (int n = 0; n < 2; ++n) bd[bj][n] = *(const LAS f32x4*)(tab + bj * 128 + cl + 4 * n);
#pragma unroll
        for (int ai = 0; ai < 2; ++ai)
#pragma unroll
            for (int m = 0; m < 4; ++m) { const int r = ai * 128 + wr * 64 + m * 16 + fr; const float w = tab[256 + r]; wsl[ai][m] = r < nvalid ? w : 0.f; }
#pragma unroll
        for (int ai = 0; ai < 2; ++ai)
#pragma unroll
            for (int m = 0; m < 4; ++m) { const int r = ai * 128 + wr * 64 + m * 16 + fr; const float w8 = wsl[ai][m];
                unsigned char* rowp = (unsigned char*)O + (size_t)(row0 + ai * 128 + m * 16) * D + u.pn * 256 + cl;
#pragma unroll
                for (int bj = 0; bj < 2; ++bj) { const f32x4 v0 = (acc[ai][bj][m][0] * W8_INV + bd[bj][0]) * w8, v1 = (acc[ai][bj][m][1] * W8_INV + bd[bj][1]) * w8;
                    u32x2 w; w.x = pk4_fp8(v0[0] * O8_SCALE, v0[1] * O8_SCALE, v0[2] * O8_SCALE, v0[3] * O8_SCALE); w.y = pk4_fp8(v1[0] * O8_SCALE, v1[1] * O8_SCALE, v1[2] * O8_SCALE, v1[3] * O8_SCALE);
                    *(u32x2*)(rowp + bj * 128) = w; } }
    }
};

struct DenseOrder {
    int nM, nN, nwg, G, c, nX; const char *A, *Bt; size_t tstep;
    __device__ __forceinline__ bool next(int i, pg8::Unit& u) const {
        long L = (long)i * G + c; if (L >= nwg + nX) return false;
        u.e = 0; u.mt = 0;
        if (L < nX) { u.pm = 64 + (int)L / 4; u.pn = 4 + (int)L % 4; return true; }
        L -= nX;
        const int wgid = pg8::xcd_remap((int)L, nwg);
        const int nig = pg8::WGM * nN, gid = wgid / nig, fm = gid * pg8::WGM, gsz = (nM - fm) < pg8::WGM ? (nM - fm) : pg8::WGM;
        u.pm = fm + ((wgid % nig) % gsz); u.pn = (wgid % nig) / gsz; return true;
    }
    __device__ __forceinline__ const char* a_base(const pg8::Unit& u) const { return A + (size_t)u.pm * tstep; }
    __device__ __forceinline__ const char* b_base(const pg8::Unit& u) const { return Bt + (size_t)u.pn * tstep; }
    __device__ __forceinline__ unsigned gather_off(const pg8::Unit&, int) const { return 0u; }
    __device__ __forceinline__ const int* tok_src(const pg8::Unit&, int) const { return nullptr; }
};
struct MoeOrder {
    const LAS int* tab; int NT, G, c, nwg; const char *A, *Bt; const int* STOK; size_t bstep_e, tstep; bool gather;
    __device__ __forceinline__ bool next(int i, pg8::Unit& u) const {
        const int x = c & 7, npx = 4, ng = NT / npx, mgn = 8 / ng, ngroup = x % ng, mgroup = x / ng, nbx = (G - x + 7) >> 3, q = i * nbx + (c >> 3);
        const int til = q / npx, ti = til * mgn + mgroup; if (ti >= nwg / NT) return false;
        u.pn = ngroup * npx + (q - til * npx);
        const int sl = (int)(threadIdx.x & 63), pv = tab[17 + (sl < NE - 1 ? sl : NE - 2)];
        const int e = (int)__popcll(__ballot(sl < NE - 1 && ti >= pv));
        u.e = e; u.mt = ti - __builtin_amdgcn_readfirstlane(tab[16 + e]); u.pm = __builtin_amdgcn_readfirstlane(tab[64 + e]) + u.mt; return true;
    }
    __device__ __forceinline__ const char* a_base(const pg8::Unit& u) const { return gather ? A : A + (size_t)u.pm * tstep; }
    __device__ __forceinline__ const char* b_base(const pg8::Unit& u) const { return Bt + (size_t)u.e * bstep_e + (size_t)u.pn * tstep; }
    __device__ __forceinline__ const int* tok_src(const pg8::Unit& u, int row) const { const int idx = u.mt * 256 + row; return STOK + (size_t)u.e * CAP + (idx < __builtin_amdgcn_readfirstlane(tab[128 + u.e]) ? idx : 0); }
    __device__ __forceinline__ unsigned gather_off(const pg8::Unit& u, int row) const { return (unsigned)(*tok_src(u, row)) * (unsigned)D; }
};

__device__ __forceinline__ void transpose_item(const float* W, int K, int N, int k0, int n0, bf16_t* WT, int orow0, LAS float* scr, int lane) {
#pragma unroll 8
    for (int i = 0; i < 32; ++i) { const int kk = 2 * i + (lane >> 5); scr[kk * 33 + (lane & 31)] = W[(size_t)(k0 + kk) * N + n0 + (lane & 31)]; }
    asm volatile("s_waitcnt lgkmcnt(0)" ::: "memory");
    const int c = lane & 7;
#pragma unroll
    for (int j = 0; j < 4; ++j) { const int n = (lane >> 3) + 8 * j; const LAS float* s = scr + (8 * c) * 33 + n;
        u32x4 o; o.x = cvt_pk_bf16(s[0 * 33], s[1 * 33]); o.y = cvt_pk_bf16(s[2 * 33], s[3 * 33]); o.z = cvt_pk_bf16(s[4 * 33], s[5 * 33]); o.w = cvt_pk_bf16(s[6 * 33], s[7 * 33]);
        *(u32x4*)(WT + (size_t)(orow0 + n) * K + k0 + 8 * c) = o; }
    asm volatile("s_waitcnt lgkmcnt(0)" ::: "memory");
}

__device__ __forceinline__ void transpose_item_fp8(const float* W, int K, int N, int k0, int n0, unsigned char* WT, int orow0, LAS float* scr, int lane) {
#pragma unroll 8
    for (int i = 0; i < 64; ++i) { const int kk = 2 * i + (lane >> 5); scr[kk * 33 + (lane & 31)] = W[(size_t)(k0 + kk) * N + n0 + (lane & 31)]; }
    asm volatile("s_waitcnt lgkmcnt(0)" ::: "memory");
    const int c = lane & 7;
#pragma unroll
    for (int j = 0; j < 4; ++j) { const int n = (lane >> 3) + 8 * j; const LAS float* s = scr + (16 * c) * 33 + n;
        u32x4 o; o.x = pk4_fp8(s[0 * 33] * W8_SCALE, s[1 * 33] * W8_SCALE, s[2 * 33] * W8_SCALE, s[3 * 33] * W8_SCALE); o.y = pk4_fp8(s[4 * 33] * W8_SCALE, s[5 * 33] * W8_SCALE, s[6 * 33] * W8_SCALE, s[7 * 33] * W8_SCALE);
        o.z = pk4_fp8(s[8 * 33] * W8_SCALE, s[9 * 33] * W8_SCALE, s[10 * 33] * W8_SCALE, s[11 * 33] * W8_SCALE); o.w = pk4_fp8(s[12 * 33] * W8_SCALE, s[13 * 33] * W8_SCALE, s[14 * 33] * W8_SCALE, s[15 * 33] * W8_SCALE);
        *(u32x4*)(WT + (size_t)(orow0 + n) * K + k0 + 16 * c) = o; }
    asm volatile("s_waitcnt lgkmcnt(0)" ::: "memory");
}

__device__ __forceinline__ void ph0(Frame& F) {
    LAS float* sc = (LAS float*)(F.lds + 67584);
    LAS float* red = (LAS float*)(F.lds + 67584 + 24576);
    LAS float* scr = (LAS float*)(F.lds + F.wave * 8448);
    constexpr int I_IN = (D / 64) * (NIN / 32), I_OUT = (D / 64) * (D / 32), I_G = 32 * 8, NJOB = 128 + (I_IN + I_OUT + I_G) / 32;
    bool have_sc = false;
    for (;;) {
        __syncthreads();
        if (F.tid == 0) F.MISC[12] = atomicAdd(F.ctl + CW_Q0, 1u);
        __syncthreads();
        const int job = __builtin_amdgcn_readfirstlane((int)F.MISC[12]);
        if (job >= NJOB) break;
        if (job < 128) {
            if (!have_sc) { for (int idx = F.tid; idx < 3 * D; idx += 512) { const int r = idx >> 11, k = idx & 2047; const float v = r < 2 ? F.c[r * D + k] : F.c_ctx[k]; sc[idx] = v * fsigmoid(v); } have_sc = true; __syncthreads(); }
            const int cg = job, sub = F.lane / 24, c4 = F.lane % 24;
            f32x4 a0 = {0.f, 0.f, 0.f, 0.f}, a1 = a0, a2 = a0;
            if (F.lane < 48) {
                const float* wp = F.w_mod + (size_t)(F.wave * 2 + sub) * 12288 + cg * 96 + c4 * 4;
                for (int it = 0; it < 128; it += 8) {
                    f32x4 wv[8];
#pragma unroll
                    for (int u = 0; u < 8; ++u) wv[u] = __builtin_nontemporal_load((const f32x4*)(wp + (size_t)(it + u) * 16 * 12288));
#pragma unroll
                    for (int u = 0; u < 8; ++u) { const int k = (it + u) * 16 + F.wave * 2 + sub; a0 += sc[k] * wv[u]; a1 += sc[D + k] * wv[u]; a2 += sc[2 * D + k] * wv[u]; }
                }
                LAS float* rp = red + (F.wave * 2 + sub) * 288 + c4 * 4;
                *(LAS f32x4*)(rp) = a0; *(LAS f32x4*)(rp + 96) = a1; *(LAS f32x4*)(rp + 192) = a2;
            }
            __syncthreads();
            if (F.tid < 288) { const int r = F.tid / 96, cc = F.tid % 96; float s = F.b_mod[cg * 96 + cc];
#pragma unroll
                for (int p = 0; p < 16; ++p) s += red[p * 288 + r * 96 + cc];
                F.MOD[r * 12288 + cg * 96 + cc] = s; }
        } else {
#pragma unroll 1
            for (int q = 0; q < 4; ++q) {
                int r = (job - 128) * 32 + q * 8 + F.wave;
                if (r < I_IN) { const int nblk = NIN / 32, k0 = 64 * (r / nblk), n0 = 32 * (r % nblk); int orow0;
                    if (n0 < 3072) orow0 = n0; else if (n0 < 4096) { const int qq = n0 - 3072; orow0 = 3072 + (qq >> 7) * 256 + (qq & 127); } else { const int qq = n0 - 4096; orow0 = 3072 + (qq >> 7) * 256 + 128 + (qq & 127); }
                    transpose_item(F.w_in, D, NIN, k0, n0, F.WIN, orow0, scr, F.lane); continue; }
                r -= I_IN;
                if (r < I_OUT) { const int nblk = D / 32, k0 = 64 * (r / nblk), n0 = 32 * (r % nblk); transpose_item(F.w_out, D, D, k0, n0, F.WOUT, n0, scr, F.lane); continue; }
                r -= I_OUT;
                { const int mat = r >> 3, sub = r & 7, type = mat >> 4, dh = mat & 15; const int k0 = 64 * (sub >> 2), n0 = 32 * (sub & 3);
                  const float* W = (type ? F.lru_w_i : F.lru_w_r) + (size_t)dh * 16384; transpose_item(W, 128, 128, k0, n0, F.WG + (size_t)(type * 16 + dh) * 16384, n0, scr, F.lane); }
            }
        }
    }
}

struct CvItem { const GAS float* W; GAS unsigned char* WT; };
typedef float f32x16 __attribute__((ext_vector_type(16)));
typedef unsigned u32x6 __attribute__((ext_vector_type(6)));
constexpr int CV6_NSTRIP = 2 * 32 * 64, CV6_FQ_PITCH = 1040, CV6_TILE_BYTES = 4 * CV6_FQ_PITCH * 4;
__device__ __forceinline__ u32x6 cvt_fp6_32(const float (&v)[32], const float scale) {
    f32x16 p, q;
#pragma unroll
    for (int i = 0; i < 16; ++i) { p[i] = v[i] * scale; q[i] = v[16 + i] * scale; }
    return __builtin_amdgcn_cvt_scalef32_2xpk16_fp6_f32(p, q, 1.0f);
}
__device__ __forceinline__ CvItem cv6_decode(Frame& F, int strip, int kt) {
    const int which = strip >> 11, e = (strip >> 6) & 31, n0 = 32 * (strip & 63);
    const unsigned long long m0 = which == 0 ? ~0ull : 0ull;
    const unsigned long long wsel = ((unsigned long long)F.w_gate & m0) | ((unsigned long long)F.w_up & ~m0);
    const int orow0 = (n0 >> 7) * 256 + which * 128 + (n0 & 127);
    CvItem c; c.W = (const GAS float*)wsel + (size_t)e * D * FF + (size_t)(128 * kt) * 2048 + n0;
    c.WT = (GAS unsigned char*)F.WGU + (size_t)e * 4096 * D + (size_t)orow0 * 2048 + kt * 128;
    return c;
}
__device__ __forceinline__ void cv6_load(const CvItem& c, int lane, f32x4 (&v)[16]) {
    const GAS float* p = c.W + (size_t)(lane >> 3) * 2048 + 4 * (lane & 7);
#pragma unroll
    for (int i = 0; i < 16; ++i) v[i] = __builtin_nontemporal_load((const GAS f32x4*)(p + (size_t)(8 * i) * 2048));
}
__device__ __forceinline__ void cv6_store(const CvItem& c, int lane, const f32x4 (&v)[16], LAS float* scr) {
    const int r8 = lane >> 3, c4 = lane & 7;
    LAS float* wb = scr + (r8 >> 2) * 128 + 4 * c4 + (r8 & 3);
#pragma unroll
    for (int i = 0; i < 16; ++i)
#pragma unroll
        for (int nn = 0; nn < 4; ++nn) wb[(i >> 2) * CV6_FQ_PITCH + 2 * (i & 3) * 128 + 32 * nn] = v[i][nn];
    asm volatile("s_waitcnt lgkmcnt(0)" ::: "memory");
#pragma unroll
    for (int rd = 0; rd < 2; ++rd) {
        const int npp = 16 * rd + (lane >> 2), fq = lane & 3;
        const LAS float* rb = scr + fq * CV6_FQ_PITCH + 4 * npp;
        float f[32];
#pragma unroll
        for (int j = 0; j < 8; ++j) { const f32x4 t = *(const LAS f32x4*)(rb + j * 128); f[4 * j] = t.x; f[4 * j + 1] = t.y; f[4 * j + 2] = t.z; f[4 * j + 3] = t.w; }
        const u32x6 pk = cvt_fp6_32(f, W8_SCALE);
        const unsigned lo4 = (unsigned)__builtin_amdgcn_update_dpp(0, (int)pk[4], 0x114, 0xf, 0xf, false), lo5 = (unsigned)__builtin_amdgcn_update_dpp(0, (int)pk[5], 0x114, 0xf, 0xf, false);
        const unsigned hi4 = (unsigned)__builtin_amdgcn_update_dpp(0, (int)pk[4], 0x104, 0xf, 0xf, false), hi5 = (unsigned)__builtin_amdgcn_update_dpp(0, (int)pk[5], 0x104, 0xf, 0xf, false);
        const bool odd = (npp & 1) != 0;
        const int na = odd ? npp - 1 : npp, nb = odd ? npp : npp + 1;
        GAS unsigned char* oa = c.WT + (size_t)(4 * (na & 7) + (na >> 3)) * 2048 + 16 * fq + (odd ? 64 : 0);
        GAS unsigned char* ob = c.WT + (size_t)(4 * (nb & 7) + (nb >> 3)) * 2048 + 16 * fq + (odd ? 0 : 64);
        const u32x4 f1 = {pk[0], pk[1], pk[2], pk[3]}, slo = {lo4, lo5, lo4, lo5}, shi = {hi4, hi5, hi4, hi5};
        __builtin_nontemporal_store(odd ? slo : f1, (GAS u32x4*)oa);
        __builtin_nontemporal_store(odd ? f1 : shi, (GAS u32x4*)ob);
    }
    asm volatile("s_waitcnt lgkmcnt(0)" ::: "memory");
}
__device__ __forceinline__ int cv6_claim(Frame& F) { int s = 0; if (F.lane == 0) s = (int)atomicAdd(F.ctl + CW_QCV6, 1u); return __builtin_amdgcn_readfirstlane(s); }
__device__ __forceinline__ void ph_expert_conv6(Frame& F) {
    LAS float* scr = (LAS float*)(F.lds + F.wave * CV6_TILE_BYTES);
    int sc = cv6_claim(F), kb = 0;
    if (sc >= CV6_NSTRIP) return;
    f32x4 va[16], vb[16];
    cv6_load(cv6_decode(F, sc, kb), F.lane, va);
    for (;;) {
        int s1 = sc, k1 = kb + 1; if (k1 == 16) { s1 = cv6_claim(F); k1 = 0; }
        const bool h1 = s1 < CV6_NSTRIP;
        cv6_load(cv6_decode(F, h1 ? s1 : sc, h1 ? k1 : kb), F.lane, vb);
        cv6_store(cv6_decode(F, sc, kb), F.lane, va, scr);
        if (!h1) break;
        int s2 = s1, k2 = k1 + 1; if (k2 == 16) { s2 = cv6_claim(F); k2 = 0; }
        const bool h2 = s2 < CV6_NSTRIP;
        cv6_load(cv6_decode(F, h2 ? s2 : s1, h2 ? k2 : k1), F.lane, va);
        cv6_store(cv6_decode(F, s1, k1), F.lane, vb, scr);
        if (!h2) break;
        sc = s2; kb = k2;
    }
}

constexpr int CV_PK = 132, CV_TILE_BYTES = 8 * CV_PK * 4, CV_NSTRIP = 32 * 64, CV_KB = 16;
__device__ __forceinline__ CvItem cv_decode(Frame& F, int strip, int kb) {
    const int which = 2, e = (strip >> 6) & 31, n0 = 32 * (strip & 63), k0 = 128 * kb;
    const unsigned long long m0 = which == 0 ? ~0ull : 0ull, m1 = which == 1 ? ~0ull : 0ull, m2 = which == 2 ? ~0ull : 0ull;
    const unsigned long long wsel = ((unsigned long long)F.w_gate & m0) | ((unsigned long long)F.w_up & m1) | ((unsigned long long)F.w_down & m2);
    const unsigned long long osel = ((unsigned long long)F.WGU & (m0 | m1)) | ((unsigned long long)F.WDN & m2);
    const int orow0 = which == 2 ? n0 : (n0 >> 7) * 256 + which * 128 + (n0 & 127);
    const size_t ebytes = which == 2 ? (size_t)D * FF : (size_t)4096 * D;
    CvItem c; c.W = (const GAS float*)wsel + (size_t)e * D * FF + (size_t)k0 * 2048 + n0;
    c.WT = (GAS unsigned char*)osel + (size_t)e * ebytes + (size_t)orow0 * 2048 + k0;
    return c;
}
__device__ __forceinline__ void cv_load(const CvItem& c, int lane, f32x4 (&v)[16]) {
    const GAS float* p = c.W + (size_t)(lane >> 3) * 2048 + 4 * (lane & 7);
#pragma unroll
    for (int i = 0; i < 16; ++i) v[i] = __builtin_nontemporal_load((const GAS f32x4*)(p + (size_t)(8 * i) * 2048));
}
__device__ __forceinline__ void cv_store(const CvItem& c, int lane, const f32x4 (&v)[16], LAS float* scr) {
    LAS unsigned* sb = (LAS unsigned*)scr;
    const int r8 = lane >> 3, c4 = lane & 7;
#pragma unroll
    for (int i = 0; i < 16; ++i) { const f32x4 w = v[i] * W8_SCALE; sb[c4 * CV_PK + 8 * i + r8] = pk4_fp8(w.x, w.y, w.z, w.w); }
    asm volatile("s_waitcnt lgkmcnt(0)" ::: "memory");
    const int n4 = lane >> 3, kb = lane & 7;
    u32x4 dq[4];
#pragma unroll
    for (int g = 0; g < 4; ++g) dq[g] = *(const LAS u32x4*)(sb + n4 * CV_PK + 16 * kb + 4 * g);
    u32x4 o[4];
#pragma unroll
    for (int g = 0; g < 4; ++g) {
        const unsigned lo01 = __builtin_amdgcn_perm(dq[g].y, dq[g].x, 0x05010400u), hi01 = __builtin_amdgcn_perm(dq[g].y, dq[g].x, 0x07030602u);
        const unsigned lo23 = __builtin_amdgcn_perm(dq[g].w, dq[g].z, 0x05010400u), hi23 = __builtin_amdgcn_perm(dq[g].w, dq[g].z, 0x07030602u);
        o[0][g] = __builtin_amdgcn_perm(lo23, lo01, 0x05040100u); o[1][g] = __builtin_amdgcn_perm(lo23, lo01, 0x07060302u);
        o[2][g] = __builtin_amdgcn_perm(hi23, hi01, 0x05040100u); o[3][g] = __builtin_amdgcn_perm(hi23, hi01, 0x07060302u);
    }
#pragma unroll
    for (int j = 0; j < 4; ++j) __builtin_nontemporal_store(o[j], (GAS u32x4*)(c.WT + (size_t)(4 * n4 + j) * 2048 + 16 * kb));
    asm volatile("s_waitcnt lgkmcnt(0)" ::: "memory");
}
__device__ __forceinline__ int cv_claim(Frame& F) { int s = 0; if (F.lane == 0) s = (int)atomicAdd(F.ctl + CW_QCV, 1u); return __builtin_amdgcn_readfirstlane(s); }
__device__ __forceinline__ void ph_expert_conv(Frame& F) {
    LAS float* scr = (LAS float*)(F.lds + F.wave * CV6_TILE_BYTES);
    int sc = cv_claim(F), kb = 0;
    if (sc >= CV_NSTRIP) return;
    f32x4 va[16], vb[16];
    cv_load(cv_decode(F, sc, kb), F.lane, va);
    for (;;) {
        int s1 = sc, k1 = kb + 1; if (k1 == CV_KB) { s1 = cv_claim(F); k1 = 0; }
        const bool h1 = s1 < CV_NSTRIP;
        cv_load(cv_decode(F, h1 ? s1 : sc, h1 ? k1 : kb), F.lane, vb);
        cv_store(cv_decode(F, sc, kb), F.lane, va, scr);
        if (!h1) break;
        int s2 = s1, k2 = k1 + 1; if (k2 == CV_KB) { s2 = cv_claim(F); k2 = 0; }
        const bool h2 = s2 < CV_NSTRIP;
        cv_load(cv_decode(F, h2 ? s2 : s1, h2 ? k2 : k1), F.lane, va);
        cv_store(cv_decode(F, s1, k1), F.lane, vb, scr);
        if (!h2) break;
        sc = s2; kb = k2;
    }
}

constexpr int AT_STRIDE = 4112;
__device__ __forceinline__ void ph1(Frame& F) {
    LAS float* Ac = (LAS float*)F.lds; LAS float* Bc = Ac + D;
    const int gw = F.bid * 8 + F.wave, NGW = F.nb * 8;
    for (int seg = 0; seg < 3; ++seg) {
        __syncthreads();
        for (int cc = F.tid; cc < D; cc += 512) { const float sh = F.MOD[seg * 12288 + cc], sl = F.MOD[seg * 12288 + D + cc]; Ac[cc] = F.g_mix[cc] * (1.0f + sl); Bc[cc] = sh; }
        __syncthreads();
        if (seg < 2) {
            const float* in = F.x + (size_t)seg * SEQ * D; bf16_t* outp = F.XN + (size_t)(seg * SEQ) * D;
            for (int m = gw; m < SEQ; m += NGW) {
                const f32x4* xr = (const f32x4*)(in + (size_t)m * D) + F.lane; f32x4 v[8]; float s = 0.f;
#pragma unroll
                for (int j = 0; j < 8; ++j) { v[j] = __builtin_nontemporal_load(xr + 64 * j); s += (v[j].x * v[j].x + v[j].y * v[j].y) + (v[j].z * v[j].z + v[j].w * v[j].w); }
                const float rstd = 1.0f / sqrtf(wave_sum(s) * (1.0f / D) + EPS);
                unsigned long long* o8 = (unsigned long long*)(outp + (size_t)m * D) + F.lane;
#pragma unroll
                for (int j = 0; j < 8; ++j) { const f32x4 a = *(const LAS f32x4*)(Ac + 4 * (F.lane + 64 * j)), b = *(const LAS f32x4*)(Bc + 4 * (F.lane + 64 * j)); const f32x4 o = v[j] * rstd * a + b;
                    o8[64 * j] = (unsigned long long)cvt_pk_bf16(o.x, o.y) | ((unsigned long long)cvt_pk_bf16(o.z, o.w) << 32); }
            }
        } else {
            LAS unsigned char* AT = F.lds + 16384; LAS float* RED = (LAS float*)(F.lds + 16384 + 16 * AT_STRIDE + 256);
            for (int u = F.bid; u < 256; u += F.nb) {
                const int rg = u >> 3, cg = u & 7;
                __syncthreads();
#pragma unroll 1
                for (int rr = 0; rr < 2; ++rr) { const int r = F.wave * 2 + rr;
                    const f32x4* xr = (const f32x4*)(F.ctx + (size_t)(16 * rg + r) * D) + F.lane; f32x4 v[8]; float s = 0.f;
#pragma unroll
                    for (int j = 0; j < 8; ++j) { v[j] = xr[64 * j]; s += (v[j].x * v[j].x + v[j].y * v[j].y) + (v[j].z * v[j].z + v[j].w * v[j].w); }
                    const float rstd = 1.0f / sqrtf(wave_sum(s) * (1.0f / D) + EPS);
#pragma unroll
                    for (int j = 0; j < 8; ++j) { const f32x4 a = *(const LAS f32x4*)(Ac + 4 * (F.lane + 64 * j)), b = *(const LAS f32x4*)(Bc + 4 * (F.lane + 64 * j)); const f32x4 o = v[j] * rstd * a + b;
                        u32x2 w; w.x = cvt_pk_bf16(o.x, o.y); w.y = cvt_pk_bf16(o.z, o.w); *(LAS u32x2*)(AT + r * AT_STRIDE + 8 * (F.lane + 64 * j)) = w; } }
                __syncthreads();
                const int c16 = F.lane & 15, q = F.lane >> 4;
                f32x4 acc[8];
#pragma unroll
                for (int n = 0; n < 8; ++n) acc[n] = (f32x4){0.f, 0.f, 0.f, 0.f};
                const bf16_t* wb = F.WIN + (size_t)(DA + 128 * cg + c16) * D + 256 * F.wave + 8 * q;
                const bf16_t* wp[8];
#pragma unroll
                for (int n = 0; n < 8; ++n) wp[n] = wb + (size_t)(16 * n) * D;
                u32x4 bA[8], bB[8];
#define P1_LD(dst, ks) do { _Pragma("unroll") for (int n = 0; n < 8; ++n) asm volatile("global_load_dwordx4 %0, %1, off offset:%2" : "=v"(dst[n]) : "v"(wp[n]), "n"(64 * (ks))); } while (0)
#define P1_WAIT(dst, cnt) asm volatile("s_waitcnt vmcnt(" #cnt ")" : "+v"(dst[0]), "+v"(dst[1]), "+v"(dst[2]), "+v"(dst[3]), "+v"(dst[4]), "+v"(dst[5]), "+v"(dst[6]), "+v"(dst[7]) :: "memory")
#define P1_MMA(dst, ks) do { const bf16x8 af = *(const LAS bf16x8*)(AT + c16 * AT_STRIDE + (256 * F.wave + 32 * (ks) + 8 * q) * 2); \
                    _Pragma("unroll") for (int n = 0; n < 8; ++n) acc[n] = __builtin_amdgcn_mfma_f32_16x16x32_bf16(af, __builtin_bit_cast(bf16x8, dst[n]), acc[n], 0, 0, 0); } while (0)
                P1_LD(bA, 0);
                P1_LD(bB, 1); P1_WAIT(bA, 8); P1_MMA(bA, 0);
                P1_LD(bA, 2); P1_WAIT(bB, 8); P1_MMA(bB, 1);
                P1_LD(bB, 3); P1_WAIT(bA, 8); P1_MMA(bA, 2);
                P1_LD(bA, 4); P1_WAIT(bB, 8); P1_MMA(bB, 3);
                P1_LD(bB, 5); P1_WAIT(bA, 8); P1_MMA(bA, 4);
                P1_LD(bA, 6); P1_WAIT(bB, 8); P1_MMA(bB, 5);
                P1_LD(bB, 7); P1_WAIT(bA, 8); P1_MMA(bA, 6);
                P1_WAIT(bB, 0); P1_MMA(bB, 7);
#undef P1_LD
#undef P1_WAIT
#undef P1_MMA
#pragma unroll
                for (int n = 0; n < 8; ++n)
#pragma unroll
                    for (int rg4 = 0; rg4 < 4; ++rg4) RED[(F.wave * 16 + 4 * q + rg4) * 128 + 16 * n + c16] = acc[n][rg4];
                __syncthreads();
                { const int tok = F.tid >> 5, c4 = (F.tid & 31) * 4; f32x4 sum = {0.f, 0.f, 0.f, 0.f};
#pragma unroll
                  for (int w = 0; w < 8; ++w) sum += *(const LAS f32x4*)(RED + (w * 16 + tok) * 128 + c4);
                  u32x2 o; o.x = cvt_pk_bf16(sum.x, sum.y); o.y = cvt_pk_bf16(sum.z, sum.w);
                  *(u32x2*)(F.XA + (size_t)(T + 16 * rg + tok) * DA + 128 * cg + c4) = o; }
            }
        }
    }
}

constexpr int XCT_STRIDE = 272;
template <bool FINAL>
__device__ __forceinline__ void gates_phase(Frame& F, const int nrep) {
    LAS unsigned char* xcT = F.lds; LAS unsigned char* hsT = F.lds + 64 * XCT_STRIDE;
    const int h = F.bid & 7, kb0 = F.bid >> 3, kstride = (F.nb - h + 7) >> 3;
    const int NU = FINAL ? 256 : 2 * NCHUNK;
    const int c16 = F.lane & 15, q = F.lane >> 4, jrow = F.wave * 16 + c16, ch = h * 128 + jrow;
    bf16x8 bfr[4][4];
#pragma unroll
    for (int ks = 0; ks < 4; ++ks)
#pragma unroll
        for (int td = 0; td < 4; ++td) bfr[ks][td] = *(const bf16x8*)(F.WG + (size_t)((td * 8 + h) * 128 + jrow) * 128 + ks * 32 + q * 8);
    const float brf = F.lru_b_r[ch], brb = F.lru_b_r[DA + ch], bif = F.lru_b_i[ch], bib = F.lru_b_i[DA + ch];
    const float cff = -8.0f * log1pf(expf(-F.lru_lam[ch])), cfb = -8.0f * log1pf(expf(-F.lru_lam[DA + ch]));
    const int cg = F.tid & 15, tok0 = F.tid >> 4, chc = h * 128 + cg * 8;
    LAS float* CW = (LAS float*)(F.lds + 128 * XCT_STRIDE);
    for (int i = F.tid; i < 640; i += 512) CW[i] = i < 512 ? F.conv_a_w[(i >> 7) * DA + h * 128 + (i & 127)] : F.conv_a_b[h * 128 + (i - 512)];
    u32x4 xr[2][4];
#define GU_DECODE(k, b_, ci_, grow0_, t0_, seqlen_) const int b_ = (k) / (FINAL ? 128 : NCHUNK), ci_ = (k) % (FINAL ? 128 : NCHUNK); \
        const bool ctxu_ = !FINAL && ci_ < 4; const int t0_ = ctxu_ ? ci_ * 64 : (FINAL ? ci_ : ci_ - 4) * 64, seqlen_ = ctxu_ ? CTXL : SEQ, grow0_ = ctxu_ ? T + b_ * CTXL + t0_ : b_ * SEQ + t0_;
#define GU_LOAD(k) do { GU_DECODE(k, b_, ci_, grow0_, t0_, seqlen_) (void)ci_; \
        _Pragma("unroll") for (int it = 0; it < 2; ++it) _Pragma("unroll") for (int kk = 0; kk < 4; ++kk) { const int tt = t0_ + tok0 + 32 * it + kk - 2; \
            xr[it][kk] = (tt >= 0 && tt < seqlen_) ? *(const u32x4*)(F.XA + (size_t)(grow0_ + tok0 + 32 * it + kk - 2) * DA + chc) : (u32x4){0u, 0u, 0u, 0u}; } } while (0)
#pragma unroll 1
    for (int rep = 0; rep < nrep; ++rep) {
    int k = kb0;
    if (k < NU) GU_LOAD(k);
    for (; k < NU; k += kstride) {
        GU_DECODE(k, b, ci, grow0, t0, seqlen) (void)t0; (void)seqlen;
        __syncthreads();
#pragma unroll
        for (int it = 0; it < 2; ++it) { f32x4 a0 = *(const LAS f32x4*)(CW + 512 + cg * 8), a1 = *(const LAS f32x4*)(CW + 512 + cg * 8 + 4);
#pragma unroll
            for (int kk = 0; kk < 4; ++kk) { float xf[8]; unpack8(xr[it][kk], xf); a0 += *(const LAS f32x4*)(CW + kk * 128 + cg * 8) * (f32x4){xf[0], xf[1], xf[2], xf[3]}; a1 += *(const LAS f32x4*)(CW + kk * 128 + cg * 8 + 4) * (f32x4){xf[4], xf[5], xf[6], xf[7]}; }
            u32x4 o; o.x = cvt_pk_bf16(a0.x, a0.y); o.y = cvt_pk_bf16(a0.z, a0.w); o.z = cvt_pk_bf16(a1.x, a1.y); o.w = cvt_pk_bf16(a1.z, a1.w);
            *(LAS u32x4*)(xcT + (tok0 + 32 * it) * XCT_STRIDE + cg * 16) = o; }
        { const int kn = k + kstride; if (kn < NU) GU_LOAD(kn); }
        __syncthreads();
        f32x4 acc[4][4];
#pragma unroll
        for (int m = 0; m < 4; ++m)
#pragma unroll
            for (int td = 0; td < 4; ++td) acc[m][td] = (f32x4){0.f, 0.f, 0.f, 0.f};
#pragma unroll
        for (int ks = 0; ks < 4; ++ks) {
#pragma unroll
            for (int m = 0; m < 4; ++m) { const int arow = 16 * (c16 >> 2) + 4 * m + (c16 & 3); const bf16x8 af = *(const LAS bf16x8*)(xcT + arow * XCT_STRIDE + (ks * 32 + q * 8) * 2);
#pragma unroll
                for (int td = 0; td < 4; ++td) acc[m][td] = __builtin_amdgcn_mfma_f32_16x16x32_bf16(af, bfr[ks][td], acc[m][td], 0, 0, 0); }
        }
#pragma unroll
        for (int m = 0; m < 4; ++m)
#pragma unroll
            for (int rg = 0; rg < 4; ++rg) { const int tok = 16 * q + 4 * m + rg; const float xcv = __uint_as_float((unsigned)(*(const LAS unsigned short*)(xcT + tok * XCT_STRIDE + jrow * 2)) << 16);
                { float ao, bo; gate_pair(acc[m][0][rg] + brf, acc[m][2][rg] + bif, cff, xcv, ao, bo); acc[m][0][rg] = ao; acc[m][2][rg] = bo; }
                { float ao, bo; gate_pair(acc[m][1][rg] + brb, acc[m][3][rg] + bib, cfb, xcv, ao, bo); acc[m][1][rg] = ao; acc[m][3][rg] = bo; } }
        float Af = 1.f, Bf = 0.f, Ab = 1.f, Bb = 0.f;
#pragma unroll
        for (int m = 0; m < 4; ++m)
#pragma unroll
            for (int rg = 0; rg < 4; ++rg) { Bf = acc[m][0][rg] * Bf + acc[m][2][rg]; Af *= acc[m][0][rg]; }
#pragma unroll
        for (int m = 3; m >= 0; --m)
#pragma unroll
            for (int rg = 3; rg >= 0; --rg) { Bb = acc[m][1][rg] * Bb + acc[m][3][rg]; Ab *= acc[m][1][rg]; }
        float A_[4], B_[4], Ab_[4], Bb_[4];
#pragma unroll
        for (int qq = 0; qq < 4; ++qq) { A_[qq] = __shfl(Af, c16 + 16 * qq); B_[qq] = __shfl(Bf, c16 + 16 * qq); Ab_[qq] = __shfl(Ab, c16 + 16 * qq); Bb_[qq] = __shfl(Bb, c16 + 16 * qq); }
        if constexpr (!FINAL) {
            const float At = (A_[0] * A_[1]) * (A_[2] * A_[3]), Bt = ((B_[0] * A_[1] + B_[1]) * A_[2] + B_[2]) * A_[3] + B_[3];
            const float Abt = (Ab_[0] * Ab_[1]) * (Ab_[2] * Ab_[3]), Bbt = ((Bb_[3] * Ab_[2] + Bb_[2]) * Ab_[1] + Bb_[1]) * Ab_[0] + Bb_[0];
            if (q == 0) { F.AGG[(size_t)((0 * 2 + b) * NCHUNK + ci) * DA + ch] = (f32x2){At, Bt}; F.AGG[(size_t)((1 * 2 + b) * NCHUNK + ci) * DA + ch] = (f32x2){Abt, Bbt}; }
        } else {
            float hf = F.HIN[(size_t)((0 * 2 + b) * 128 + ci) * DA + ch], hb = F.HIN[(size_t)((1 * 2 + b) * 128 + ci) * DA + ch];
#pragma unroll
            for (int qq = 0; qq < 4; ++qq) hf = (qq < q) ? A_[qq] * hf + B_[qq] : hf;
#pragma unroll
            for (int qq = 3; qq >= 0; --qq) hb = (qq > q) ? Ab_[qq] * hb + Bb_[qq] : hb;
            float hs[4][4]; float hh = hf;
#pragma unroll
            for (int m = 0; m < 4; ++m)
#pragma unroll
                for (int rg = 0; rg < 4; ++rg) { hh = acc[m][0][rg] * hh + acc[m][2][rg]; hs[m][rg] = hh; }
            hh = hb;
#pragma unroll
            for (int m = 3; m >= 0; --m)
#pragma unroll
                for (int rg = 3; rg >= 0; --rg) { hh = acc[m][1][rg] * hh + acc[m][3][rg]; hs[m][rg] += hh; }
#pragma unroll
            for (int m = 0; m < 4; ++m)
#pragma unroll
                for (int rg = 0; rg < 4; ++rg) { const int tok = 16 * q + 4 * m + rg; *(LAS unsigned short*)(hsT + tok * XCT_STRIDE + jrow * 2) = (unsigned short)(cvt_pk_bf16(hs[m][rg], 0.f) & 0xffffu); }
            __syncthreads();
#pragma unroll
            for (int it = 0; it < 2; ++it) { const int tok = tok0 + 32 * it; *(u32x4*)(F.HS + (size_t)(grow0 + tok) * DA + chc) = *(const LAS u32x4*)(hsT + tok * XCT_STRIDE + cg * 16); }
        }
    }
    }
#undef GU_DECODE
#undef GU_LOAD
}
__device__ __forceinline__ void ph4(Frame& F) {
    LAS f32x2* G = (LAS f32x2*)F.lds;
    for (int u = F.bid; u < 128; u += F.nb) {
        const int dir = u >> 6, b = (u >> 5) & 1, ch = (u & 31) * 32 + (F.tid & 31), g = F.tid >> 5;
        const f32x2* ag = F.AGG + (size_t)((dir * 2 + b) * NCHUNK) * DA + ch; float* hin = F.HIN + (size_t)((dir * 2 + b) * 128) * DA + ch;
        f32x2 v[12]; float A = 1.f, B = 0.f;
        __syncthreads();
        if (g < 11) {
#pragma unroll
            for (int j = 0; j < 12; ++j) { const int p = g * 12 + j, cidx = dir == 0 ? p : (p < 4 ? 3 - p : 135 - p); v[j] = ag[(size_t)cidx * DA]; }
#pragma unroll
            for (int j = 0; j < 12; ++j) { B = v[j].x * B + v[j].y; A *= v[j].x; }
            G[g * 32 + (F.tid & 31)] = (f32x2){A, B};
        }
        __syncthreads();
        if (g < 11) {
            float hcur = 0.f;
            for (int gg = 0; gg < g; ++gg) { const f32x2 t = G[gg * 32 + (F.tid & 31)]; hcur = t.x * hcur + t.y; }
#pragma unroll
            for (int j = 0; j < 12; ++j) { const int p = g * 12 + j, cidx = dir == 0 ? p : (p < 4 ? 3 - p : 135 - p); if (cidx >= 4) hin[(size_t)(cidx - 4) * DA] = hcur; hcur = v[j].x * hcur + v[j].y; }
        }
    }
}
__device__ __forceinline__ void p5b_load(Frame& F, int t, int c0, int c1, u32x4 (&v)[12]) {
    const int tl = t & (SEQ - 1), col = tl & 63, grow = tl >> 6; const size_t ro = (size_t)t * DA; const u32x4 zero = {0u, 0u, 0u, 0u};
    v[0] = __builtin_nontemporal_load((const u32x4*)(F.Gb + ro + c0)); v[1] = __builtin_nontemporal_load((const u32x4*)(F.Gb + ro + c1)); v[2] = __builtin_nontemporal_load((const u32x4*)(F.HS + ro + c0)); v[3] = __builtin_nontemporal_load((const u32x4*)(F.HS + ro + c1));
    v[4] = __builtin_nontemporal_load((const u32x4*)(F.BB + ro + c0)); v[5] = __builtin_nontemporal_load((const u32x4*)(F.BB + ro + c1)); v[6] = *(const u32x4*)(F.P + ro + c0); v[7] = *(const u32x4*)(F.P + ro + c1);
    v[8] = col > 0 ? *(const u32x4*)(F.P + ro - DA + c0) : zero; v[9] = col < 63 ? *(const u32x4*)(F.P + ro + DA + c0) : zero;
    v[10] = grow > 0 ? *(const u32x4*)(F.P + ro - 64 * DA + c1) : zero; v[11] = grow < 127 ? *(const u32x4*)(F.P + ro + 64 * DA + c1) : zero;
}
__device__ __forceinline__ void p5b_item(Frame& F, int t, int c0, int c1, const u32x4 (&v)[12], const f32x4 (&wa)[2][2], const f32x4 (&wb)[2][2], const f32x4 (&w0)[2][2], const f32x4 (&w1)[2][2], const f32x4 (&w2)[2][2]) {
    float ya[2][8], yb[2][8]; float sa = 0.f, sb = 0.f;
#pragma unroll
    for (int cc = 0; cc < 2; ++cc) { float gg[8], hh[8]; unpack8(v[cc], gg); unpack8(v[2 + cc], hh);
#pragma unroll
        for (int j = 0; j < 8; ++j) { const float y = gg[j] * hh[j]; sa += y * y; ya[cc][j] = y * wa[cc][j >> 2][j & 3]; } }
#pragma unroll
    for (int cc = 0; cc < 2; ++cc) { float bq[8], a[8], m[8], p[8]; unpack8(v[4 + cc], bq); unpack8(v[6 + cc], a); unpack8(v[8 + 2 * cc], m); unpack8(v[9 + 2 * cc], p);
#pragma unroll
        for (int j = 0; j < 8; ++j) { const float y = bq[j] * (w0[cc][j >> 2][j & 3] * m[j] + w1[cc][j >> 2][j & 3] * a[j] + w2[cc][j >> 2][j & 3] * p[j]); sb += y * y; yb[cc][j] = y * wb[cc][j >> 2][j & 3]; } }
    sa = wave_sum(sa); sb = wave_sum(sb);
    const float ra = 1.0f / sqrtf(sa * (1.0f / DA) + EPS), rb = 1.0f / sqrtf(sb * (1.0f / DA) + EPS);
    bf16_t* yo = F.Y + (size_t)t * D;
#pragma unroll
    for (int cc = 0; cc < 2; ++cc) { const int c = cc ? c1 : c0; u32x4 o;
        o.x = cvt_pk_bf16(ya[cc][0] * ra, ya[cc][1] * ra); o.y = cvt_pk_bf16(ya[cc][2] * ra, ya[cc][3] * ra); o.z = cvt_pk_bf16(ya[cc][4] * ra, ya[cc][5] * ra); o.w = cvt_pk_bf16(ya[cc][6] * ra, ya[cc][7] * ra);
        *(u32x4*)(yo + c) = o;
        o.x = cvt_pk_bf16(yb[cc][0] * rb, yb[cc][1] * rb); o.y = cvt_pk_bf16(yb[cc][2] * rb, yb[cc][3] * rb); o.z = cvt_pk_bf16(yb[cc][4] * rb, yb[cc][5] * rb); o.w = cvt_pk_bf16(yb[cc][6] * rb, yb[cc][7] * rb);
        *(u32x4*)(yo + DA + c) = o; }
}
__device__ __forceinline__ void ph5b(Frame& F) {
    const int gw = F.bid * 8 + F.wave, NGW = F.nb * 8, c0 = 8 * F.lane, c1 = 512 + 8 * F.lane;
    if (gw >= T) return;
    f32x4 wa[2][2], wb[2][2], w0[2][2], w1[2][2], w2[2][2];
#pragma unroll
    for (int cc = 0; cc < 2; ++cc)
#pragma unroll
        for (int hh = 0; hh < 2; ++hh) { const int c = (cc ? c1 : c0) + 4 * hh; wa[cc][hh] = *(const f32x4*)(F.g_out_a + c); wb[cc][hh] = *(const f32x4*)(F.g_out_b + c);
            w0[cc][hh] = *(const f32x4*)(F.conv_b_w + c); w1[cc][hh] = *(const f32x4*)(F.conv_b_w + DA + c); w2[cc][hh] = *(const f32x4*)(F.conv_b_w + 2 * DA + c); }
    u32x4 va[12], vb[12]; int t = gw;
    p5b_load(F, t, c0, c1, va);
    for (;;) {
        const int t1 = t + NGW; const bool h1 = t1 < T;
        p5b_load(F, h1 ? t1 : t, c0, c1, vb);
        p5b_item(F, t, c0, c1, va, wa, wb, w0, w1, w2);
        if (!h1) break;
        const int t2 = t1 + NGW; const bool h2 = t2 < T;
        p5b_load(F, h2 ? t2 : t1, c0, c1, va);
        p5b_item(F, t1, c0, c1, vb, wa, wb, w0, w1, w2);
        if (!h2) break;
        t = t2;
    }
}

constexpr int XT_STRIDE = 2052;
__device__ __forceinline__ void ph7(Frame& F) {
    LAS float* Ac = (LAS float*)F.lds; LAS float* Bc = Ac + D; LAS float* XT = (LAS float*)(F.lds + 16384); LAS float* RED = XT; LAS float* LG = (LAS float*)(F.lds + 16384 + 16 * XT_STRIDE * 4);
    int curb = -1;
    for (int g = F.bid; g < T / 16; g += F.nb) {
        const int row0 = 16 * g, b = row0 >> 13;
        __syncthreads();
        if (b != curb) { for (int cc = F.tid; cc < D; cc += 512) { const float sh = F.MOD[b * 12288 + 6144 + cc], sl = F.MOD[b * 12288 + 8192 + cc]; Ac[cc] = F.g_ffn[cc] * (1.0f + sl); Bc[cc] = sh; } curb = b; __syncthreads(); }
#pragma unroll 1
        for (int rr = 0; rr < 2; ++rr) { const int r = F.wave * 2 + rr; const size_t row = (size_t)row0 + r;
            const f32x4* xr = (const f32x4*)(F.x + row * D) + F.lane; const u32x2* mr = (const u32x2*)(F.XN + row * D) + F.lane; f32x4 v[8]; float s = 0.f;
#pragma unroll
            for (int j = 0; j < 8; ++j) { const u32x2 mw = __builtin_nontemporal_load(mr + 64 * j); v[j] = __builtin_nontemporal_load(xr + 64 * j) + (f32x4){bf_lo(mw.x), bf_hi(mw.x), bf_lo(mw.y), bf_hi(mw.y)}; s += (v[j].x * v[j].x + v[j].y * v[j].y) + (v[j].z * v[j].z + v[j].w * v[j].w); }
            const float rstd = 1.0f / sqrtf(wave_sum(s) * (1.0f / D) + EPS);
            unsigned char* o6 = F.XN2 + row * D + (F.lane >> 2) * 128 + (F.lane & 3) * 16;
            u32x2* x1o = (u32x2*)(F.Y + row * D) + F.lane;
#pragma unroll
            for (int j = 0; j < 8; ++j) { u32x2 xw; xw.x = cvt_pk_bf16(v[j].x, v[j].y); xw.y = cvt_pk_bf16(v[j].z, v[j].w); __builtin_nontemporal_store(xw, x1o + 64 * j); }
#pragma unroll
            for (int j = 0; j < 8; ++j) { const f32x4 a = *(const LAS f32x4*)(Ac + 4 * (F.lane + 64 * j)), bq = *(const LAS f32x4*)(Bc + 4 * (F.lane + 64 * j)); const f32x4 o = v[j] * rstd * a + bq;
                v[j] = o;
                *(LAS f32x4*)(XT + r * XT_STRIDE + 4 * (F.lane + 64 * j)) = o; }
            { float fv[32];
#pragma unroll
              for (int j = 0; j < 8; ++j) { const f32x4 t = *(const LAS f32x4*)(XT + r * XT_STRIDE + 32 * F.lane + 4 * j); fv[4 * j] = t.x; fv[4 * j + 1] = t.y; fv[4 * j + 2] = t.z; fv[4 * j + 3] = t.w; }
              const u32x6 pk = cvt_fp6_32(fv, X6_SCALE);
              *(u32x4*)o6 = (u32x4){pk[0], pk[1], pk[2], pk[3]}; *(u32x4*)(o6 + 64) = (u32x4){pk[4], pk[5], pk[4], pk[5]}; }
        }
        __syncthreads();
        {
            const int r = F.lane & 15, q = F.lane >> 4; f32x4 acc0 = {0.f, 0.f, 0.f, 0.f}, acc1 = acc0;
#pragma unroll 8
            for (int i = 0; i < 16; ++i) { const int kb = 256 * F.wave + 16 * i + 4 * q; const f32x4 a4 = *(const LAS f32x4*)(XT + r * XT_STRIDE + kb);
#pragma unroll
                for (int u = 0; u < 4; ++u) { const float b0 = F.w_router[(kb + u) * NE + r], b1 = F.w_router[(kb + u) * NE + 16 + r];
                    acc0 = __builtin_amdgcn_mfma_f32_16x16x4f32(a4[u], b0, acc0, 0, 0, 0); acc1 = __builtin_amdgcn_mfma_f32_16x16x4f32(a4[u], b1, acc1, 0, 0, 0); } }
            __syncthreads();
#pragma unroll
            for (int rg = 0; rg < 4; ++rg) { RED[(F.wave * 16 + 4 * q + rg) * 32 + r] = acc0[rg]; RED[(F.wave * 16 + 4 * q + rg) * 32 + 16 + r] = acc1[rg]; }
        }
        __syncthreads();
        { const int tok = F.tid >> 5, e = F.tid & 31; float s = F.b_router[e];
#pragma unroll
          for (int w = 0; w < 8; ++w) s += RED[(w * 16 + tok) * 32 + e];
          LG[tok * 33 + e] = s; }
        __syncthreads();
        if (F.tid < 16) { const int tok = F.tid; unsigned taken = 0u; float tv[4]; int te[4];
#pragma unroll
            for (int k = 0; k < 4; ++k) { float best = -3.0e38f; int bi = 0;
                for (int e = 0; e < NE; ++e) { const float v = LG[tok * 33 + e]; if (!((taken >> e) & 1u) && v > best) { best = v; bi = e; } }
                taken |= 1u << bi; tv[k] = best; te[k] = bi; }
            float ex[4], sum = 0.f;
#pragma unroll
            for (int k = 0; k < 4; ++k) { ex[k] = expf(tv[k] - tv[0]); sum += ex[k]; }
            const float inv = 1.0f / sum; const int token = row0 + tok;
            unsigned rank[4];
#pragma unroll
            for (int k = 0; k < 4; ++k) rank[k] = atomicAdd(F.CNT + te[k], 1u);
#pragma unroll
            for (int k = 0; k < 4; ++k) { F.STOK[(size_t)te[k] * CAP + rank[k]] = token; F.SLW[(size_t)te[k] * CAP + rank[k]] = ex[k] * inv; F.ER[token * 4 + k] = (unsigned)te[k] | (rank[k] << 8); }
        }
    }
}
__device__ __forceinline__ void moe_tables(Frame& F) {
    __syncthreads();
    if (F.tid < 64) {
        const int e = F.tid, c = e < NE ? (int)F.CNT[e] : 0, tl = (c + 255) >> 8;
        int incl = tl;
#pragma unroll
        for (int d = 1; d < NE; d <<= 1) { const int o = __shfl_up(incl, d); if (e >= d) incl += o; }
        if (e < NE) { F.MISC[128 + e] = (unsigned)c; F.MISC[16 + e] = (unsigned)(incl - tl); F.MISC[64 + e] = (unsigned)(incl - tl); }
        if (e == NE - 1) { F.MISC[16 + NE] = (unsigned)incl; F.MISC[64 + NE] = (unsigned)incl; }
    }
    __syncthreads();
}
__device__ __forceinline__ void ph11(Frame& F) {
    LAS float* GT = (LAS float*)F.lds; LAS float* GF = GT + 2 * D;
    for (int cc = F.tid; cc < D; cc += 512) { GT[cc] = F.MOD[10240 + cc]; GT[D + cc] = F.MOD[12288 + 10240 + cc]; GF[cc] = F.g_final[cc]; }
    __syncthreads();
    const int gw = F.bid * 8 + F.wave, NGW = F.nb * 8;
    u32x4 ern = gw < T ? *(const u32x4*)(F.ER + (size_t)gw * 4) : (u32x4){0u, 0u, 0u, 0u};
    for (int t = gw; t < T; t += NGW) {
        const int b = t >> 13; size_t pos[4]; const u32x4 erc = ern;
        { const int tn = t + NGW; ern = *(const u32x4*)(F.ER + (size_t)(tn < T ? tn : t) * 4); }
#pragma unroll
        for (int k = 0; k < 4; ++k) { const unsigned er = erc[k]; pos[k] = ((size_t)F.MISC[64 + (er & 255u)] << 8) + (er >> 8); }
        float x2[4][8]; float ssq = 0.f;
#pragma unroll
        for (int j = 0; j < 4; ++j) { const int col = 8 * (F.lane + 64 * j);
            const u32x4 mw = __builtin_nontemporal_load((const u32x4*)(F.Y + (size_t)t * D + col));
            const f32x4 xa = {bf_lo(mw.x), bf_hi(mw.x), bf_lo(mw.y), bf_hi(mw.y)}, xb = {bf_lo(mw.z), bf_hi(mw.z), bf_lo(mw.w), bf_hi(mw.w)};
            float s8[8] = {0.f, 0.f, 0.f, 0.f, 0.f, 0.f, 0.f, 0.f};
#pragma unroll
            for (int k = 0; k < 4; ++k) { const u32x2 ov = __builtin_nontemporal_load((const u32x2*)((const unsigned char*)F.O + pos[k] * D + col));
                const f32x2 q0 = __builtin_amdgcn_cvt_pk_f32_fp8((int)ov.x, false), q1 = __builtin_amdgcn_cvt_pk_f32_fp8((int)ov.x, true), q2 = __builtin_amdgcn_cvt_pk_f32_fp8((int)ov.y, false), q3 = __builtin_amdgcn_cvt_pk_f32_fp8((int)ov.y, true);
                s8[0] += q0.x; s8[1] += q0.y; s8[2] += q1.x; s8[3] += q1.y; s8[4] += q2.x; s8[5] += q2.y; s8[6] += q3.x; s8[7] += q3.y; }
#pragma unroll
            for (int i = 0; i < 8; ++i) s8[i] *= O8_INV;
            const f32x4 ga = *(const LAS f32x4*)(GT + b * D + col), gb = *(const LAS f32x4*)(GT + b * D + col + 4);
            x2[j][0] = xa.x + ga.x * s8[0]; x2[j][1] = xa.y + ga.y * s8[1]; x2[j][2] = xa.z + ga.z * s8[2]; x2[j][3] = xa.w + ga.w * s8[3];
            x2[j][4] = xb.x + gb.x * s8[4]; x2[j][5] = xb.y + gb.y * s8[5]; x2[j][6] = xb.z + gb.z * s8[6]; x2[j][7] = xb.w + gb.w * s8[7];
#pragma unroll
            for (int i = 0; i < 8; ++i) ssq += x2[j][i] * x2[j][i]; }
        const float rstd = 1.0f / sqrtf(wave_sum(ssq) * (1.0f / D) + EPS);
#pragma unroll
        for (int j = 0; j < 4; ++j) { const int col = 8 * (F.lane + 64 * j); const f32x4 fa = *(const LAS f32x4*)(GF + col), fb = *(const LAS f32x4*)(GF + col + 4);
            __builtin_nontemporal_store((f32x4){x2[j][0] * rstd * fa.x, x2[j][1] * rstd * fa.y, x2[j][2] * rstd * fa.z, x2[j][3] * rstd * fa.w}, (f32x4*)(F.out + (size_t)t * D + col));
            __builtin_nontemporal_store((f32x4){x2[j][4] * rstd * fb.x, x2[j][5] * rstd * fb.y, x2[j][6] * rstd * fb.z, x2[j][7] * rstd * fb.w}, (f32x4*)(F.out + (size_t)t * D + col + 4)); }
    }
}

struct Args { const float* in[29]; float* out; unsigned char* ws; int ph_lo, ph_hi, li, pad; };
__global__ void __launch_bounds__(512, 2) fwd_kernel(Args args) {
    extern __shared__ __attribute__((aligned(16))) unsigned char lds[];
    Frame F;
    F.lds = (LAS unsigned char*)lds; F.MISC = (volatile LAS unsigned*)(F.lds + MISC_OFF);
    F.tid = threadIdx.x; F.lane = F.tid & 63; F.wave = __builtin_amdgcn_readfirstlane(F.tid >> 6); F.G = gridDim.x;
    unsigned char* ws = args.ws;
    F.ctl = (unsigned*)(ws + WS_CTL);
    F.x = args.in[0]; F.c = args.in[1]; F.ctx = args.in[2]; F.c_ctx = args.in[3]; F.w_mod = args.in[4]; F.b_mod = args.in[5]; F.g_mix = args.in[6]; F.w_in = args.in[7];
    F.conv_a_w = args.in[8]; F.conv_a_b = args.in[9]; F.lru_w_r = args.in[10]; F.lru_b_r = args.in[11]; F.lru_w_i = args.in[12]; F.lru_b_i = args.in[13]; F.lru_lam = args.in[14];
    F.conv_b_w = args.in[15]; F.g_out_a = args.in[16]; F.g_out_b = args.in[17]; F.w_out = args.in[18]; F.g_ffn = args.in[19]; F.w_router = args.in[20]; F.b_router = args.in[21];
    F.w_gate = args.in[22]; F.b_gate = args.in[23]; F.w_up = args.in[24]; F.b_up = args.in[25]; F.w_down = args.in[26]; F.b_down = args.in[27]; F.g_final = args.in[28];
    F.out = args.out;
    F.MOD = (float*)(ws + WS_MOD); F.WG = (bf16_t*)(ws + WS_WG); F.WIN = (bf16_t*)(ws + WS_WIN); F.WOUT = (bf16_t*)(ws + WS_WOUT); F.XN = (bf16_t*)(ws + WS_XN); F.Gb = (bf16_t*)(ws + WS_G);
    F.XA = (bf16_t*)(ws + WS_XA); F.BB = (bf16_t*)(ws + WS_BB); F.P = (bf16_t*)(ws + WS_P); F.Y = (bf16_t*)(ws + WS_Y); F.WGU = (bf16_t*)(ws + WS_WGU); F.WDN = (bf16_t*)(ws + WS_WDN);
    F.H = (bf16_t*)(ws + WS_H); F.O = (bf16_t*)(ws + WS_O); F.AGG = (f32x2*)(ws + WS_AGG); F.HIN = (float*)(ws + WS_HIN); F.ER = (unsigned*)(ws + WS_ER); F.STOK = (int*)(ws + WS_STOK);
    F.SLW = (float*)(ws + WS_SLW); F.CNT = F.ctl + CW_CNT; F.HS = (bf16_t*)(ws + WS_HS); F.XN2 = ws + WS_XN2;
    for (int u = F.tid; u < (LDS_BYTES - MISC_OFF) / 4; u += 512) F.MISC[u] = 0u;
    __syncthreads();
    const bool split = (F.G % 64) == 0 && NC8 > 0;
    const int row8 = (int)blockIdx.x >> 3;
    const bool conv_role = split && ((row8 & 7) < NC8);
    const int Gm = split ? (F.G / 8) * (8 - NC8) : F.G, Gc = split ? (F.G / 8) * NC8 : F.G;
    const int cm = split ? ((int)blockIdx.x & 7) + 8 * ((row8 >> 3) * (8 - NC8) + ((row8 & 7) - NC8)) : (int)blockIdx.x;
    const int cc = split ? ((int)blockIdx.x & 7) + 8 * ((row8 >> 3) * NC8 + (row8 & 7)) : (int)blockIdx.x;
    XcdBarrier bar = xcd_barrier_post(F.ctl + CW_BAR, F.MISC + 8, (unsigned)F.G, true);
    XcdBarrier barM = xcd_barrier_post(F.ctl + CW_BARM, F.MISC + 10, (unsigned)Gm, !conv_role);
#ifndef PH_MASK
#define PH_MASK 0xFFF
#endif
#define IN(k) ((PH_MASK >> (k)) & 1)
#define REP(k) ((REPEAT_MASK >> (k)) & 1)
#define NREP(k) (1 + (REP(k) ? args.pad : 0))

    if (conv_role) {
        F.bid = cc; F.nb = Gc;
        if (IN(8)) { ph_expert_conv6(F); ph_expert_conv(F); }
    } else {
        F.bid = cm; F.nb = Gm;
        if (IN(0)) ph0(F);
        xcd_barrier(barM);
        if (IN(1)) ph1(F);
        xcd_barrier(barM);
        if (IN(2)) {
            DenseOrder S; S.nM = 64; S.nN = 20; S.nwg = 1280; S.G = Gm; S.c = cm; S.nX = 0; S.A = (const char*)F.XN; S.Bt = (const char*)F.WIN; S.tstep = (size_t)256 * D * 2;
            EpiInProj E{args.ws, F.P};
            pg8::gemm_phase<EpiInProj, DenseOrder, false, true, true, false>(F.lds, D, S, E);
        }
        if (IN(8)) { ph_expert_conv6(F); ph_expert_conv(F); }
    }
    F.bid = blockIdx.x; F.nb = F.G;
    xcd_barrier(bar);
    if (IN(3)) { gates_phase<false>(F, NREP(3)); } xcd_barrier(bar);
    if (IN(4)) { for (int r = 0; r < NREP(4); ++r) { if (r) xcd_barrier(bar); ph4(F); } } xcd_barrier(bar);
    if (IN(5)) { gates_phase<true>(F, NREP(5)); } xcd_barrier(bar);
    if (IN(5)) { for (int r = 0; r < NREP(7); ++r) { if (r) xcd_barrier(bar); ph5b(F); } } xcd_barrier(bar);
    if (IN(6)) {
        DenseOrder S; S.nM = 64; S.nN = 8; S.nwg = 512; S.G = F.G; S.c = blockIdx.x; S.nX = 0; S.A = (const char*)F.Y; S.Bt = (const char*)F.WOUT; S.tstep = (size_t)256 * D * 2;
        EpiOutProj E{F.XN, F.MOD};
        for (int r = 0; r < NREP(6); ++r) { if (r) xcd_barrier(bar); pg8::gemm_phase<EpiOutProj, DenseOrder, false, true, true, false>(F.lds, D, S, E); }
    } xcd_barrier(bar);
    if (IN(7)) { ph7(F); } xcd_barrier(bar);
    if (IN(9)) {
        moe_tables(F);
        MoeOrder S; S.tab = (const LAS int*)F.MISC; S.NT = 16; S.G = F.G; S.c = blockIdx.x; S.nwg = __builtin_amdgcn_readfirstlane((int)F.MISC[16 + NE]) * 16; S.A = (const char*)F.XN2; S.Bt = (const char*)F.WGU; S.STOK = F.STOK;
        S.bstep_e = (size_t)4096 * D; S.tstep = (size_t)256 * D; S.gather = true;
        EpiGU E{F.H, F.b_gate, F.b_up};
        for (int r = 0; r < NREP(9); ++r) { if (r) xcd_barrier(bar); pg8::gemm_phase<EpiGU, MoeOrder, true, true, true, true, true>(F.lds, D / 2, S, E); }
    } xcd_barrier(bar);
    if (IN(10)) {
        MoeOrder S; S.tab = (const LAS int*)F.MISC; S.NT = 8; S.G = F.G; S.c = blockIdx.x; S.nwg = __builtin_amdgcn_readfirstlane((int)F.MISC[16 + NE]) * 8; S.A = (const char*)F.H; S.Bt = (const char*)F.WDN; S.STOK = F.STOK;
        S.bstep_e = (size_t)D * FF; S.tstep = (size_t)256 * FF; S.gather = false;
        EpiDown E{F.O, F.b_down, F.SLW, (const LAS int*)F.MISC + 128};
        for (int r = 0; r < NREP(10); ++r) { if (r) xcd_barrier(bar); pg8::gemm_phase<EpiDown, MoeOrder, false, true, true, true>(F.lds, FF / 2, S, E); }
    } xcd_barrier(bar);
    if (IN(11)) { ph11(F); }
#undef IN
#undef REP
}

extern "C" void kernel_launch(void* const* d_in, const int* in_sizes, int n_in, void* d_out, int out_size, void* d_ws, size_t ws_size, hipStream_t stream) {
    static int grid = 0;
    if (grid == 0) {
        if (n_in != 29 || in_sizes[0] != T * D || out_size != T * D || ws_size < WS_END) { fprintf(stderr, "kernel_launch: unexpected shapes (n_in %d, in0 %d, out %d, ws %zu); nothing launched\n", n_in, n_in > 0 ? in_sizes[0] : -1, out_size, ws_size); grid = -1; return; }
        int dev = 0, cus = 0, per_cu = 0;
        if (hipGetDevice(&dev) != hipSuccess || hipDeviceGetAttribute(&cus, hipDeviceAttributeMultiprocessorCount, dev) != hipSuccess) { grid = -1; return; }
        if (hipFuncSetAttribute((const void*)fwd_kernel, hipFuncAttributeMaxDynamicSharedMemorySize, LDS_BYTES) != hipSuccess) { fprintf(stderr, "kernel_launch: hipFuncSetAttribute failed\n"); grid = -1; return; }
        if (hipOccupancyMaxActiveBlocksPerMultiprocessor(&per_cu, (const void*)fwd_kernel, 512, LDS_BYTES) != hipSuccess || per_cu < 1) fprintf(stderr, "kernel_launch: occupancy query reports %d\n", per_cu);
        (void)hipGetLastError();
        grid = cus;
    }
    if (grid < 0) return;
    (void)hipMemsetAsync((char*)d_ws + WS_CTL, 0, CTL_ZERO_BYTES, stream);
    Args a{};
    for (int i = 0; i < 29; ++i) a.in[i] = (const float*)d_in[i];
    a.out = (float*)d_out; a.ws = (unsigned char*)d_ws;
    a.ph_lo = 0; a.ph_hi = NPH; a.li = 0; a.pad = REPEAT_MASK ? 1 : 0; hipLaunchKernelGGL(fwd_kernel, dim3(grid), dim3(512), LDS_BYTES, stream, a);
}
```
